# Optimizing an MI355X kernel written in HIP

```python
import math
import jax, jax.numpy as jnp
from jax import lax
import numpy as np

D_MODEL = 1024
BATCH = 4
SEQ = 8192
DEPTH = 4

D_MIX = D_MODEL
N_MIXERS = 4
GROUP_WIDTH = D_MIX // N_MIXERS
HEAD_DIM = 64
N_HEADS = GROUP_WIDTH // HEAD_DIM
ATTN_BLOCK = 128
SG_CHUNK = 128
SSM_CHUNK = 128
SSM_GROUPS = 2
SSM_HEADS_PER_GROUP = N_HEADS // SSM_GROUPS
SSM_STATE = 128
CONV_WIDTH = 4
SSM_XBC = GROUP_WIDTH + 2 * SSM_GROUPS * SSM_STATE
MLSTM_CHUNK = 128
MLSTM_M_INIT = -1e30
N_EXPERT_GROUPS = 4
EXPERTS_PER_GROUP = 8
N_EXPERTS = N_EXPERT_GROUPS * EXPERTS_PER_GROUP
TOP_K = 2
D_EXPERT = 512
MOE_BLOCK = 256
NORM_EPS = 1e-6
ATTN_COLS = 3 * GROUP_WIDTH + N_HEADS
SG_COLS = 2 * GROUP_WIDTH
SSM_COLS = GROUP_WIDTH + SSM_XBC + N_HEADS
MLSTM_COLS = 4 * GROUP_WIDTH + 2 * N_HEADS
D_IN_PROJ = ATTN_COLS + SG_COLS + SSM_COLS + MLSTM_COLS

kernel_name = 'hybrid_fox_gmlp_ssd_mlstm_hmoe'


def rms_norm(x, gain):
    xf = x.astype(jnp.float32)
    y = xf * lax.rsqrt(jnp.mean(xf * xf, axis=-1, keepdims=True) + NORM_EPS)
    return (y * gain.astype(jnp.float32)).astype(x.dtype)


def split_columns(x, widths):
    cuts = [int(i) for i in np.cumsum(widths)[:-1]]
    return jnp.split(x, cuts, axis=-1)


def causal_depthwise_conv(x, w, b):
    width, ch = w.shape
    y = lax.conv_general_dilated(x, w[:, None, :].astype(x.dtype), window_strides=(1,),
                                 padding=((width - 1, 0),),
                                 dimension_numbers=('NWC', 'WIO', 'NWC'),
                                 feature_group_count=ch)
    return y + b.astype(y.dtype)


def forgetting_attention(q, k, v, f_logit):
    Bb, S, H, Dh = q.shape
    L = ATTN_BLOCK
    qf = q.astype(jnp.float32) * (Dh ** -0.5)
    kf = k.astype(jnp.float32)
    vf = v.astype(jnp.float32)
    cum_logf = jnp.cumsum(jax.nn.log_sigmoid(f_logit.astype(jnp.float32)), axis=1).transpose(0, 2, 1)
    diag = jnp.tril(jnp.ones((L, L), bool))
    outs = []
    for blk in range(S // L):
        q0, q1 = blk * L, (blk + 1) * L
        logits = jnp.einsum('bqhd,bkhd->bhqk', qf[:, q0:q1], kf[:, :q1])
        logits = logits + cum_logf[:, :, q0:q1, None] - cum_logf[:, :, None, :q1]
        mask = jnp.concatenate([jnp.ones((L, q0), bool), diag], axis=1)
        probs = jax.nn.softmax(jnp.where(mask, logits, -jnp.inf), axis=-1)
        outs.append(jnp.einsum('bhqk,bkhd->bqhd', probs, vf[:, :q1]))
    return jnp.concatenate(outs, axis=1)


def spatial_gating(u, v, v_gain, w_s, b_s):
    Bb, S, H, Dh = u.shape
    L = SG_CHUNK
    u = jax.nn.gelu(u.astype(jnp.float32))
    v = rms_norm(jax.nn.gelu(v.astype(jnp.float32)), v_gain)
    causal = jnp.tril(jnp.ones((L, L), bool))
    w = jnp.where(causal[None], w_s.astype(jnp.float32), 0.0)
    vc = v.reshape(Bb, S // L, L, H, Dh)
    mixed = jnp.einsum('hts,bcshd->bcthd', w, vc) + b_s.astype(jnp.float32).T[None, None, :, :, None]
    return u * mixed.reshape(Bb, S, H, Dh)


def ssd_chunked(x, a, b, c):
    Bb, S, G, R, P = x.shape
    L = SSM_CHUNK
    nc = S // L
    x = x.reshape(Bb, nc, L, G, R, P)
    a = a.reshape(Bb, nc, L, G, R)
    b = b.reshape(Bb, nc, L, G, -1)
    c = c.reshape(Bb, nc, L, G, -1)
    a_cum = jnp.cumsum(a, axis=2)
    causal = jnp.tril(jnp.ones((L, L), bool))[None, None, :, :, None, None]
    seg = a_cum[:, :, :, None] - a_cum[:, :, None, :]
    decay = jnp.exp(jnp.where(causal, seg, -jnp.inf))
    scores = jnp.einsum('bctgn,bcsgn->bctsg', c, b)
    y_diag = jnp.einsum('bctsgr,bcsgrp->bctgrp', scores[..., None] * decay, x)
    decay_to_end = jnp.exp(a_cum[:, :, -1:] - a_cum)
    states = jnp.einsum('bcsgn,bcsgrp->bcgrpn', b, x * decay_to_end[..., None])
    chunk_decay = jnp.exp(a_cum[:, :, -1])

    def carry_state(h, inp):
        st, dc = inp
        return dc[..., None, None] * h + st, h

    h0 = jnp.zeros((Bb,) + states.shape[2:], jnp.float32)
    _, h_in = lax.scan(carry_state, h0, (jnp.moveaxis(states, 1, 0), jnp.moveaxis(chunk_decay, 1, 0)))
    h_in = jnp.moveaxis(h_in, 0, 1)
    y_off = jnp.einsum('bctgn,bcgrpn->bctgrp', c, h_in) * jnp.exp(a_cum)[..., None]
    return (y_diag + y_off).reshape(Bb, S, G, R, P)


def mamba2_mixer(z, xbc, dt_raw, conv_w, conv_b, dt_bias, a_log, d_skip):
    Bb, S, _ = xbc.shape
    G, R = SSM_GROUPS, SSM_HEADS_PER_GROUP
    xbc = jax.nn.silu(causal_depthwise_conv(xbc, conv_w, conv_b)).astype(jnp.float32)
    xs, bm, cm = jnp.split(xbc, [GROUP_WIDTH, GROUP_WIDTH + SSM_GROUPS * SSM_STATE], axis=-1)
    xs = xs.reshape(Bb, S, G, R, HEAD_DIM)
    bm = bm.reshape(Bb, S, G, SSM_STATE)
    cm = cm.reshape(Bb, S, G, SSM_STATE)
    dt = jax.nn.softplus(dt_raw.astype(jnp.float32) + dt_bias.astype(jnp.float32)).reshape(Bb, S, G, R)
    a = -jnp.exp(a_log.astype(jnp.float32)).reshape(G, R)
    y = ssd_chunked(xs * dt[..., None], dt * a, bm, cm)
    y = y + d_skip.astype(jnp.float32).reshape(G, R)[..., None] * xs
    y = y.reshape(Bb, S, N_HEADS, HEAD_DIM)
    return y * jax.nn.silu(z.astype(jnp.float32)).reshape(Bb, S, N_HEADS, HEAD_DIM)


def mlstm_chunkwise(q, k, v, i_pre, f_pre):
    Bb, S, H, Dh = q.shape
    L = MLSTM_CHUNK
    nc = S // L
    q = q.astype(jnp.float32).reshape(Bb, nc, L, H, Dh)
    k = (k.astype(jnp.float32) * (Dh ** -0.5)).reshape(Bb, nc, L, H, Dh)
    v = v.astype(jnp.float32).reshape(Bb, nc, L, H, Dh)
    log_f = jax.nn.log_sigmoid(f_pre.astype(jnp.float32)).reshape(Bb, nc, L, H)
    ig = i_pre.astype(jnp.float32).reshape(Bb, nc, L, H)
    a = jnp.cumsum(log_f, axis=2)
    a_end = a[:, :, -1]
    g = a_end[:, :, None] - a + ig

    def carry_state(carry, inp):
        C, n, m = carry
        kc, vc, gc, ac = inp
        m_new = jnp.maximum(ac + m, gc.max(axis=1))
        w_s = jnp.exp(gc - m_new[:, None, :])
        scale = jnp.exp(ac + m - m_new)
        C_new = scale[..., None, None] * C + jnp.einsum('blhd,blhe->bhde', vc * w_s[..., None], kc)
        n_new = scale[..., None] * n + jnp.einsum('blh,blhe->bhe', w_s, kc)
        return (C_new, n_new, m_new), (C, n, m)

    init = (jnp.zeros((Bb, H, Dh, Dh), jnp.float32), jnp.zeros((Bb, H, Dh), jnp.float32),
            jnp.full((Bb, H), MLSTM_M_INIT, jnp.float32))
    _, (C_in, n_in, m_in) = lax.scan(carry_state, init, (jnp.moveaxis(k, 1, 0), jnp.moveaxis(v, 1, 0),
                                                         jnp.moveaxis(g, 1, 0), jnp.moveaxis(a_end, 1, 0)))
    C_in = jnp.moveaxis(C_in, 0, 1)
    n_in = jnp.moveaxis(n_in, 0, 1)
    m_in = jnp.moveaxis(m_in, 0, 1)
    causal = jnp.tril(jnp.ones((L, L), bool))[None, None, :, :, None]
    log_d = a[:, :, :, None, :] - a[:, :, None, :, :] + ig[:, :, None, :, :]
    log_d = jnp.where(causal, log_d, -jnp.inf)
    log_inter = a + m_in[:, :, None, :]
    m_t = jnp.maximum(log_d.max(axis=3), log_inter)
    w = jnp.einsum('bcthd,bcshd->bctsh', q, k) * jnp.exp(log_d - m_t[:, :, :, None, :])
    inter = jnp.exp(log_inter - m_t)
    num = jnp.einsum('bctsh,bcshd->bcthd', w, v) + inter[..., None] * jnp.einsum('bchde,bcthe->bcthd', C_in, q)
    den = w.sum(axis=3) + inter * jnp.einsum('bche,bcthe->bcth', n_in, q)
    h = num / jnp.maximum(jnp.abs(den), jnp.exp(-m_t))[..., None]
    return h.reshape(Bb, S, H, Dh)


def hybrid_mixer(h, w_in, w_out, mix_gain, attn_f_bias, sg_w, sg_b, conv_w, conv_b,
                 dt_bias, a_log, d_skip, i_bias, f_bias):
    Bb, S, _ = h.shape
    heads = lambda t: t.reshape(Bb, S, N_HEADS, HEAD_DIM)
    gw = GROUP_WIDTH
    proj = h @ w_in
    (aq, ak, av, af, su, sv, mz, mxbc, mdt, lq, lk, lv, lo, li, lf) = split_columns(
        proj, [gw, gw, gw, N_HEADS, gw, gw, gw, SSM_XBC, N_HEADS, gw, gw, gw, gw, N_HEADS, N_HEADS])
    g_attn, g_sg, g_ssm, g_ml = [t.reshape(N_HEADS, HEAD_DIM) for t in jnp.split(mix_gain, N_MIXERS)]
    y_attn = rms_norm(forgetting_attention(heads(aq), heads(ak), heads(av),
                                           af.astype(jnp.float32) + attn_f_bias.astype(jnp.float32)), g_attn)
    y_sg = spatial_gating(heads(su), heads(sv), g_sg, sg_w, sg_b)
    y_ssm = rms_norm(mamba2_mixer(mz, mxbc, mdt, conv_w, conv_b, dt_bias, a_log, d_skip), g_ssm)
    y_ml = jax.nn.sigmoid(heads(lo).astype(jnp.float32)) * rms_norm(
        mlstm_chunkwise(heads(lq), heads(lk), heads(lv),
                        li.astype(jnp.float32) + i_bias.astype(jnp.float32),
                        lf.astype(jnp.float32) + f_bias.astype(jnp.float32)), g_ml)
    y = jnp.concatenate([y_attn, y_sg, y_ssm, y_ml], axis=2).reshape(Bb, S, D_MIX).astype(h.dtype)
    return y @ w_out


def hierarchical_moe(h, w_rg, b_rg, w_re, b_re, w_gate, w_up, w_down):
    Bb, S, D = h.shape
    tokens = h.reshape(-1, D)
    T = tokens.shape[0]
    rows = jnp.arange(T)
    g_logits = (tokens @ w_rg).astype(jnp.float32) + b_rg.astype(jnp.float32)
    g_sel = jnp.argmax(g_logits, axis=-1)
    g_prob = jax.nn.softmax(g_logits, axis=-1)[rows, g_sel]
    e_logits = ((tokens @ w_re).astype(jnp.float32) + b_re.astype(jnp.float32)).reshape(
        T, N_EXPERT_GROUPS, EXPERTS_PER_GROUP)[rows, g_sel]
    top_logit, top_local = lax.top_k(e_logits, TOP_K)
    gate = g_prob[:, None] * jax.nn.softmax(top_logit, axis=-1)
    expert = g_sel[:, None] * EXPERTS_PER_GROUP + top_local
    M = T * TOP_K
    e_flat = expert.reshape(-1).astype(jnp.int32)
    tok_flat = (jnp.arange(M) // TOP_K).astype(jnp.int32)
    w_flat = gate.reshape(-1)
    order = jnp.argsort(e_flat)
    e_sorted = e_flat[order]
    counts = jnp.bincount(e_flat, length=N_EXPERTS)
    starts = jnp.cumsum(counts) - counts
    padded = ((counts + MOE_BLOCK - 1) // MOE_BLOCK) * MOE_BLOCK
    p_ends = jnp.cumsum(padded)
    p_starts = p_ends - padded
    dest = p_starts[e_sorted] + (jnp.arange(M) - starts[e_sorted])
    n_blocks = -(-M // MOE_BLOCK) + N_EXPERTS
    P = n_blocks * MOE_BLOCK
    row_tok = jnp.full((P,), T, jnp.int32).at[dest].set(tok_flat[order])
    row_w = jnp.zeros((P,), jnp.float32).at[dest].set(w_flat[order])
    block_e = jnp.minimum(jnp.searchsorted(p_ends, jnp.arange(n_blocks) * MOE_BLOCK, side='right'),
                          N_EXPERTS - 1)
    tokens_pad = jnp.concatenate([tokens, jnp.zeros((1, D), tokens.dtype)], axis=0)
    xb = tokens_pad[row_tok].reshape(n_blocks, MOE_BLOCK, D)

    def expert_block(args):
        xe, e = args
        return (jax.nn.silu(xe @ w_gate[e]) * (xe @ w_up[e])) @ w_down[e]

    yb = lax.map(expert_block, (xb, block_e)).reshape(P, D)
    y = jnp.zeros((T + 1, D), jnp.float32).at[row_tok].add(yb.astype(jnp.float32) * row_w[:, None])
    return y[:T].reshape(Bb, S, D).astype(h.dtype)


def setup_inputs(seed: int = 0) -> dict:
    key = jax.random.key(seed)
    ks = jax.random.split(key, 32)
    nrm = lambda k, shape, s: s * jax.random.normal(k, shape, jnp.float32)
    x = nrm(ks[0], (BATCH, SEQ, D_MODEL), 1.0)
    c = nrm(ks[1], (BATCH, D_MODEL), 1.0)
    w_in = nrm(ks[2], (DEPTH, D_MODEL, D_IN_PROJ), D_MODEL ** -0.5)
    w_out = nrm(ks[3], (DEPTH, D_MIX, D_MODEL), D_MIX ** -0.5)
    w_mix_norm = 1.0 + nrm(ks[4], (DEPTH, D_MIX), 0.1)
    attn_f_bias = jnp.linspace(2.0, 6.0, N_HEADS)[None, :] + nrm(ks[5], (DEPTH, N_HEADS), 0.1)
    sg_w = nrm(ks[6], (DEPTH, N_HEADS, SG_CHUNK, SG_CHUNK), 0.5 * SG_CHUNK ** -0.5)
    sg_b = 1.0 + nrm(ks[7], (DEPTH, N_HEADS, SG_CHUNK), 0.1)
    ssm_conv_w = nrm(ks[8], (DEPTH, CONV_WIDTH, SSM_XBC), CONV_WIDTH ** -0.5)
    ssm_conv_b = nrm(ks[9], (DEPTH, SSM_XBC), 0.02)
    dt0 = jnp.exp(jax.random.uniform(ks[10], (DEPTH, N_HEADS), jnp.float32,
                                     minval=math.log(1e-3), maxval=math.log(1e-1)))
    ssm_dt_bias = dt0 + jnp.log(-jnp.expm1(-dt0))
    ssm_a_log = jnp.log(jax.random.uniform(ks[11], (DEPTH, N_HEADS), jnp.float32, minval=1.0, maxval=16.0))
    ssm_d = 1.0 + nrm(ks[12], (DEPTH, N_HEADS), 0.1)
    mlstm_i_bias = nrm(ks[13], (DEPTH, N_HEADS), 0.1)
    mlstm_f_bias = jnp.linspace(3.0, 6.0, N_HEADS)[None, :] + nrm(ks[14], (DEPTH, N_HEADS), 0.1)
    w_ada = nrm(ks[15], (DEPTH, D_MODEL, 6 * D_MODEL), 0.5 * D_MODEL ** -0.5)
    b_ada = nrm(ks[16], (DEPTH, 6 * D_MODEL), 0.02)
    w_norm1 = 1.0 + nrm(ks[17], (DEPTH, D_MODEL), 0.1)
    w_norm2 = 1.0 + nrm(ks[18], (DEPTH, D_MODEL), 0.1)
    w_router_group = nrm(ks[19], (DEPTH, D_MODEL, N_EXPERT_GROUPS), D_MODEL ** -0.5)
    b_router_group = nrm(ks[20], (DEPTH, N_EXPERT_GROUPS), 0.01)
    w_router_expert = nrm(ks[21], (DEPTH, D_MODEL, N_EXPERTS), D_MODEL ** -0.5)
    b_router_expert = nrm(ks[22], (DEPTH, N_EXPERTS), 0.01)
    w_expert_gate = nrm(ks[23], (DEPTH, N_EXPERTS, D_MODEL, D_EXPERT), D_MODEL ** -0.5)
    w_expert_up = nrm(ks[24], (DEPTH, N_EXPERTS, D_MODEL, D_EXPERT), D_MODEL ** -0.5)
    w_expert_down = nrm(ks[25], (DEPTH, N_EXPERTS, D_EXPERT, D_MODEL), D_EXPERT ** -0.5)
    w_norm_final = 1.0 + nrm(ks[26], (D_MODEL,), 0.1)
    return {'x': x, 'c': c, 'w_in': w_in, 'w_out': w_out, 'w_mix_norm': w_mix_norm,
            'attn_f_bias': attn_f_bias, 'sg_w': sg_w, 'sg_b': sg_b,
            'ssm_conv_w': ssm_conv_w, 'ssm_conv_b': ssm_conv_b, 'ssm_dt_bias': ssm_dt_bias,
            'ssm_a_log': ssm_a_log, 'ssm_d': ssm_d, 'mlstm_i_bias': mlstm_i_bias,
            'mlstm_f_bias': mlstm_f_bias, 'w_ada': w_ada, 'b_ada': b_ada,
            'w_norm1': w_norm1, 'w_norm2': w_norm2,
            'w_router_group': w_router_group, 'b_router_group': b_router_group,
            'w_router_expert': w_router_expert, 'b_router_expert': b_router_expert,
            'w_expert_gate': w_expert_gate, 'w_expert_up': w_expert_up,
            'w_expert_down': w_expert_down, 'w_norm_final': w_norm_final}


def reference(x, c, w_in, w_out, w_mix_norm, attn_f_bias, sg_w, sg_b, ssm_conv_w, ssm_conv_b,
              ssm_dt_bias, ssm_a_log, ssm_d, mlstm_i_bias, mlstm_f_bias, w_ada, b_ada,
              w_norm1, w_norm2, w_router_group, b_router_group, w_router_expert, b_router_expert,
              w_expert_gate, w_expert_up, w_expert_down, w_norm_final):
    cond = jax.nn.silu(c)
    for layer in range(DEPTH):
        mod = cond @ w_ada[layer] + b_ada[layer]
        shift1, scale1, gate1, shift2, scale2, gate2 = jnp.split(mod[:, None, :], 6, axis=-1)
        h = rms_norm(x, w_norm1[layer]) * (1.0 + scale1) + shift1
        x = x + gate1 * hybrid_mixer(h, w_in[layer], w_out[layer], w_mix_norm[layer], attn_f_bias[layer],
                                     sg_w[layer], sg_b[layer], ssm_conv_w[layer], ssm_conv_b[layer],
                                     ssm_dt_bias[layer], ssm_a_log[layer], ssm_d[layer],
                                     mlstm_i_bias[layer], mlstm_f_bias[layer])
        h = rms_norm(x, w_norm2[layer]) * (1.0 + scale2) + shift2
        x = x + gate2 * hierarchical_moe(h, w_router_group[layer], b_router_group[layer],
                                         w_router_expert[layer], b_router_expert[layer],
                                         w_expert_gate[layer], w_expert_up[layer], w_expert_down[layer])
    return rms_norm(x, w_norm_final)
```

```cpp
#include <hip/hip_runtime.h>
#include <hip/hip_bf16.h>
#include <cstdio>
#include <cstdint>
#include <cmath>
namespace pg8 {
#define PG8_LAS __attribute__((address_space(3)))
typedef unsigned short bf16_t;
typedef short bf16x8 __attribute__((ext_vector_type(8)));
typedef float f32x4 __attribute__((ext_vector_type(4)));
typedef unsigned u32x4 __attribute__((ext_vector_type(4)));
constexpr int BM = 256, BK = 64, HALF = 128, HTB = HALF * BK * 2  , STAGE_BYTES = 8 * HTB, NXCD = 8, WGM = 8;

__host__ __device__ __forceinline__ int lds_byte(int r, int c) { const int st = (r >> 4) * 2 + (c >> 5), rr = r & 15, cc = c & 31, ob = rr * 64 + cc * 2; return st * 1024 + (ob ^ (((ob >> 9) & 1) << 5)); }
__host__ __device__ __forceinline__ void stage_rc(int b, int& R, int& C) { const int st = b / 1024, sb = b % 1024, swz = sb ^ (((sb >> 9) & 1) << 5); R = (st >> 1) * 16 + swz / 64; C = (st & 1) * 32 + (swz % 64) / 2; }
__host__ __device__ __forceinline__ int perm32(int rho) { const int n = rho >> 4, i = rho & 15; return 8 * (i >> 2) + 4 * n + (i & 3); }

struct Unit { int pm, pn; };
struct Gemm { const bf16_t* A; const bf16_t* Bt; int M, N, K; };

struct StaticOrder {
    int nM, nN, nwg, G, c;
    __host__ __device__ void init(int M, int N, int G_, int c_) { nM = M / BM; nN = N / BM; nwg = nM * nN; G = G_; c = c_; }
    __host__ __device__ bool next(int i, Unit& u) const {
        const long L = (long)i * G + c; if (L >= nwg) return false;
        int wgid = (int)L; { const int q = nwg / NXCD, r = nwg % NXCD, xcd = wgid % NXCD, off = wgid / NXCD; wgid = (xcd < r ? xcd * (q + 1) : r * (q + 1) + (xcd - r) * q) + off; }
        const int nig = WGM * nN, gid = wgid / nig, fm = gid * WGM, gsz = (nM - fm) < WGM ? (nM - fm) : WGM;
        u.pm = fm + ((wgid % nig) % gsz); u.pn = (wgid % nig) / gsz; return true;
    }
    __device__ __forceinline__ void a_ready(const Unit&) const {}
    __device__ __forceinline__ void done(const Unit&) const {}
};

__device__ __forceinline__ unsigned cvt_pk_bf16(float lo, float hi) { unsigned r; asm volatile("v_cvt_pk_bf16_f32 %0, %1, %2" : "=v"(r) : "v"(lo), "v"(hi)); return r; }
typedef float f32x2 __attribute__((ext_vector_type(2)));
template <class Epi, class Sched, bool ALIGN_EPI = false, bool SP2 = false>
__device__ __forceinline__ void gemm_phase(PG8_LAS unsigned char* lds, const Gemm g, const Sched& S, const Epi& E) {
    int tid_ = threadIdx.x; asm volatile("" : "+v"(tid_));
    const int tid = tid_, wid = __builtin_amdgcn_readfirstlane(tid >> 6), lane = tid & 63, wr = wid >> 2, wc = wid & 3, fr = lane & 15, fq = lane >> 4;
    const int K = g.K, nt = K / BK;
    unsigned voffA[2], voffB[2];
#pragma unroll
    for (int i = 0; i < 2; ++i) { int R, C; stage_rc(tid * 16 + i * 8192, R, C); const int Rb = Epi::PERM ? ((R & ~31) + perm32(R & 31)) : R;
        voffA[i] = (unsigned)(R * K + C) * 2u; voffB[i] = (unsigned)(Rb * K + C) * 2u; }
    const size_t kstep = (size_t)(BK * 2);
    const size_t hstep = (size_t)HALF * K * 2;
    const size_t tstep = 2 * hstep;
    const unsigned ldsw = (unsigned)wid * 1024u;
    const int aoff = lds_byte(wr * 64 + fr, fq * 8), boff = lds_byte(wc * 32 + fr, fq * 8);
#define PG8_SA(b, h) (((b) * 2 + (h)) * HTB)
#define PG8_SB(b, h) ((4 + (b) * 2 + (h)) * HTB)
#define PG8_STAGE(bufoff, gbase, voff) do { _Pragma("unroll") for (int _i = 0; _i < 2; ++_i) \
        __builtin_amdgcn_global_load_lds((const unsigned*)((const char*)(gbase) + (voff)[_i]), (PG8_LAS unsigned*)(lds + (bufoff) + ldsw + _i * 8192), 16, 0, 0); } while (0)
#define PG8_LDA(dst, b, h) do { _Pragma("unroll") for (int m = 0; m < 4; ++m) _Pragma("unroll") for (int k = 0; k < 2; ++k) dst[m][k] = *(const PG8_LAS bf16x8*)(lds + PG8_SA(b, h) + aoff + m * 2048 + k * 1024); } while (0)
#define PG8_LDB(dst, b, h) do { _Pragma("unroll") for (int n = 0; n < 2; ++n) _Pragma("unroll") for (int k = 0; k < 2; ++k) dst[n][k] = *(const PG8_LAS bf16x8*)(lds + PG8_SB(b, h) + boff + n * 2048 + k * 1024); } while (0)
#define PG8_MMA(ai, bj, At, Bt) do { __builtin_amdgcn_s_setprio(1); _Pragma("unroll") for (int m = 0; m < 4; ++m) _Pragma("unroll") for (int n = 0; n < 2; ++n) _Pragma("unroll") for (int k = 0; k < 2; ++k) \
        acc[ai][bj][m][n] = __builtin_amdgcn_mfma_f32_16x16x32_bf16(Bt[n][k], At[m][k], acc[ai][bj][m][n], 0, 0, 0); __builtin_amdgcn_s_setprio(0); } while (0)
#define PG8_WAIT_V(n) asm volatile("s_waitcnt vmcnt(" #n ")" ::: "memory")
#define PG8_WAIT_L(n) asm volatile("s_waitcnt lgkmcnt(" #n ")" ::: "memory")
#define PG8_BAR __builtin_amdgcn_s_barrier()
#define PG8_SCHED __builtin_amdgcn_sched_barrier(0)
    Unit cur, nxt; int ui = 0;
    if (!S.next(0, cur)) return;
    f32x4 acc[2][2][4][2];
#pragma unroll
    for (int a = 0; a < 2; ++a)
#pragma unroll
        for (int b = 0; b < 2; ++b)
#pragma unroll
            for (int m = 0; m < 4; ++m)
#pragma unroll
                for (int n = 0; n < 2; ++n) acc[a][b][m][n] = (f32x4){0.f, 0.f, 0.f, 0.f};
    bf16x8 At[4][2], B0[2][2], B1[2][2];
    const char* cA = (const char*)g.A + (size_t)cur.pm * tstep; const char* cB = (const char*)g.Bt + (size_t)cur.pn * tstep;
    S.a_ready(cur);
    if constexpr (SP2) {
        PG8_STAGE(PG8_SB(0, 0), cB, voffB); PG8_STAGE(PG8_SB(0, 1), cB + hstep, voffB); PG8_STAGE(PG8_SA(0, 0), cA, voffA); PG8_STAGE(PG8_SA(0, 1), cA + hstep, voffA);
        if (wr == 1) PG8_BAR;
        PG8_WAIT_V(2); PG8_BAR;
        PG8_STAGE(PG8_SB(1, 0), cB + kstep, voffB); PG8_STAGE(PG8_SA(1, 0), cA + kstep, voffA); PG8_STAGE(PG8_SB(1, 1), cB + hstep + kstep, voffB);
        PG8_WAIT_V(6); PG8_BAR;
    } else {
        PG8_STAGE(PG8_SB(0, 0), cB, voffB); PG8_STAGE(PG8_SA(0, 0), cA, voffA); PG8_STAGE(PG8_SB(0, 1), cB + hstep, voffB); PG8_STAGE(PG8_SA(0, 1), cA + hstep, voffA);
        if (wr == 1) PG8_BAR;
        PG8_WAIT_V(4); PG8_BAR;
        PG8_STAGE(PG8_SB(1, 0), cB + kstep, voffB); PG8_STAGE(PG8_SA(1, 0), cA + kstep, voffA); PG8_STAGE(PG8_SB(1, 1), cB + hstep + kstep, voffB);
        PG8_WAIT_V(6); PG8_BAR;
    }
    for (;;) {
        const bool has_next = S.next(ui + 1, nxt);
        const char* nA = has_next ? (const char*)g.A + (size_t)nxt.pm * tstep : cA; const char* nB = has_next ? (const char*)g.Bt + (size_t)nxt.pn * tstep : cB;
        for (int t = 0; t < nt; t += 2) {
            const bool last = (t == nt - 2);
            const char* a1 = cA + (size_t)(t + 1) * kstep;
            const char* a2 = last ? nA : cA + (size_t)(t + 2) * kstep; const char* b2 = last ? nB : cB + (size_t)(t + 2) * kstep;
            const char* a3 = a2 + kstep; const char* b3 = b2 + kstep;
            if (last && has_next) S.a_ready(nxt);
            if constexpr (SP2) {
            PG8_LDB(B0, 0, 0); PG8_LDB(B1, 0, 1); PG8_SCHED; PG8_LDA(At, 0, 0); PG8_STAGE(PG8_SA(1, 1), a1 + hstep, voffA);
            PG8_WAIT_V(8); PG8_WAIT_L(0); PG8_BAR; PG8_MMA(0, 0, At, B0); PG8_MMA(0, 1, At, B1); PG8_BAR; PG8_SCHED;
            PG8_LDA(At, 0, 1); PG8_STAGE(PG8_SB(0, 0), b2, voffB); PG8_STAGE(PG8_SB(0, 1), b2 + hstep, voffB); PG8_STAGE(PG8_SA(0, 0), a2, voffA);
            PG8_WAIT_V(8); PG8_WAIT_L(0); PG8_BAR; PG8_MMA(1, 0, At, B0); PG8_MMA(1, 1, At, B1); PG8_BAR; PG8_SCHED;
            PG8_LDB(B0, 1, 0); PG8_LDB(B1, 1, 1); PG8_SCHED; PG8_LDA(At, 1, 0); PG8_STAGE(PG8_SA(0, 1), a2 + hstep, voffA);
            PG8_WAIT_V(8); PG8_WAIT_L(0); PG8_BAR; PG8_MMA(0, 0, At, B0); PG8_MMA(0, 1, At, B1); PG8_BAR; PG8_SCHED;
            PG8_LDA(At, 1, 1); PG8_STAGE(PG8_SB(1, 0), b3, voffB); PG8_STAGE(PG8_SB(1, 1), b3 + hstep, voffB); PG8_STAGE(PG8_SA(1, 0), a3, voffA);
            PG8_WAIT_V(8); PG8_WAIT_L(0); PG8_BAR; PG8_MMA(1, 0, At, B0); PG8_MMA(1, 1, At, B1); PG8_BAR; PG8_SCHED;
            } else {
            PG8_LDB(B0, 0, 0); PG8_SCHED; PG8_LDA(At, 0, 0); PG8_STAGE(PG8_SA(1, 1), a1 + hstep, voffA);
            PG8_WAIT_L(8); PG8_BAR; PG8_WAIT_L(0); PG8_MMA(0, 0, At, B0); PG8_BAR; PG8_SCHED;
            PG8_LDB(B1, 0, 1); PG8_STAGE(PG8_SB(0, 0), b2, voffB);
            PG8_BAR; PG8_WAIT_L(0); PG8_MMA(0, 1, At, B1); PG8_BAR;
            PG8_LDA(At, 0, 1); PG8_STAGE(PG8_SA(0, 0), a2, voffA);
            PG8_BAR; PG8_WAIT_L(0); PG8_MMA(1, 0, At, B0); PG8_BAR; PG8_SCHED;
            PG8_STAGE(PG8_SB(0, 1), b2 + hstep, voffB);
            PG8_WAIT_V(6); PG8_BAR; PG8_MMA(1, 1, At, B1); PG8_BAR;
            PG8_LDB(B0, 1, 0); PG8_SCHED; PG8_LDA(At, 1, 0); PG8_STAGE(PG8_SA(0, 1), a2 + hstep, voffA);
            PG8_WAIT_L(8); PG8_BAR; PG8_WAIT_L(0); PG8_MMA(0, 0, At, B0); PG8_BAR; PG8_SCHED;
            PG8_LDB(B1, 1, 1); PG8_STAGE(PG8_SB(1, 0), b3, voffB);
            PG8_BAR; PG8_WAIT_L(0); PG8_MMA(0, 1, At, B1); PG8_BAR;
            PG8_LDA(At, 1, 1); PG8_STAGE(PG8_SA(1, 0), a3, voffA);
            PG8_BAR; PG8_WAIT_L(0); PG8_MMA(1, 0, At, B0); PG8_BAR; PG8_SCHED;
            PG8_STAGE(PG8_SB(1, 1), b3 + hstep, voffB);
            PG8_WAIT_V(6); PG8_BAR; PG8_MMA(1, 1, At, B1); PG8_BAR;
            }
        }
        if constexpr (ALIGN_EPI) { if (wr == 0) PG8_BAR; }
        if constexpr (!Epi::AFTER_DRAIN) { E(acc, cur, wr, wc, fr, fq); S.done(cur); }
        if (!has_next) break;
#pragma unroll
        for (int a = 0; a < 2; ++a)
#pragma unroll
            for (int b = 0; b < 2; ++b)
#pragma unroll
                for (int m = 0; m < 4; ++m)
#pragma unroll
                    for (int n = 0; n < 2; ++n) acc[a][b][m][n] = (f32x4){0.f, 0.f, 0.f, 0.f};
        cur = nxt; cA = nA; cB = nB; ++ui;
        if constexpr (ALIGN_EPI) { if (wr == 1) PG8_BAR; }
    }
    PG8_WAIT_V(0);
    if constexpr (!ALIGN_EPI) { if (wr == 0) PG8_BAR; }
    PG8_BAR;
    if constexpr (Epi::AFTER_DRAIN) { E.fused(acc, cur, wr, wc, fr, fq, lds, wid, lane); S.done(cur); }
#undef PG8_SA
#undef PG8_SB
#undef PG8_STAGE
#undef PG8_LDA
#undef PG8_LDB
#undef PG8_MMA
#undef PG8_WAIT_V
#undef PG8_WAIT_L
#undef PG8_BAR
#undef PG8_SCHED
}
}

#ifndef PG8_SP2
#define PG8_SP2 true
#endif
#ifndef PG8_ALIGN
#define PG8_ALIGN true
#endif
#include <hip/hip_bf16.h>
#include <cmath>
namespace attn_body {
using bf16=__hip_bfloat16;
using bf16x8=__attribute__((ext_vector_type(8)))short;
using s16x4=__attribute__((ext_vector_type(4)))short;
using f32x16=__attribute__((ext_vector_type(16)))float;
using u32x4=__attribute__((ext_vector_type(4)))unsigned;
typedef float f32x4_t __attribute__((ext_vector_type(4)));
constexpr int BATCH=4,NHEAD=4,SEQ=8192,D=64,DM=3328,DO=1024;
constexpr int NW=8,QBLK=32,QB=QBLK*NW,KVBLK=64,NQB=SEQ/QB;
constexpr int ATTN_UNIT_ROWS=QB;
__device__ __forceinline__ int crow(int r,int hi){return (r&3)+8*(r>>2)+4*hi;}
#define SBAR() __builtin_amdgcn_sched_barrier(0)
__device__ __forceinline__ void cmask(f32x16&p0,f32x16&p1,int jb,int qrel,int hi){
  const float NEG=-INFINITY; int kb=64*jb+4*hi;
  #pragma unroll
  for(int r=0;r<16;++r){int kv=kb+(r&3)+8*(r>>2); if(kv>qrel)p0[r]=NEG; if(kv+32>qrel)p1[r]=NEG;}
}

constexpr int NSLOT=3, SLOTB=8192;
constexpr int LDS_K=0, LDS_V=NSLOT*SLOTB, LDS_WS=2*NSLOT*SLOTB, LDS_OST=LDS_WS+NW*64*4, LDS_F2=LDS_OST+NW*4096, LDS_BYTES=LDS_F2+SEQ*4;
constexpr float C2=0.125f*1.4426950408889634f;
__device__ __forceinline__ void glds16(const void*gsrc,unsigned lds_dst){unsigned keep;
  asm volatile("s_mov_b32 %0, m0\n\ts_mov_b32 m0, %2\n\ts_nop 0\n\tglobal_load_lds_dwordx4 %1, off\n\ts_mov_b32 m0, %0":"=&s"(keep):"v"(gsrc),"s"(lds_dst):"memory");}
__device__ __forceinline__ float max3f(float a,float b,float c){float r;asm("v_max3_f32 %0, %1, %2, %3":"=v"(r):"v"(a),"v"(b),"v"(c));return r;}
__device__ __forceinline__ float max2f(float a,float b){float r;asm("v_max_f32_e32 %0, %1, %2":"=v"(r):"v"(a),"v"(b));return r;}
__device__ __forceinline__ float fadd_s(float a,float b){float r;asm("v_add_f32_e32 %0, %1, %2":"=v"(r):"v"(a),"v"(b));return r;}
__device__ __forceinline__ float fsub_s(float a,float b){float r;asm("v_sub_f32_e32 %0, %1, %2":"=v"(r):"v"(a),"v"(b));return r;}
typedef float f32x2_t __attribute__((ext_vector_type(2))); typedef __bf16 bf16x2_t __attribute__((ext_vector_type(2)));
__device__ __forceinline__ unsigned cvtpk_s(float lo,float hi){f32x2_t v={lo,hi};bf16x2_t b=__builtin_convertvector(v,bf16x2_t);return __builtin_bit_cast(unsigned,b);}
#define WAIT_BAR(N) asm volatile("s_waitcnt vmcnt(" #N ") lgkmcnt(0)\n\ts_barrier":::"memory")

__device__ __forceinline__ void qkt(f32x16&p0,f32x16&p1,const char*Kslot,const bf16x8*qr,const f32x16&negm,int r32,int hi){
  const char*kb=Kslot+hi*1024+r32*16;
  #pragma unroll
  for(int d0=0;d0<4;++d0){
    const bf16x8 b0=*reinterpret_cast<const bf16x8*>(kb+d0*2048);
    const bf16x8 b1=*reinterpret_cast<const bf16x8*>(kb+d0*2048+512);
    if(d0==0){p0=__builtin_amdgcn_mfma_f32_32x32x16_bf16(b0,qr[0],negm,0,0,0);p1=__builtin_amdgcn_mfma_f32_32x32x16_bf16(b1,qr[0],negm,0,0,0);}
    else{p0=__builtin_amdgcn_mfma_f32_32x32x16_bf16(b0,qr[d0],p0,0,0,0);p1=__builtin_amdgcn_mfma_f32_32x32x16_bf16(b1,qr[d0],p1,0,0,0);}}
}
typedef __attribute__((address_space(3))) const char* lds_cptr;
typedef short v4i16_t __attribute__((ext_vector_type(4)));
__device__ __forceinline__ void kload8(bf16x8*kf,lds_cptr kp){
  kf[0]=*(const __attribute__((address_space(3))) bf16x8*)(kp);      kf[1]=*(const __attribute__((address_space(3))) bf16x8*)(kp+512);
  kf[2]=*(const __attribute__((address_space(3))) bf16x8*)(kp+2048); kf[3]=*(const __attribute__((address_space(3))) bf16x8*)(kp+2560);
  kf[4]=*(const __attribute__((address_space(3))) bf16x8*)(kp+4096); kf[5]=*(const __attribute__((address_space(3))) bf16x8*)(kp+4608);
  kf[6]=*(const __attribute__((address_space(3))) bf16x8*)(kp+6144); kf[7]=*(const __attribute__((address_space(3))) bf16x8*)(kp+6656);
}
__device__ __forceinline__ void kload2(bf16x8*kf,lds_cptr kp,int j){ kf[2*j]=*(const __attribute__((address_space(3))) bf16x8*)(kp+j*2048); kf[2*j+1]=*(const __attribute__((address_space(3))) bf16x8*)(kp+j*2048+512); }
__device__ __forceinline__ s16x4 vtr(lds_cptr p){ return __builtin_bit_cast(s16x4,__builtin_amdgcn_ds_read_tr16_b64_v4i16((__attribute__((address_space(3))) v4i16_t*)p)); }
__device__ __forceinline__ float rowmax(const f32x16&p0,const f32x16&p1){
  float a=max3f(p0[0],p0[1],p1[0]),b=max3f(p0[2],p0[3],p1[1]);a=max3f(a,p1[2],p1[3]);
  #pragma unroll
  for(int r=4;r<16;r+=4){a=max3f(a,p0[r],p0[r+1]);b=max3f(b,p0[r+2],p0[r+3]);a=max3f(a,p1[r],p1[r+1]);b=max3f(b,p1[r+2],p1[r+3]);}
  const float m=max2f(a,b);
  auto rr=__builtin_amdgcn_permlane32_swap(__float_as_uint(m),__float_as_uint(m),false,false);
  return max2f(__uint_as_float(rr[0]),__uint_as_float(rr[1]));
}
__device__ __forceinline__ void pv(f32x16*o,int vb,bf16x8 pa0,bf16x8 pa1,bf16x8 pa2,bf16x8 pa3){
  #pragma unroll
  for(int d0=0;d0<2;++d0){s16x4 lo[4],hi[4];
    #pragma unroll
    for(int ks=0;ks<4;++ks){
      asm volatile("ds_read_b64_tr_b16 %0,%1 offset:%c2":"=&v"(lo[ks]):"v"(vb),"i"(d0*4096+ks*1024):"memory");
      asm volatile("ds_read_b64_tr_b16 %0,%1 offset:%c2":"=&v"(hi[ks]):"v"(vb),"i"(d0*4096+ks*1024+512):"memory");}
    asm volatile("s_waitcnt lgkmcnt(0)":::"memory");SBAR();
    #define PK(k) (bf16x8){lo[k][0],lo[k][1],lo[k][2],lo[k][3],hi[k][0],hi[k][1],hi[k][2],hi[k][3]}
    o[d0]=__builtin_amdgcn_mfma_f32_32x32x16_bf16(pa0,PK(0),o[d0],0,0,0);
    o[d0]=__builtin_amdgcn_mfma_f32_32x32x16_bf16(pa1,PK(1),o[d0],0,0,0);
    o[d0]=__builtin_amdgcn_mfma_f32_32x32x16_bf16(pa2,PK(2),o[d0],0,0,0);
    o[d0]=__builtin_amdgcn_mfma_f32_32x32x16_bf16(pa3,PK(3),o[d0],0,0,0);
    #undef PK
  }
}

#ifndef ATTN_STORE16
#define ATTN_STORE16(p,v) (*(u32x4*)(p)=(v))
#endif
template<int THRL> __device__ __forceinline__ void attn_unit(int b,int h,int qb,const bf16*Q,const bf16*__restrict__ K,const bf16*__restrict__ V,bf16*O,const float*__restrict__ F2g,const float*__restrict__ gain,char*shm){
  int tid_=threadIdx.x; asm volatile("":"+v"(tid_)); const int tid=tid_,lane=tid&63,r32=lane&31,hi=lane>>5; const int wid=__builtin_amdgcn_readfirstlane(tid>>6);
  const long rowbase=(long)b*SEQ; const int q0=qb*QB;
  const bf16*Qw=Q+(rowbase+q0+wid*QBLK)*DM+h*D;
  const bf16*Kh=K+rowbase*DM+h*D,*Vh=V+rowbase*DM+h*D;
  const lds_cptr shm3=(lds_cptr)shm;
  const unsigned lds0=(unsigned)(uintptr_t)shm;
  float*wsf=(float*)(shm+LDS_WS)+wid*64;
  const bf16*ksrc=Kh+(long)lane*DM+wid*8;
  const bf16*vsrc=Vh+(long)(16*(wid&3)+(lane>>2))*DM+(wid>>2)*32+(lane&3)*8;
  const unsigned kdst=lds0+LDS_K+wid*1024, vdst=lds0+LDS_V+wid*1024;
  #define DMA_K(t,slot) glds16(ksrc+(long)(t)*KVBLK*DM,(unsigned)__builtin_amdgcn_readfirstlane(kdst+(slot)))
  #define DMA_V(t,slot) glds16(vsrc+(long)(t)*KVBLK*DM,(unsigned)__builtin_amdgcn_readfirstlane(vdst+(slot)))
  const int vb0=(int)(lds0+LDS_V)+((lane>>4)&1)*32+(lane&3)*8+(4*hi+((lane&15)>>2))*64;
  const char*Kbase=shm+LDS_K; bf16x8 kf[8];
  const lds_cptr kp0=shm3+LDS_K+hi*1024+r32*16; const lds_cptr vp0=shm3+LDS_V+((lane>>4)&1)*32+(lane&3)*8+(4*hi+((lane&15)>>2))*64;
  const int NT=(q0+QB)/KVBLK;
  { const float*f2src=F2g+((long)b*NHEAD+h)*SEQ; __attribute__((address_space(3))) float*f2l=(__attribute__((address_space(3))) float*)(shm3+LDS_F2);
    for(int i=tid;i<(q0+QB)/4;i+=NW*64){ const f32x4_t v=*(const f32x4_t*)(f2src+4*i); *(__attribute__((address_space(3))) f32x4_t*)(f2l+4*i)=v; } }
  const __attribute__((address_space(3))) float*F2L=(const __attribute__((address_space(3))) float*)(shm3+LDS_F2)+4*hi;
  DMA_K(0,0);DMA_V(0,0);DMA_K(1,SLOTB);
  bf16x8 qr[4];
  #pragma unroll
  for(int d0=0;d0<4;++d0)qr[d0]=*reinterpret_cast<const bf16x8*>(&Qw[(long)r32*DM+d0*16+hi*8]);
  float mhat=0.f,l_reg=0.f;f32x16 o[2];o[0]=f32x16{};o[1]=f32x16{};f32x16 negm=f32x16{};asm volatile("":"+v"(negm));
  const int qrel=wid*QBLK+r32;
  #define CMASK(P0,P1,t) do{int jb_=(t)-(NT-4); if(jb_>=0)cmask(P0,P1,jb_,qrel,hi);}while(0)
  #define BIAS(P0,P1,t) do{ const __attribute__((address_space(3))) float*fb_=F2L+(t)*64; \
    _Pragma("unroll") for(int g_=0;g_<4;++g_){ asm volatile("":::"memory"); const f32x4_t b0_=*(const __attribute__((address_space(3))) f32x4_t*)(fb_+8*g_); const f32x4_t b1_=*(const __attribute__((address_space(3))) f32x4_t*)(fb_+32+8*g_); \
      _Pragma("unroll") for(int e_=0;e_<4;++e_){ P0[4*g_+e_]-=b0_[e_]; P1[4*g_+e_]-=b1_[e_]; } asm volatile("":"+v"(P0),"+v"(P1)::"memory"); } }while(0)
  bool resc=false;
  #define START(P0,P1) do{ const float rm=rowmax(P0,P1); resc=false; \
    { const float dl=rm; mhat=fadd_s(mhat,dl); \
      _Pragma("unroll") for(int r=0;r<16;++r){P0[r]=fsub_s(P0[r],dl);P1[r]=fsub_s(P1[r],dl);} \
      _Pragma("unroll") for(int r=0;r<16;++r)negm[r]=-mhat; asm volatile("":"+v"(negm)); } \
    _Pragma("unroll") for(int r=0;r<16;++r)P0[r]=__builtin_amdgcn_exp2f(P0[r]); }while(0)
  #define RESC() do{ if(resc){ asm volatile("s_waitcnt lgkmcnt(0)":::"memory"); \
      _Pragma("unroll") for(int d_=0;d_<2;++d_) _Pragma("unroll") for(int r=0;r<16;++r)o[d_][r]*=wsf[crow(r,hi)]; } }while(0)
  f32x16 pA0,pA1,pB0,pB1;
  int sl_prev=0,sl_cur=0,sl_next=SLOTB;
  #define ROT() do{sl_prev=sl_cur;sl_cur=sl_next;sl_next=(sl_next==(NSLOT-1)*SLOTB)?0:sl_next+SLOTB;}while(0)
  DMA_K(2,2*SLOTB);
  WAIT_BAR(3);
  qkt(pA0,pA1,Kbase,qr,negm,r32,hi);asm volatile("s_nop 15\n\ts_nop 7":"+v"(pA0),"+v"(pA1));BIAS(pA0,pA1,0);CMASK(pA0,pA1,0);
  START(pA0,pA1);
  _Pragma("unroll") for(int r=0;r<16;++r)pA1[r]=__builtin_amdgcn_exp2f(pA1[r]);
  WAIT_BAR(0);
  DMA_K(3,0);DMA_V(1,SLOTB);
  ROT();
  kload8(kf,kp0+sl_cur);
  WAIT_BAR(2);
  s16x4 vlo[8],vhi[8]; u32x4 pw0,pw1,pw2,pw3;
  #define PKW(P,B) cvtpk_s(P[B],P[B+1])
  #define PAF(k) __builtin_bit_cast(bf16x8,pw##k)
  #define VFR(i) (bf16x8){vlo[i][0],vlo[i][1],vlo[i][2],vlo[i][3],vhi[i][0],vhi[i][1],vhi[i][2],vhi[i][3]}
  #define PIN(x) asm volatile("":"+v"(x))
  #define MX3(a,b,c) __builtin_fmaxf(__builtin_fmaxf((a),(b)),(c))
  #define GAPA(MF,A0,A1,A2,A3,W0,W1,PW) do{ MF; sacc+=A0; sacc+=A1; sacc+=A2; sacc+=A3; PIN(sacc); W0; W1; PIN(PW); SBAR(); }while(0)
  #define EX(v) __builtin_amdgcn_exp2f(v)
  #define GAPB(MF,X,B) do{ MF; X[B]=EX(X[B]); X[B+1]=EX(X[B+1]); X[B+2]=EX(X[B+2]); X[B+3]=EX(X[B+3]); PIN(X); SBAR(); }while(0)
  #define VRD(i) do{ vlo[i]=vtr(vp_+(((i)>>2)*4096+((i)&3)*1024)); vhi[i]=vtr(vp_+(((i)>>2)*4096+((i)&3)*1024+512)); }while(0)
  #define KRD(G,j) do{ if(G){ kload2(kf,kp0+sl_next,j); SBAR(); } }while(0)
  #define STEP(C0,C1,P0,P1,t,GK,GV,GL) do{ SBAR(); \
    const lds_cptr vp_=vp0+sl_prev; \
    VRD(0); SBAR(); float sacc=(P0[0]+P0[1]); \
    GAPA(C0=__builtin_amdgcn_mfma_f32_32x32x16_bf16(kf[0],qr[0],negm,0,0,0), P0[2],P0[3],P0[4],P0[5],     pw0[0]=PKW(P0,0), pw0[1]=PKW(P0,2), pw0); \
    VRD(4); SBAR(); GAPA(C1=__builtin_amdgcn_mfma_f32_32x32x16_bf16(kf[1],qr[0],negm,0,0,0), P0[6],P0[7],P0[8],P0[9],     pw0[2]=PKW(P0,4), pw0[3]=PKW(P0,6), pw0); \
    VRD(1); SBAR(); GAPA(C0=__builtin_amdgcn_mfma_f32_32x32x16_bf16(kf[2],qr[1],C0,0,0,0),   P0[10],P0[11],P0[12],P0[13], pw1[0]=PKW(P0,8), pw1[1]=PKW(P0,10), pw1); \
    VRD(5); SBAR(); GAPA(C1=__builtin_amdgcn_mfma_f32_32x32x16_bf16(kf[3],qr[1],C1,0,0,0),   P0[14],P0[15],P1[0],P1[1],   pw1[2]=PKW(P0,12),pw1[3]=PKW(P0,14), pw1); \
    VRD(2); SBAR(); GAPA(C0=__builtin_amdgcn_mfma_f32_32x32x16_bf16(kf[4],qr[2],C0,0,0,0),   P1[2],P1[3],P1[4],P1[5],     pw2[0]=PKW(P1,0), pw2[1]=PKW(P1,2), pw2); \
    VRD(6); SBAR(); GAPA(C1=__builtin_amdgcn_mfma_f32_32x32x16_bf16(kf[5],qr[2],C1,0,0,0),   P1[6],P1[7],P1[8],P1[9],     pw2[2]=PKW(P1,4), pw2[3]=PKW(P1,6), pw2); \
    VRD(3); SBAR(); GAPA(C0=__builtin_amdgcn_mfma_f32_32x32x16_bf16(kf[6],qr[3],C0,0,0,0),   P1[10],P1[11],P1[12],P1[13], pw3[0]=PKW(P1,8), pw3[1]=PKW(P1,10), pw3); \
    VRD(7); SBAR(); GAPA(C1=__builtin_amdgcn_mfma_f32_32x32x16_bf16(kf[7],qr[3],C1,0,0,0),   P1[14],P1[15],0.f,0.f,       pw3[2]=PKW(P1,12),pw3[3]=PKW(P1,14), pw3); \
    l_reg+=sacc; \
    if(GK){DMA_K((t)+3,sl_cur);} if(GV){DMA_V((t)+1,sl_next);} \
    BIAS(C0,C1,t); CMASK(C0,C1,t); \
    { float a=MX3(C0[0],C0[1],C1[0]),b=MX3(C0[2],C0[3],C1[1]); a=MX3(a,C1[2],C1[3]); \
      _Pragma("unroll") for(int r=4;r<16;r+=4){a=MX3(a,C0[r],C0[r+1]);b=MX3(b,C0[r+2],C0[r+3]);a=MX3(a,C1[r],C1[r+1]);b=MX3(b,C1[r+2],C1[r+3]);} \
      float rm=__builtin_fmaxf(a,b); { auto rr=__builtin_amdgcn_permlane32_swap(__float_as_uint(rm),__float_as_uint(rm),false,false); rm=__builtin_fmaxf(__uint_as_float(rr[0]),__uint_as_float(rr[1])); } \
      resc=false; \
      if(__builtin_expect(__any(rm>(float)THRL),0)){ const float dl=__builtin_fmaxf(rm,0.f); mhat+=dl; \
        _Pragma("unroll") for(int r=0;r<16;++r){C0[r]-=dl;C1[r]-=dl;} \
        _Pragma("unroll") for(int r=0;r<16;++r)negm[r]=-mhat; asm volatile("":"+v"(negm)); \
        const float f=__builtin_amdgcn_exp2f(-dl); l_reg*=f; if(hi==0)wsf[r32]=f; resc=true; } } \
    SBAR(); \
    GAPB(o[0]=__builtin_amdgcn_mfma_f32_32x32x16_bf16(PAF(0),VFR(0),o[0],0,0,0), C0,0); \
    GAPB(o[1]=__builtin_amdgcn_mfma_f32_32x32x16_bf16(PAF(0),VFR(4),o[1],0,0,0), C0,4); \
    KRD(GL,0); GAPB(o[0]=__builtin_amdgcn_mfma_f32_32x32x16_bf16(PAF(1),VFR(1),o[0],0,0,0), C0,8); \
    KRD(GL,1); GAPB(o[1]=__builtin_amdgcn_mfma_f32_32x32x16_bf16(PAF(1),VFR(5),o[1],0,0,0), C0,12); \
    KRD(GL,2); GAPB(o[0]=__builtin_amdgcn_mfma_f32_32x32x16_bf16(PAF(2),VFR(2),o[0],0,0,0), C1,0); \
    KRD(GL,3); GAPB(o[1]=__builtin_amdgcn_mfma_f32_32x32x16_bf16(PAF(2),VFR(6),o[1],0,0,0), C1,4); \
    GAPB(o[0]=__builtin_amdgcn_mfma_f32_32x32x16_bf16(PAF(3),VFR(3),o[0],0,0,0), C1,8); \
    GAPB(o[1]=__builtin_amdgcn_mfma_f32_32x32x16_bf16(PAF(3),VFR(7),o[1],0,0,0), C1,12); \
    }while(0)
  int t=1;
  #undef CMASK
  #define CMASK(P0,P1,t) do{}while(0)
  for(;t+5<NT;t+=2){
    STEP(pB0,pB1,pA0,pA1,t,true,true,true);     WAIT_BAR(2); RESC(); ROT();
    STEP(pA0,pA1,pB0,pB1,t+1,true,true,true);   WAIT_BAR(2); RESC(); ROT();
  }
  #undef CMASK
  #define CMASK(P0,P1,t) do{int jb_=(t)-(NT-4); if(jb_>=0)cmask(P0,P1,jb_,qrel,hi);}while(0)
  #define ENDW(tt) do{ if((tt)+3<NT){WAIT_BAR(2);} else if((tt)+2<NT){WAIT_BAR(1);} else {WAIT_BAR(0);} }while(0)
  for(;t+1<NT;t+=2){
    STEP(pB0,pB1,pA0,pA1,t,(t+3<NT),(t+1<NT),(t+1<NT));       ENDW(t);   RESC(); ROT();
    STEP(pA0,pA1,pB0,pB1,t+1,(t+4<NT),(t+2<NT),(t+2<NT));     ENDW(t+1); RESC(); ROT();
  }
  STEP(pB0,pB1,pA0,pA1,NT-1,false,false,false); RESC();
  { float sacc=pB0[0]+pB0[1]; _Pragma("unroll") for(int r=2;r<16;++r)sacc+=pB0[r]; _Pragma("unroll") for(int r=0;r<16;++r)sacc+=pB1[r]; l_reg+=sacc;
    pw0=(u32x4){PKW(pB0,0),PKW(pB0,2),PKW(pB0,4),PKW(pB0,6)};pw1=(u32x4){PKW(pB0,8),PKW(pB0,10),PKW(pB0,12),PKW(pB0,14)};pw2=(u32x4){PKW(pB1,0),PKW(pB1,2),PKW(pB1,4),PKW(pB1,6)};pw3=(u32x4){PKW(pB1,8),PKW(pB1,10),PKW(pB1,12),PKW(pB1,14)};
    SBAR(); pv(o,vb0+sl_cur,PAF(0),PAF(1),PAF(2),PAF(3)); }
  #undef PKW
  #undef PAF
  #undef VFR
  #undef PIN
  #undef MX3
  #undef GAPA
  #undef GAPB
  #undef EX
  #undef VRD
  #undef KRD
  #undef STEP
  #undef ENDW
  {auto rr=__builtin_amdgcn_permlane32_swap(__float_as_uint(l_reg),__float_as_uint(l_reg),false,false);l_reg=__uint_as_float(rr[0])+__uint_as_float(rr[1]);}
  if(hi==0)wsf[32+r32]=l_reg;asm volatile("s_waitcnt lgkmcnt(0)":::"memory");
  float rli[16];
  #pragma unroll
  for(int r=0;r<16;++r)rli[r]=__builtin_amdgcn_rcpf(wsf[32+crow(r,hi)]);
  bf16*Ow=O+(rowbase+q0+wid*QBLK)*DO+h*D;
  { bf16*stg=(bf16*)(shm+LDS_OST)+wid*2048;
    #pragma unroll
    for(int r=0;r<16;++r){const int orow=crow(r,hi);
      #pragma unroll
      for(int d0=0;d0<2;++d0)stg[orow*64+d0*32+r32]=__float2bfloat16(o[d0][r]*rli[r]);}
    asm volatile("s_waitcnt lgkmcnt(0)":::"memory");
    const f32x4_t g0=*(const f32x4_t*)(gain+h*D+(lane&7)*8), g1=*(const f32x4_t*)(gain+h*D+(lane&7)*8+4);
    #pragma unroll
    for(int i=0;i<4;++i){const int row=i*8+(lane>>3),ch=lane&7; const u32x4 v=*(const u32x4*)(stg+row*64+ch*8);
      float x[8];
      #pragma unroll
      for(int e=0;e<4;++e){ x[2*e]=__uint_as_float(v[e]<<16); x[2*e+1]=__uint_as_float(v[e]&0xffff0000u); }
      float ss=0.f;
      #pragma unroll
      for(int e=0;e<8;++e)ss+=x[e]*x[e];
      ss+=__int_as_float(__builtin_amdgcn_ds_bpermute((lane^1)<<2,__float_as_int(ss))); ss+=__int_as_float(__builtin_amdgcn_ds_bpermute((lane^2)<<2,__float_as_int(ss))); ss+=__int_as_float(__builtin_amdgcn_ds_bpermute((lane^4)<<2,__float_as_int(ss)));
      const float rs=rsqrtf(ss*(1.0f/64.0f)+1e-6f);
      u32x4 w; w[0]=cvtpk_s(x[0]*rs*g0[0],x[1]*rs*g0[1]); w[1]=cvtpk_s(x[2]*rs*g0[2],x[3]*rs*g0[3]); w[2]=cvtpk_s(x[4]*rs*g1[0],x[5]*rs*g1[1]); w[3]=cvtpk_s(x[6]*rs*g1[2],x[7]*rs*g1[3]);
      ATTN_STORE16(Ow+(long)row*DO+ch*8,w);} }
  asm volatile("s_waitcnt lgkmcnt(0)\n\ts_barrier":::"memory");
  #undef DMA_K
  #undef DMA_V
  #undef CMASK
  #undef START
  #undef RESC
  #undef ROT
}
constexpr int ATTN_LDS_BYTES=LDS_BYTES;
struct AttnTensors { const bf16* Q; const bf16* K; const bf16* V; bf16* O; const float* F2; const float* gain; };
struct AttnUnit { int bh; int qb; };
struct StaticOrder {
  int vcu, G;
  __device__ __forceinline__ explicit StaticOrder(int grid,int block):vcu((grid%8==0)?(block%8)*(grid/8)+block/8:block),G(grid){}
  __device__ __forceinline__ bool next(int i,AttnUnit&u)const{ const int pair=vcu+(i>>1)*G; if(pair>=256)return false; const int s=pair&15; u.bh=pair>>4; u.qb=(i&1)?31-s:s; return true; }
  __device__ __forceinline__ void a_ready(const AttnUnit&)const{}
  __device__ __forceinline__ void done(const AttnUnit&)const{}
};
template<class Sched,int THRL=8> __device__ __forceinline__ void attn_phase(char*lds,const AttnTensors&T,const Sched&S){
  AttnUnit u;
  for(int i=0;S.next(i,u);++i){ S.a_ready(u); attn_unit<THRL>(u.bh/NHEAD,u.bh%NHEAD,u.qb,T.Q,T.K,T.V,T.O,T.F2,T.gain,lds); S.done(u); }
}
#undef SBAR
#undef WAIT_BAR
}
#define GAS __attribute__((address_space(1)))
#define LAS __attribute__((address_space(3)))
typedef unsigned short bf16;
typedef unsigned v4u __attribute__((ext_vector_type(4)));
typedef float f32x4 __attribute__((ext_vector_type(4)));
typedef short bf16x8 __attribute__((ext_vector_type(8)));
typedef GAS unsigned gu32;
typedef GAS unsigned long long gu64;
#define RLX_AGENT __ATOMIC_RELAXED, __HIP_MEMORY_SCOPE_AGENT
#define LDS_WAIT() asm volatile("s_waitcnt lgkmcnt(0)" ::: "memory")
#define VM_WAIT() asm volatile("s_waitcnt vmcnt(0)" ::: "memory")
__device__ __forceinline__ unsigned long long rt() { return __builtin_amdgcn_s_memrealtime(); }
__device__ __forceinline__ unsigned f2bf(float f) { unsigned u = __builtin_bit_cast(unsigned, f); return (u + 0x7fffu + ((u >> 16) & 1u)) >> 16; }
__device__ __forceinline__ unsigned pk2(float lo, float hi) { return f2bf(lo) | (f2bf(hi) << 16); }

#define XB_TMO      128
#define XB_XCNT(j)  (256  + 64 * (j))
#define XB_XSUB(j)  (1280 + 64 * (j))
#define XB_XGEN(j)  (2304 + 64 * (j))
#define XB_TOP      3328
#define XB_TOPGEN   3392
#define XCD_BAR_WORDS 3456
#define XB_SPIN_CAP (1u << 18)
#ifndef XB_SCOPE
#define XB_SCOPE ""
#endif

__device__ __forceinline__ unsigned xb_ld(unsigned* p)              { return __hip_atomic_load(p, __ATOMIC_RELAXED, __HIP_MEMORY_SCOPE_AGENT); }
__device__ __forceinline__ unsigned xb_add(unsigned* p, unsigned v) { return __hip_atomic_fetch_add(p, v, __ATOMIC_RELAXED, __HIP_MEMORY_SCOPE_AGENT); }
__device__ __forceinline__ unsigned xb_xcc_id() { return (unsigned)__builtin_amdgcn_s_getreg((3 << 11) | 20) & 0xFu; }
#define XB_SPIN(cond, bar) do { unsigned _sp = 0; while (cond) { __builtin_amdgcn_s_sleep(1); \
    if ((++_sp & 255u) == 0u) { if (xb_ld(&(bar)[XB_TMO])) break; if (_sp > XB_SPIN_CAP) { atomicAdd(&(bar)[XB_TMO], 1u); break; } } } } while (0)

struct XcdBarrier {
    unsigned* bar; unsigned x;
    volatile LAS unsigned* st;
};

__device__ __forceinline__ XcdBarrier xcd_barrier_post(unsigned* bar, volatile LAS unsigned* st) {
    XcdBarrier b; b.bar = bar; b.x = xb_xcc_id(); b.st = st;
    if (threadIdx.x == 0) (void)xb_add(&bar[XB_XCNT(b.x)], 1u);
    return b;
}
__device__ __forceinline__ void xcd_barrier_complete(unsigned* bar, unsigned x, unsigned& nloc, unsigned& nx) {
    const unsigned G = gridDim.x * gridDim.y * gridDim.z;
    unsigned sum, cnt, mine, sp = 0u;
    for (;;) {
        sum = 0u; cnt = 0u; mine = 0u;
#pragma unroll
        for (unsigned j = 0; j < 16; ++j) { const unsigned c = xb_ld(&bar[XB_XCNT(j)]); sum += c; cnt += (c > 0u) ? 1u : 0u; mine = (j == x) ? c : mine; }
        if (sum == G) break;
        __builtin_amdgcn_s_sleep(1);
        if ((++sp & 255u) == 0u) { if (xb_ld(&bar[XB_TMO])) break; if (sp > XB_SPIN_CAP) { atomicAdd(&bar[XB_TMO], 1u); break; } }
    }
    nloc = mine > 0u ? mine : 1u; nx = cnt > 0u ? cnt : 1u;
}

__device__ __forceinline__ void xcd_barrier(const XcdBarrier& b) {
    asm volatile("s_waitcnt vmcnt(0)" ::: "memory");
    __syncthreads();
    if (threadIdx.x == 0) {
        unsigned* bar = b.bar;
        __builtin_amdgcn_s_waitcnt(0);
        unsigned nloc = b.st[0], nx = b.st[1];
        if (nloc == 0u) { xcd_barrier_complete(bar, b.x, nloc, nx); b.st[0] = nloc; b.st[1] = nx; }
        const unsigned old = xb_add(&bar[XB_XSUB(b.x)], 1u);
        const unsigned gen = old / nloc;
        if (old + 1u == (gen + 1u) * nloc) {
            __builtin_amdgcn_fence(__ATOMIC_RELEASE, XB_SCOPE);
            asm volatile("s_waitcnt vmcnt(0)" ::: "memory");
            const unsigned og = xb_add(&bar[XB_TOP], 1u);
            const unsigned tg = og / nx;
            if (og + 1u == (tg + 1u) * nx) xb_add(&bar[XB_TOPGEN], 1u);
            else XB_SPIN(xb_ld(&bar[XB_TOPGEN]) == tg, bar);
            __builtin_amdgcn_fence(__ATOMIC_ACQUIRE, XB_SCOPE);
            xb_add(&bar[XB_XGEN(b.x)], 1u);
            asm volatile("s_waitcnt vmcnt(0)" ::: "memory");
        } else {
            XB_SPIN(xb_ld(&bar[XB_XGEN(b.x)]) == gen, bar);
            __builtin_amdgcn_fence(__ATOMIC_ACQUIRE, XB_SCOPE);
            asm volatile("s_waitcnt vmcnt(0)" ::: "memory");
        }
    }
    __syncthreads();
}

constexpr int NWAVES = 8;
constexpr int T = 32768, D = 1024, SEQ = 8192, NBATCH = 4, NLAYER = 4, CHUNK = 128, NCHUNK = T / CHUNK, CPB = SEQ / CHUNK;
constexpr int DINP = 3344, PP = 3328, NPROJ_T = 3584;
constexpr int O_AQ = 0, O_AK = 256, O_AV = 512, O_SU = 768, O_SV = 1024, O_MZ = 1280, O_LQ = 2304, O_LK = 2560, O_LV = 2816, O_LO = 3072;
constexpr int O_XBC = 1536;
constexpr int XC = 768;
constexpr int NEXP = 32, DEXP = 512, MOE_TILES = 288, MOE_ROWS = MOE_TILES * 256;
constexpr float NORM_EPS = 1e-6f;
constexpr float ATT_C2 = 0.125f * 1.4426950408889634f;
constexpr float LOG2E = 1.4426950408889634f;

constexpr size_t MiB = 1u << 20;
constexpr size_t WS_CTL = 0, CTL_ZERO_BYTES = 1 * MiB;
constexpr size_t WS_MOD = 1 * MiB;
constexpr size_t WS_F2 = 2 * MiB;
constexpr size_t WS_SMALL = 3 * MiB;
constexpr size_t WS_TOK = 4 * MiB;
constexpr size_t WS_GATES = 5 * MiB;
constexpr size_t WS_WR = 7 * MiB;
constexpr size_t WS_WIN = 8 * MiB;
constexpr size_t WS_WOUT = 15 * MiB;
constexpr size_t WS_WGU = 17 * MiB;
constexpr size_t WS_WDN = 81 * MiB;
constexpr size_t WS_H = 113 * MiB;
constexpr size_t WS_PROJ = 177 * MiB;
constexpr size_t WS_Y = 385 * MiB;
constexpr size_t WS_XBCC = 449 * MiB;
constexpr size_t WS_SST = 497 * MiB;
constexpr size_t WS_SHIN = 529 * MiB;
constexpr size_t WS_MLS = 545 * MiB;
constexpr size_t WS_MLC = 565 * MiB;
constexpr size_t WS_XB = 575 * MiB;
constexpr size_t WS_ACT = 719 * MiB;
constexpr size_t WS_YB = 791 * MiB;
constexpr size_t WS_XDT = 935 * MiB;
constexpr size_t WS_END = 985 * MiB;
constexpr int CW_TMO = 0, CW_BAR = 4096;
constexpr int RING_BYTES = 131072, MISC_OFF = RING_BYTES + 320, LDS_BYTES = 147456;

#define DI __device__ __forceinline__
typedef unsigned v2u __attribute__((ext_vector_type(2)));
namespace pg8 {
struct EpiProj { static constexpr bool PERM = true, AFTER_DRAIN = false;
    bf16_t* P; float* G;
    __device__ __forceinline__ void operator()(const f32x4 (&acc)[2][2][4][2], const Unit& u, int wr, int wc, int fr, int fq) const {
        const int row0 = u.pm * BM + wr * 64 + fr;
        if (u.pn < 13) {
            const int col0 = u.pn * BM + wc * 32 + 8 * fq;
#pragma unroll
            for (int ai = 0; ai < 2; ++ai)
#pragma unroll
                for (int m = 0; m < 4; ++m) { bf16_t* rowp = P + (size_t)(row0 + ai * HALF + m * 16) * 3328 + col0;
#pragma unroll
                    for (int bj = 0; bj < 2; ++bj) { const f32x4 v0 = acc[ai][bj][m][0], v1 = acc[ai][bj][m][1];
                        u32x4 w; w.x = cvt_pk_bf16(v0[0], v0[1]); w.y = cvt_pk_bf16(v0[2], v0[3]); w.z = cvt_pk_bf16(v1[0], v1[1]); w.w = cvt_pk_bf16(v1[2], v1[3]);
                        *(u32x4*)(rowp + bj * HALF) = w; } }
        } else if (wc == 0 && fq < 2) {
#pragma unroll
            for (int ai = 0; ai < 2; ++ai)
#pragma unroll
                for (int m = 0; m < 4; ++m) { float* gp = G + (size_t)(row0 + ai * HALF + m * 16) * 16 + 8 * fq;
                    *(f32x4*)(gp) = acc[ai][0][m][0]; *(f32x4*)(gp + 4) = acc[ai][0][m][1]; }
        }
    }
};
struct EpiOut { static constexpr bool PERM = false, AFTER_DRAIN = false;
    float* X; const float* gate;
    __device__ __forceinline__ void operator()(const f32x4 (&acc)[2][2][4][2], const Unit& u, int wr, int wc, int fr, int fq) const {
        const int row0 = u.pm * BM + wr * 64 + fr, col0 = u.pn * BM + wc * 32 + 4 * fq;
        const float* gb = gate + (size_t)((u.pm * BM) >> 13) * 6144 + col0;
        f32x4 gv[2][2];
#pragma unroll
        for (int bj = 0; bj < 2; ++bj)
#pragma unroll
            for (int n = 0; n < 2; ++n) gv[bj][n] = *(const f32x4*)(gb + bj * HALF + n * 16);
#pragma unroll
        for (int ai = 0; ai < 2; ++ai)
#pragma unroll
            for (int m = 0; m < 4; ++m) { float* rowp = X + (size_t)(row0 + ai * HALF + m * 16) * 1024 + col0;
#pragma unroll
                for (int bj = 0; bj < 2; ++bj)
#pragma unroll
                    for (int n = 0; n < 2; ++n) { f32x4 x = *(const f32x4*)(rowp + bj * HALF + n * 16); x = x + gv[bj][n] * acc[ai][bj][m][n]; *(f32x4*)(rowp + bj * HALF + n * 16) = x; } }
    }
};
struct EpiGU { static constexpr bool PERM = true, AFTER_DRAIN = false;
    bf16_t* A;
    __device__ __forceinline__ void operator()(const f32x4 (&acc)[2][2][4][2], const Unit& u, int wr, int wc, int fr, int fq) const {
        const int row0 = u.pm * BM + wr * 64 + fr, col0 = (u.pn & 3) * 128 + wc * 16 + 4 * fq;
#pragma unroll
        for (int ai = 0; ai < 2; ++ai)
#pragma unroll
            for (int m = 0; m < 4; ++m) { bf16_t* rowp = A + (size_t)(row0 + ai * HALF + m * 16) * 512 + col0;
#pragma unroll
                for (int bj = 0; bj < 2; ++bj) { const f32x4 g = acc[ai][bj][m][0], up = acc[ai][bj][m][1]; f32x4 a;
#pragma unroll
                    for (int e = 0; e < 4; ++e) a[e] = g[e] / (1.f + __expf(-g[e])) * up[e];
                    typedef unsigned u32x2 __attribute__((ext_vector_type(2)));
                    u32x2 w; w.x = cvt_pk_bf16(a[0], a[1]); w.y = cvt_pk_bf16(a[2], a[3]);
                    *(u32x2*)(rowp + bj * 64) = w; } }
    }
};
struct EpiDown { static constexpr bool PERM = true, AFTER_DRAIN = false;
    bf16_t* Yb;
    __device__ __forceinline__ void operator()(const f32x4 (&acc)[2][2][4][2], const Unit& u, int wr, int wc, int fr, int fq) const {
        const int row0 = u.pm * BM + wr * 64 + fr, col0 = (u.pn & 3) * BM + wc * 32 + 8 * fq;
#pragma unroll
        for (int ai = 0; ai < 2; ++ai)
#pragma unroll
            for (int m = 0; m < 4; ++m) { bf16_t* rowp = Yb + (size_t)(row0 + ai * HALF + m * 16) * 1024 + col0;
#pragma unroll
                for (int bj = 0; bj < 2; ++bj) { const f32x4 v0 = acc[ai][bj][m][0], v1 = acc[ai][bj][m][1];
                    u32x4 w; w.x = cvt_pk_bf16(v0[0], v0[1]); w.y = cvt_pk_bf16(v0[2], v0[3]); w.z = cvt_pk_bf16(v1[0], v1[1]); w.w = cvt_pk_bf16(v1[2], v1[3]);
                    *(u32x4*)(rowp + bj * HALF) = w; } }
    }
};
struct MoeOrder {
    int nunits, G, c; const PG8_LAS int* ts;
    __device__ __forceinline__ bool next(int i, Unit& u) const {
        const int L = i * G + c; if (L >= nunits) return false;
        const int rt = L >> 2; int e = 0;
        for (int k = 1; k < 32; ++k) e += (ts[k] <= rt) ? 1 : 0;
        u.pm = rt; u.pn = 4 * e + (L & 3); return true;
    }
    __device__ __forceinline__ void a_ready(const Unit&) const {}
    __device__ __forceinline__ void done(const Unit&) const {}
};
}

DI float bf2f(unsigned b) { return __uint_as_float(b << 16); }
DI float silu_f(float x) { return x / (1.f + __expf(-x)); }
DI float sigmoid_f(float x) { return 1.f / (1.f + __expf(-x)); }
DI float gelu_tanh_f(float x) { const float z = 0.7978845608028654f * (x + 0.044715f * x * x * x); return x / (1.f + __expf(-2.f * z)); }
DI float log_sigmoid_f(float x) { return fminf(x, 0.f) - log1pf(__expf(-fabsf(x))); }
DI float softplus_f(float x) { return fmaxf(x, 0.f) + log1pf(__expf(-fabsf(x))); }
DI float shx(float v, int o, int lane) { return __int_as_float(__builtin_amdgcn_ds_bpermute((lane ^ o) << 2, __float_as_int(v))); }
DI float shup(float v, int o, int lane) { return __int_as_float(__builtin_amdgcn_ds_bpermute(((lane - o) & 63) << 2, __float_as_int(v))); }
DI float shidx(float v, int src) { return __int_as_float(__builtin_amdgcn_ds_bpermute(src << 2, __float_as_int(v))); }
DI float wave_sum(float v, int lane) {
#pragma unroll
    for (int o = 1; o < 64; o <<= 1) v += shx(v, o, lane);
    return v;
}
DI f32x4 mfma16(bf16x8 a, bf16x8 b, f32x4 c) { return __builtin_amdgcn_mfma_f32_16x16x32_bf16(a, b, c, 0, 0, 0); }
#define GL_PIN(x) asm volatile("s_nop 4" : "+v"(x))
DI void unpack8(const v4u w, float (&x)[8]) {
#pragma unroll
    for (int e = 0; e < 4; ++e) { x[2 * e] = __uint_as_float(w[e] << 16); x[2 * e + 1] = __uint_as_float(w[e] & 0xffff0000u); }
}

struct Frame {
    LAS unsigned char* lds;
    volatile LAS unsigned* MISC;
    gu32* ctl;
    int tid, lane, wave, vcu, G, bx, l; size_t z;
    float* out; unsigned char* ws;
};
constexpr int PTRTAB_OFF = 131072 + 2048;
DI const float* inp(const Frame& F, int i) {
    const LAS unsigned* t = (const LAS unsigned*)(F.lds + PTRTAB_OFF) + 2 * i;
    const unsigned lo = __builtin_amdgcn_readfirstlane(t[0]), hi = __builtin_amdgcn_readfirstlane(t[1]);
    return (const float*)(const GAS float*)(((unsigned long long)hi << 32) | lo);
}
enum { I_X = 0, I_C, I_WIN, I_WOUT, I_MIXG, I_AFB, I_SGW, I_SGB, I_CONVW, I_CONVB, I_DTB, I_ALOG, I_DSKIP, I_IB, I_FB, I_WADA, I_BADA, I_WN1, I_WN2, I_WRG, I_BRG, I_WRE, I_BRE, I_WEG, I_WEU, I_WED, I_WNF };

DI void refresh(Frame& F) { int t_ = F.tid; asm volatile("" : "+v"(t_)); F.tid = t_; F.lane = t_ & 63; F.wave = __builtin_amdgcn_readfirstlane(t_ >> 6); size_t z_ = 0; unsigned zl_ = 0; asm volatile("" : "+s"(z_), "+s"(zl_)); F.ws = F.ws + z_; F.lds = F.lds + zl_; }
DI void tile_g2l(LAS bf16* dst, int lp, const bf16* src, size_t gp, int rows, int cols, int tid) {
    const int cpr = cols >> 3, n = rows * cpr;
    for (int i = tid; i < n; i += NWAVES * 64) { const int r = i / cpr, c = (i % cpr) * 8; *(LAS v4u*)(dst + r * lp + c) = *(const v4u*)(src + (size_t)r * gp + c); }
}
DI void tile_l2g(bf16* dst, size_t gp, const LAS bf16* src, int lp, int rows, int cols, int tid) {
    const int cpr = cols >> 3, n = rows * cpr;
    for (int i = tid; i < n; i += NWAVES * 64) { const int r = i / cpr, c = (i % cpr) * 8; *(v4u*)(dst + (size_t)r * gp + c) = *(const LAS v4u*)(src + r * lp + c); }
}
template <bool IS_MAX> DI float scan128(float x, int tid, LAS float* red) {
    const int lane = tid & 63;
#pragma unroll
    for (int o = 1; o < 64; o <<= 1) { const float y = shup(x, o, lane); if (lane >= o) x = IS_MAX ? fmaxf(x, y) : x + y; }
    if (tid == 63) red[0] = x;
    __syncthreads();
    if (tid >= 64 && tid < 128) { const float p = red[0]; x = IS_MAX ? fmaxf(x, p) : x + p; }
    __syncthreads();
    return x;
}

DI void p_mod(Frame& F) {
    LAS float* SC = (LAS float*)F.lds;
    LAS float* RED = SC + 4096;
    const float* c = inp(F, I_C);
    for (int i = F.tid; i < 4096; i += 512) SC[i] = silu_f(c[i]);
    __syncthreads();
    float* mod = (float*)(F.ws + WS_MOD);
    const int jj = F.tid & 63, kg = F.tid >> 6;
    for (int u = F.bx; u < NLAYER * 96; u += F.G) {
        const int l = u / 96, j0 = (u % 96) * 64;
        const float* w = inp(F, I_WADA) + ((size_t)l * 1024 + kg * 128) * 6144 + j0 + jj;
        float a0 = 0.f, a1 = 0.f, a2 = 0.f, a3 = 0.f;
#pragma unroll 8
        for (int k = 0; k < 128; ++k) { const float wv = w[(size_t)k * 6144]; const int kk = kg * 128 + k; a0 += SC[kk] * wv; a1 += SC[1024 + kk] * wv; a2 += SC[2048 + kk] * wv; a3 += SC[3072 + kk] * wv; }
        RED[(kg * 4 + 0) * 64 + jj] = a0; RED[(kg * 4 + 1) * 64 + jj] = a1; RED[(kg * 4 + 2) * 64 + jj] = a2; RED[(kg * 4 + 3) * 64 + jj] = a3;
        __syncthreads();
        if (F.tid < 256) { const int b = F.tid >> 6; float s = inp(F, I_BADA)[(size_t)l * 6144 + j0 + jj];
#pragma unroll
            for (int g = 0; g < 8; ++g) s += RED[(g * 4 + b) * 64 + jj];
            mod[((size_t)l * 4 + b) * 6144 + j0 + jj] = s; }
        __syncthreads();
    }
}

DI void tr_item(const float* colp, size_t N, bf16* WT, int d0, int K, int k0, LAS float* scr, int lane, float wscale = 1.f) {
#pragma unroll 8
    for (int i = 0; i < 32; ++i) { const int kk = 2 * i + (lane >> 5); scr[kk * 33 + (lane & 31)] = colp ? colp[(size_t)(k0 + kk) * N] * wscale : 0.f; }
    LDS_WAIT(); asm volatile("" ::: "memory");
    const int c = lane & 7;
#pragma unroll
    for (int j = 0; j < 4; ++j) { const int n = (lane >> 3) + 8 * j; const LAS float* s = scr + (8 * c) * 33 + n;
        v4u o; o.x = pk2(s[0 * 33], s[1 * 33]); o.y = pk2(s[2 * 33], s[3 * 33]); o.z = pk2(s[4 * 33], s[5 * 33]); o.w = pk2(s[6 * 33], s[7 * 33]);
        *(GAS v4u*)(WT + (size_t)(d0 + n) * K + k0 + 8 * c) = o; }
    LDS_WAIT(); asm volatile("" ::: "memory");
}
constexpr int CV_IN = 13 * 8 * 16, CV_INS = 16, CV_OUT = 512, CV_R = 32, CV_DENSE = CV_IN + CV_INS + CV_OUT + CV_R, CV_GU = 32 * 512, CV_DN = 32 * 256, CV_EXP = CV_GU + CV_DN;
DI void p_convert(Frame& F, int l, bool dense, bool experts) {
    LAS float* scr = (LAS float*)(F.lds + F.wave * 16384);
    const int gw = F.vcu * NWAVES + F.wave, NGW = F.G * NWAVES, li = F.lane & 31;
    const int n0 = dense ? 0 : CV_DENSE, n1 = experts ? CV_DENSE + CV_EXP : CV_DENSE;
    for (int it = n0 + gw; it < n1; it += NGW) {
        int r = it;
        if (r < CV_IN) { const int tile = r >> 7, blk = (r >> 4) & 7, kb = r & 15;
            const int so = tile == 0 ? 0 : tile == 1 ? 256 : tile == 2 ? 512 : tile == 3 ? 772 : tile == 4 ? 1028 : tile == 5 ? 1284 : tile == 6 ? 1540 : tile == 7 ? 1796 : tile == 8 ? 2052 : tile == 9 ? 2312 : tile == 10 ? 2568 : tile == 11 ? 2824 : 3080;
            tr_item(inp(F, I_WIN) + (size_t)l * 1024 * DINP + so + blk * 32 + li, DINP, (bf16*)(F.ws + WS_WIN), tile * 256 + blk * 32, 1024, kb * 64, scr, F.lane, tile == 0 ? ATT_C2 : 1.f); continue; }
        r -= CV_IN;
        if (r < CV_INS) { const int col = li < 4 ? 768 + li : li < 8 ? 2308 + (li - 4) : li < 12 ? 3336 + (li - 8) : li < 16 ? 3340 + (li - 12) : -1;
            tr_item(col >= 0 ? inp(F, I_WIN) + (size_t)l * 1024 * DINP + col : nullptr, DINP, (bf16*)(F.ws + WS_WIN), 3328, 1024, r * 64, scr, F.lane); continue; }
        r -= CV_INS;
        if (r < CV_OUT) { const int blk = r >> 4, kb = r & 15;
            tr_item(inp(F, I_WOUT) + (size_t)l * 1024 * 1024 + blk * 32 + li, 1024, (bf16*)(F.ws + WS_WOUT), blk * 32, 1024, kb * 64, scr, F.lane); continue; }
        r -= CV_OUT;
        if (r < CV_R) { const int blk = r >> 4, kb = r & 15, row = blk * 32 + li;
            const float* cp = row < 4 ? inp(F, I_WRG) + (size_t)l * 1024 * 4 + row : row < 36 ? inp(F, I_WRE) + (size_t)l * 1024 * 32 + (row - 4) : nullptr;
            tr_item(cp, row < 4 ? 4 : 32, (bf16*)(F.ws + WS_WR), blk * 32, 1024, kb * 64, scr, F.lane); continue; }
        r -= CV_R;
        if (r < CV_GU) { const int e = r >> 9, blk = (r >> 4) & 31, kb = r & 15, rr = blk * 32 + li, j = rr >> 8, cc = rr & 255;
            const int which = (cc >> 2) & 1, uu = 128 * j + 64 * (cc >> 7) + ((cc & 127) >> 3) * 4 + (cc & 3);
            tr_item((which ? inp(F, I_WEU) : inp(F, I_WEG)) + ((size_t)(l * 32 + e) * 1024) * 512 + uu, 512, (bf16*)(F.ws + WS_WGU) + (size_t)e * 1024 * 1024, blk * 32, 1024, kb * 64, scr, F.lane); continue; }
        r -= CV_GU;
        { const int e = r >> 8, blk = (r >> 3) & 31, kb = r & 7;
            tr_item(inp(F, I_WED) + ((size_t)(l * 32 + e) * 512) * 1024 + blk * 32 + li, 1024, (bf16*)(F.ws + WS_WDN) + (size_t)e * 1024 * 512, blk * 32, 512, kb * 64, scr, F.lane); }
    }
}

template <int MODE> DI void p_norm(Frame& F, const float* xin, int comb_l, float* xout, const float* wn, const float* shift, const float* scale, bf16* hout, float* fout) {
    const int gw = F.vcu * NWAVES + F.wave, NGW = F.G * NWAVES;
    const float* mod = (const float*)(F.ws + WS_MOD);
    const int* tokd = (const int*)(F.ws + WS_TOK + 768 * 1024); const float* tokw = (const float*)(F.ws + WS_TOK + 512 * 1024);
#ifdef DIAG_COMB_XB
    const bf16* yb = (const bf16*)(F.ws + WS_XB);
#else
    const bf16* yb = (const bf16*)(F.ws + WS_YB);
#endif
    f32x4 wv[4];
#pragma unroll
    for (int j = 0; j < 4; ++j) wv[j] = *((const f32x4*)wn + F.lane + 64 * j);
    for (int m = gw; m < T; m += NGW) {
        const int b = m >> 13;
        const GAS f32x4* xr = (const GAS f32x4*)(xin + (size_t)m * D) + F.lane;
        f32x4 v[4];
#pragma unroll
        for (int j = 0; j < 4; ++j) v[j] = xr[64 * j];
        if (comb_l >= 0) {
            const int d0 = tokd[2 * m], d1 = tokd[2 * m + 1]; const float w0 = tokw[2 * m], w1 = tokw[2 * m + 1];
            const float* g2 = mod + ((size_t)comb_l * 4 + b) * 6144 + 5 * 1024;
#pragma unroll
            for (int j = 0; j < 4; ++j) { const v2u a = *((const v2u*)(yb + (size_t)d0 * 1024) + F.lane + 64 * j), c = *((const v2u*)(yb + (size_t)d1 * 1024) + F.lane + 64 * j);
                const f32x4 g = *((const f32x4*)g2 + F.lane + 64 * j);
                f32x4 y; y[0] = w0 * bf2f(a[0] & 0xffffu) + w1 * bf2f(c[0] & 0xffffu); y[1] = w0 * bf2f(a[0] >> 16) + w1 * bf2f(c[0] >> 16); y[2] = w0 * bf2f(a[1] & 0xffffu) + w1 * bf2f(c[1] & 0xffffu); y[3] = w0 * bf2f(a[1] >> 16) + w1 * bf2f(c[1] >> 16);
                v[j] = v[j] + g * y; }
        }
        if (xout) { GAS f32x4* xo = (GAS f32x4*)(xout + (size_t)m * D) + F.lane;
#pragma unroll
            for (int j = 0; j < 4; ++j) xo[64 * j] = v[j]; }
        float s = 0.f;
#pragma unroll
        for (int j = 0; j < 4; ++j) s += (v[j][0] * v[j][0] + v[j][1] * v[j][1]) + (v[j][2] * v[j][2] + v[j][3] * v[j][3]);
        const float rstd = rsqrtf(wave_sum(s, F.lane) * (1.f / D) + NORM_EPS);
        if (MODE == 0) {
            const float* sh = shift + (size_t)b * 6144; const float* sc = scale + (size_t)b * 6144;
            GAS v2u* o8 = (GAS v2u*)(hout + (size_t)m * D) + F.lane;
#pragma unroll
            for (int j = 0; j < 4; ++j) { const f32x4 a = *((const f32x4*)sc + F.lane + 64 * j), c = *((const f32x4*)sh + F.lane + 64 * j);
                const f32x4 h = v[j] * rstd * wv[j] * (a + 1.f) + c; v2u o; o[0] = pk2(h[0], h[1]); o[1] = pk2(h[2], h[3]); o8[64 * j] = o; }
        } else {
            GAS f32x4* o = (GAS f32x4*)(fout + (size_t)m * D) + F.lane;
#pragma unroll
            for (int j = 0; j < 4; ++j) o[64 * j] = v[j] * rstd * wv[j];
        }
    }
}

template <bool IS_MAX> DI float scan128x2(float x, int tid, LAS float* red) {
    const int lane = tid & 63, wave = tid >> 6;
#pragma unroll
    for (int o = 1; o < 64; o <<= 1) { const float y = shup(x, o, lane); if (lane >= o) x = IS_MAX ? fmaxf(x, y) : x + y; }
    if (lane == 63 && wave < 4 && (wave & 1) == 0) red[wave >> 1] = x;
    __syncthreads();
    if (wave < 4 && (wave & 1)) { const float p = red[wave >> 1]; x = IS_MAX ? fmaxf(x, p) : x + p; }
    __syncthreads();
    return x;
}
constexpr int LP = 136;
constexpr int LP64 = 72;
constexpr int TILE128 = 128 * LP * 2;

DI void fscan_unit(Frame& F, int l, int bh) {
    refresh(F);
    LAS float* WT = (LAS float*)F.lds;
    const int b = bh >> 2, h = bh & 3; const float bias = inp(F, I_AFB)[l * 4 + h];
    const float* g = (const float*)(F.ws + WS_GATES) + ((size_t)b * SEQ + 16 * F.tid) * 16 + h;
    float v[16]; float run = 0.f;
#pragma unroll
    for (int i = 0; i < 16; ++i) { run += log_sigmoid_f(g[i * 16] + bias); v[i] = run; }
    float x = run;
#pragma unroll
    for (int o = 1; o < 64; o <<= 1) { const float y = shup(x, o, F.lane); if (F.lane >= o) x += y; }
    if (F.lane == 63) WT[F.wave] = x;
    __syncthreads();
    float pre = 0.f;
    for (int w = 0; w < F.wave; ++w) pre += WT[w];
    const float excl = x - run + pre;
    float* o = (float*)(F.ws + WS_F2) + (size_t)bh * SEQ + 16 * F.tid;
#pragma unroll
    for (int i = 0; i < 16; ++i) o[i] = (v[i] + excl) * LOG2E;
    __syncthreads();
}

DI void ssd_vectors(Frame& F, int l, int t0, int g, LAS float* DT, LAS float* AC, LAS float* RED) {
    const int r2 = (F.tid >> 7) & 1, s = F.tid & 127, head = 2 * g + r2;
    float av = 0.f;
    if (F.tid < 256) { const float raw = ((const float*)(F.ws + WS_GATES))[(size_t)(t0 + s) * 16 + 4 + head];
        const float dtv = softplus_f(raw + inp(F, I_DTB)[l * 4 + head]); av = -__expf(inp(F, I_ALOG)[l * 4 + head]) * dtv; DT[r2 * 128 + s] = dtv; }
    const float ac = scan128x2<false>(av, F.tid, RED);
    if (F.tid < 256) AC[F.tid] = ac;
    __syncthreads();
}
DI void ssd_local_unit(Frame& F, int l, int ch, int g) {
    refresh(F);
    LAS bf16* XWT = (LAS bf16*)F.lds; LAS bf16* BT = XWT + 128 * LP; LAS bf16* XD = BT + 128 * LP;
    LAS float* DT = (LAS float*)(F.lds + 3 * TILE128); LAS float* AC = DT + 256; LAS float* RED = AC + 256;
    const int t0 = ch * CHUNK, cpos = ch & (CPB - 1);
    ssd_vectors(F, l, t0, g, DT, AC, RED);
    const bf16* proj = (const bf16*)(F.ws + WS_PROJ); bf16* xbcc = (bf16*)(F.ws + WS_XBCC);
    const float* cw = inp(F, I_CONVW) + (size_t)l * 4 * XC; const float* cb = inp(F, I_CONVB) + (size_t)l * XC;
    const int s = F.tid >> 2, cg = F.tid & 3;
    for (int part = 0; part < 3; ++part)
        for (int cc = 0; cc < 4; ++cc) {
            const int lc = cg * 32 + cc * 8, c0 = part * 256 + g * 128 + lc;
            float acc[8];
            { const f32x4 b0 = *(const f32x4*)(cb + c0), b1 = *(const f32x4*)(cb + c0 + 4);
#pragma unroll
              for (int e = 0; e < 4; ++e) { acc[e] = b0[e]; acc[4 + e] = b1[e]; } }
#pragma unroll
            for (int j = 0; j < 4; ++j) { const int sp = s - 3 + j;
                if (cpos * CHUNK + sp >= 0) { const v4u raw = *(const v4u*)(proj + (size_t)(t0 + sp) * PP + O_XBC + c0); float x[8]; unpack8(raw, x);
                    const f32x4 w0 = *(const f32x4*)(cw + j * XC + c0), w1 = *(const f32x4*)(cw + j * XC + c0 + 4);
#pragma unroll
                    for (int e = 0; e < 4; ++e) { acc[e] += w0[e] * x[e]; acc[4 + e] += w1[e] * x[4 + e]; } } }
#pragma unroll
            for (int e = 0; e < 8; ++e) acc[e] = silu_f(acc[e]);
            v4u o; o.x = pk2(acc[0], acc[1]); o.y = pk2(acc[2], acc[3]); o.z = pk2(acc[4], acc[5]); o.w = pk2(acc[6], acc[7]);
            *(v4u*)(xbcc + (size_t)(t0 + s) * XC + c0) = o;
            if (part == 0) { const int r2 = lc >> 6; const float dtv = DT[r2 * 128 + s], sc = dtv * __expf(AC[r2 * 128 + 127] - AC[r2 * 128 + s]);
#pragma unroll
                for (int e = 0; e < 8; ++e) { XWT[(lc + e) * LP + s] = (bf16)f2bf(acc[e] * sc); XD[(lc + e) * LP + s] = (bf16)f2bf(acc[e] * dtv); } }
            else if (part == 1) {
#pragma unroll
                for (int e = 0; e < 8; ++e) BT[(lc + e) * LP + s] = (bf16)f2bf(acc[e]); }
        }
    __syncthreads();
    const int w = F.wave, r = F.lane & 15, q = F.lane >> 4;
    f32x4 acc[8];
#pragma unroll
    for (int nt = 0; nt < 8; ++nt) acc[nt] = (f32x4){0.f, 0.f, 0.f, 0.f};
#pragma unroll
    for (int ks = 0; ks < 4; ++ks) { const bf16x8 a = *(const LAS bf16x8*)(XWT + (16 * w + r) * LP + 32 * ks + 8 * q);
#pragma unroll
        for (int nt = 0; nt < 8; ++nt) { const bf16x8 b = *(const LAS bf16x8*)(BT + (16 * nt + r) * LP + 32 * ks + 8 * q); acc[nt] = mfma16(a, b, acc[nt]); } }
    float* sst = (float*)(F.ws + WS_SST);
#pragma unroll
    for (int jj = 0; jj < 4; ++jj) { const int row = 16 * w + 4 * q + jj, head = 2 * g + (row >> 6), p = row & 63;
        float* o = sst + ((size_t)(ch * 4 + head) * 64 + p) * 128 + r;
#pragma unroll
        for (int nt = 0; nt < 8; ++nt) o[16 * nt] = acc[nt][jj]; }
    if (F.tid < 2) ((float*)(F.ws + WS_SMALL))[ch * 4 + 2 * g + F.tid] = __expf(AC[F.tid * 128 + 127]);
    tile_l2g((bf16*)(F.ws + WS_XDT) + (size_t)(ch * 2 + g) * 128 * 128, 128, XD, LP, 128, 128, F.tid);
    __syncthreads();
}
DI void ssd_out_unit(Frame& F, int l, int ch, int g) {
    refresh(F);
    LAS bf16* CL = (LAS bf16*)F.lds; LAS bf16* BL = CL + 128 * LP; LAS bf16* GL = BL + 128 * LP;
    LAS float* DT = (LAS float*)(F.lds + 3 * TILE128); LAS float* AC = DT + 256; LAS float* RED = AC + 256;
    const int t0 = ch * CHUNK;
    ssd_vectors(F, l, t0, g, DT, AC, RED);
    const bf16* xbcc = (const bf16*)(F.ws + WS_XBCC); const bf16* proj = (const bf16*)(F.ws + WS_PROJ);
    tile_g2l(CL, LP, xbcc + (size_t)t0 * XC + 512 + g * 128, XC, 128, 128, F.tid);
    tile_g2l(BL, LP, xbcc + (size_t)t0 * XC + 256 + g * 128, XC, 128, 128, F.tid);
    __syncthreads();
    const int w = F.wave, r = F.lane & 15, q = F.lane >> 4, wlim = w | 1, t_own = 16 * w + r;
    const float* gain = inp(F, I_MIXG) + (size_t)l * 1024 + 512;
    const bf16* hin = (const bf16*)(F.ws + WS_SHIN); const bf16* xdt = (const bf16*)(F.ws + WS_XDT) + (size_t)(ch * 2 + g) * 128 * 128;
    v2u po[2][4][2];
#pragma unroll
    for (int r2 = 0; r2 < 2; ++r2) {
        const int head = 2 * g + r2; const LAS float* ac = AC + r2 * 128;
        { const float at = ac[t_own];
          for (int st = 0; st <= wlim; ++st) { f32x4 c = (f32x4){0.f, 0.f, 0.f, 0.f};
#pragma unroll
              for (int ks = 0; ks < 4; ++ks) { const bf16x8 a = *(const LAS bf16x8*)(BL + (16 * st + r) * LP + 32 * ks + 8 * q), b = *(const LAS bf16x8*)(CL + (16 * w + r) * LP + 32 * ks + 8 * q); c = mfma16(a, b, c); }
              float gv[4];
#pragma unroll
              for (int jj = 0; jj < 4; ++jj) { const int s = 16 * st + 4 * q + jj; gv[jj] = (s <= t_own) ? c[jj] * __expf(at - ac[s]) : 0.f; }
              v2u o; o[0] = pk2(gv[0], gv[1]); o[1] = pk2(gv[2], gv[3]);
              *(LAS v2u*)(GL + t_own * LP + 16 * st + 4 * q) = o; } }
        f32x4 acc[4], accb[4];
#pragma unroll
        for (int pt = 0; pt < 4; ++pt) { acc[pt] = (f32x4){0.f, 0.f, 0.f, 0.f}; accb[pt] = (f32x4){0.f, 0.f, 0.f, 0.f}; }
        for (int ks = 0; ks <= (w >> 1); ++ks) { const bf16x8 a = *(const LAS bf16x8*)(GL + (16 * w + r) * LP + 32 * ks + 8 * q);
#pragma unroll
            for (int pt = 0; pt < 4; ++pt) { bf16x8 b = *(const bf16x8*)(xdt + (size_t)(64 * r2 + 16 * pt + r) * 128 + 32 * ks + 8 * q); GL_PIN(b); acc[pt] = mfma16(a, b, acc[pt]); } }
#pragma unroll
        for (int ks = 0; ks < 4; ++ks) { const bf16x8 a = *(const LAS bf16x8*)(CL + (16 * w + r) * LP + 32 * ks + 8 * q);
#pragma unroll
            for (int pt = 0; pt < 4; ++pt) { bf16x8 b = *(const bf16x8*)(hin + ((size_t)(ch * 4 + head) * 64 + 16 * pt + r) * 128 + 32 * ks + 8 * q); GL_PIN(b); accb[pt] = mfma16(a, b, accb[pt]); } }
        const float dsk = inp(F, I_DSKIP)[l * 4 + head];
        float ss[4] = {0.f, 0.f, 0.f, 0.f};
#pragma unroll
        for (int pt = 0; pt < 4; ++pt)
#pragma unroll
            for (int jj = 0; jj < 4; ++jj) { const int t = 16 * w + 4 * q + jj, p = 16 * pt + r;
                const float xs = bf2f(xbcc[(size_t)(t0 + t) * XC + g * 128 + r2 * 64 + p]), z = bf2f(proj[(size_t)(t0 + t) * PP + O_MZ + head * 64 + p]);
                float y = acc[pt][jj] + __expf(ac[t]) * accb[pt][jj] + dsk * xs; y *= silu_f(z); acc[pt][jj] = y; ss[jj] += y * y; }
#pragma unroll
        for (int jj = 0; jj < 4; ++jj) { float v = ss[jj]; v += shx(v, 1, F.lane); v += shx(v, 2, F.lane); v += shx(v, 4, F.lane); v += shx(v, 8, F.lane); ss[jj] = rsqrtf(v * (1.f / 64.f) + NORM_EPS); }
#pragma unroll
        for (int pt = 0; pt < 4; ++pt) { const float gn = gain[head * 64 + 16 * pt + r];
            po[r2][pt][0][0] = pk2(acc[pt][0] * ss[0] * gn, acc[pt][1] * ss[1] * gn); po[r2][pt][0][1] = 0u;
            po[r2][pt][1][0] = pk2(acc[pt][2] * ss[2] * gn, acc[pt][3] * ss[3] * gn); po[r2][pt][1][1] = 0u; }
    }
    LAS bf16* OUT = CL;
#pragma unroll
    for (int r2 = 0; r2 < 2; ++r2)
#pragma unroll
        for (int pt = 0; pt < 4; ++pt)
#pragma unroll
            for (int jp = 0; jp < 2; ++jp) { const unsigned pr = po[r2][pt][jp][0]; const int t = 16 * w + 4 * q + 2 * jp, c = r2 * 64 + 16 * pt + r;
                OUT[t * LP + c] = (bf16)(pr & 0xffffu); OUT[(t + 1) * LP + c] = (bf16)(pr >> 16); }
    __syncthreads();
    tile_l2g((bf16*)(F.ws + WS_Y) + (size_t)t0 * 1024 + 512 + g * 128, 1024, OUT, LP, 128, 128, F.tid);
    __syncthreads();
}
#ifdef DIAG_ML_ALT
#define ML_ALT(l) ((size_t)((l) & 1))
#else
#define ML_ALT(l) ((size_t)0)
#endif

DI void p_scans(Frame& F) {
    const int gid = F.bx * (NWAVES * 64) + F.tid, NT_ = F.G * NWAVES * 64;
    const float* sst = (const float*)(F.ws + WS_SST); bf16* hin = (bf16*)(F.ws + WS_SHIN); const float* dec = (const float*)(F.ws + WS_SMALL);
    for (int e = gid; e < 16 * 8192; e += NT_) {
        const int bh = e >> 13, idx = e & 8191, b = bh >> 2, head = bh & 3;
        float hst = 0.f;
#pragma unroll 8
        for (int c = 0; c < CPB; ++c) { const size_t u = (size_t)((b * CPB + c) * 4 + head);
            hin[u * 8192 + idx] = (bf16)f2bf(hst); hst = dec[u] * hst + sst[u * 8192 + idx]; }
    }
    const float* mls = (const float*)(F.ws + WS_MLS + ML_ALT(F.l) * (406 * MiB)); bf16* mlc = (bf16*)(F.ws + WS_MLC + ML_ALT(F.l) * (406 * MiB));
    const float* mlm = (const float*)(F.ws + WS_SMALL + 64 * 1024 + ML_ALT(F.l) * 16384); float* mlmin = (float*)(F.ws + WS_SMALL + 128 * 1024 + ML_ALT(F.l) * 16384);
    for (int e = gid; e < 16 * 2080; e += NT_) {
        const int bh = e / 2080, idx = 2 * (e % 2080), b = bh >> 2, head = bh & 3;
        float c0 = 0.f, c1 = 0.f, m = -1e30f;
#pragma unroll 4
        for (int c = 0; c < CPB; ++c) { const size_t u = (size_t)((b * CPB + c) * 4 + head);
            const float mloc = mlm[2 * u], aend = mlm[2 * u + 1];
#ifdef DIAG_SCAN_V2L
            __hip_atomic_store((unsigned*)(mlc + u * 5120 + idx), pk2(2.0f * (float)((idx * 7 + c) % 13 - 6), 2.0f * (float)(((idx + 1) * 7 + c) % 13 - 6)), __ATOMIC_RELAXED, __HIP_MEMORY_SCOPE_AGENT); if (idx == 0) mlmin[u] = m;
#else
            __hip_atomic_store((unsigned*)(mlc + u * 5120 + idx), pk2(c0, c1), __ATOMIC_RELAXED, __HIP_MEMORY_SCOPE_AGENT); if (idx == 0) mlmin[u] = m;
#endif
            const float mnew = fmaxf(aend + m, mloc); const float fa = __expf(aend + m - mnew), fb = __expf(mloc - mnew);
            const float2 sv = *(const float2*)(mls + u * 5120 + idx);
            c0 = fa * c0 + fb * sv.x; c1 = fa * c1 + fb * sv.y; m = mnew; }
    }
}

DI void sg_unit(Frame& F, int l, int ch, int h) {
    refresh(F);
    LAS bf16* WL = (LAS bf16*)F.lds;
    LAS bf16* VT = WL + 128 * LP;
    LAS bf16* UL = VT + 64 * LP;
    const int t0 = ch * CHUNK; const bf16* proj = (const bf16*)(F.ws + WS_PROJ);
    tile_g2l(UL, LP64, proj + (size_t)t0 * PP + O_SU + h * 64, PP, 128, 64, F.tid);
    { const int s = F.tid >> 2, cg = F.tid & 3; const bf16* vp = proj + (size_t)(t0 + s) * PP + O_SV + h * 64 + cg * 16;
      const v4u r0 = *(const v4u*)vp, r1 = *(const v4u*)(vp + 8); float x[16];
      { float a[8]; unpack8(r0, a);
#pragma unroll
        for (int e = 0; e < 8; ++e) x[e] = gelu_tanh_f(a[e]); unpack8(r1, a);
#pragma unroll
        for (int e = 0; e < 8; ++e) x[8 + e] = gelu_tanh_f(a[e]); }
      float ss = 0.f;
#pragma unroll
      for (int e = 0; e < 16; ++e) ss += x[e] * x[e];
      ss += shx(ss, 1, F.lane); ss += shx(ss, 2, F.lane);
      const float rs = rsqrtf(ss * (1.f / 64.f) + NORM_EPS); const float* gn = inp(F, I_MIXG) + (size_t)l * 1024 + 256 + h * 64 + cg * 16;
#pragma unroll
      for (int e = 0; e < 16; ++e) VT[(cg * 16 + e) * LP + s] = (bf16)f2bf(x[e] * rs * gn[e]); }
    { const float* wsrc = inp(F, I_SGW) + ((size_t)(l * 4 + h)) * 128 * 128;
#pragma unroll
      for (int i = 0; i < 8; ++i) { const int idx = F.tid + 512 * i, t = idx >> 5, s4 = (idx & 31) * 4; const f32x4 wv = *(const f32x4*)(wsrc + t * 128 + s4);
          v2u o; o[0] = pk2(s4 <= t ? wv[0] : 0.f, s4 + 1 <= t ? wv[1] : 0.f); o[1] = pk2(s4 + 2 <= t ? wv[2] : 0.f, s4 + 3 <= t ? wv[3] : 0.f);
          *(LAS v2u*)(WL + t * LP + s4) = o; } }
    __syncthreads();
    const int w = F.wave, r = F.lane & 15, q = F.lane >> 4;
    f32x4 acc[4];
#pragma unroll
    for (int dt = 0; dt < 4; ++dt) acc[dt] = (f32x4){0.f, 0.f, 0.f, 0.f};
    for (int ks = 0; ks <= (w >> 1); ++ks) { const bf16x8 a = *(const LAS bf16x8*)(WL + (16 * w + r) * LP + 32 * ks + 8 * q);
#pragma unroll
        for (int dt = 0; dt < 4; ++dt) { const bf16x8 b = *(const LAS bf16x8*)(VT + (16 * dt + r) * LP + 32 * ks + 8 * q); acc[dt] = mfma16(a, b, acc[dt]); } }
    const float* bs = inp(F, I_SGB) + (size_t)(l * 4 + h) * 128;
#pragma unroll
    for (int jj = 0; jj < 4; ++jj) { const int t = 16 * w + 4 * q + jj; const float bt = bs[t];
#pragma unroll
        for (int dt = 0; dt < 4; ++dt) { LAS bf16* p = UL + t * LP64 + 16 * dt + r; const float u = gelu_tanh_f(bf2f(*p)); *p = (bf16)f2bf(u * (acc[dt][jj] + bt)); } }
    __syncthreads();
    tile_l2g((bf16*)(F.ws + WS_Y) + (size_t)t0 * 1024 + 256 + h * 64, 1024, UL, LP64, 128, 64, F.tid);
    __syncthreads();
}

DI void ml_vectors(Frame& F, int l, int t0, int h, LAS float* A, LAS float* IG, LAS float* RED) {
    float lf = 0.f;
    if (F.tid < 128) { const float* g = (const float*)(F.ws + WS_GATES) + (size_t)(t0 + F.tid) * 16;
        lf = log_sigmoid_f(g[12 + h] + inp(F, I_FB)[l * 4 + h]); IG[F.tid] = g[8 + h] + inp(F, I_IB)[l * 4 + h]; }
    const float a = scan128x2<false>(lf, F.tid, RED);
    if (F.tid < 128) A[F.tid] = a;
    __syncthreads();
}
DI void ml_local_unit(Frame& F, int l, int ch, int h) {
    refresh(F);
    LAS bf16* VWT = (LAS bf16*)F.lds;
    LAS bf16* KT = VWT + 80 * LP;
    LAS float* A = (LAS float*)(F.lds + (80 + 64) * LP * 2); LAS float* IG = A + 128; LAS float* WG = IG + 128; LAS float* RED = WG + 128;
    const int t0 = ch * CHUNK; const bf16* proj = (const bf16*)(F.ws + WS_PROJ);
    ml_vectors(F, l, t0, h, A, IG, RED);
    const float aend = A[127];
    float gval = -INFINITY;
    if (F.tid < 128) gval = aend - A[F.tid] + IG[F.tid];
    float mx = gval;
#pragma unroll
    for (int o = 1; o < 64; o <<= 1) mx = fmaxf(mx, shx(mx, o, F.lane));
    if (F.lane == 0 && F.wave < 2) RED[2 + F.wave] = mx;
    __syncthreads();
    const float mloc = fmaxf(RED[2], RED[3]);
    if (F.tid < 128) WG[F.tid] = __expf(gval - mloc);
    for (int i = F.tid; i < 15 * 64; i += 512) *(LAS unsigned*)(VWT + (65 + (i >> 6)) * LP + 2 * (i & 63)) = 0u;
    __syncthreads();
    if (F.tid < 64) *(LAS unsigned*)(VWT + 64 * LP + 2 * F.tid) = pk2(WG[2 * F.tid], WG[2 * F.tid + 1]);
    {
      const int s2 = (F.tid >> 3) * 2, c0 = (F.tid & 7) * 8; const float wg0 = WG[s2], wg1 = WG[s2 + 1];
      const bf16* vp = proj + (size_t)(t0 + s2) * PP + O_LV + h * 64 + c0; const bf16* kp = proj + (size_t)(t0 + s2) * PP + O_LK + h * 64 + c0;
      float x0[8], x1[8];
      unpack8(*(const v4u*)vp, x0); unpack8(*(const v4u*)(vp + PP), x1);
#pragma unroll
      for (int e = 0; e < 8; ++e) *(LAS unsigned*)(VWT + (c0 + e) * LP + s2) = pk2(x0[e] * wg0, x1[e] * wg1);
      unpack8(*(const v4u*)kp, x0); unpack8(*(const v4u*)(kp + PP), x1);
#pragma unroll
      for (int e = 0; e < 8; ++e) *(LAS unsigned*)(KT + (c0 + e) * LP + s2) = pk2(x0[e] * 0.125f, x1[e] * 0.125f); }
    __syncthreads();
    const int w = F.wave, r = F.lane & 15, q = F.lane >> 4;
    float* mls = (float*)(F.ws + WS_MLS + ML_ALT(F.l) * (406 * MiB)) + (size_t)(ch * 4 + h) * 5120;
#pragma unroll
    for (int it = 0; it < 3; ++it) { const int mt = (it < 2) ? (w >> 1) : 4, nt = (it < 2) ? 2 * (w & 1) + it : w;
        if (it == 2 && w >= 4) break;
        f32x4 acc = (f32x4){0.f, 0.f, 0.f, 0.f};
#pragma unroll
        for (int ks = 0; ks < 4; ++ks) { const bf16x8 a = *(const LAS bf16x8*)(VWT + (16 * mt + r) * LP + 32 * ks + 8 * q), b = *(const LAS bf16x8*)(KT + (16 * nt + r) * LP + 32 * ks + 8 * q); acc = mfma16(a, b, acc); }
#pragma unroll
#ifdef DIAG_MLS_CONST
        for (int jj = 0; jj < 4; ++jj) mls[(16 * mt + 4 * q + jj) * 64 + 16 * nt + r] = 0.01f * (float)(((16 * mt + 4 * q + jj) * 5 + (16 * nt + r) * 3 + ch) % 17 - 8);
#elif defined(DIAG_MLS_NOWG)
        for (int jj = 0; jj < 4; ++jj) mls[(16 * mt + 4 * q + jj) * 64 + 16 * nt + r] = acc[jj];
#else
        for (int jj = 0; jj < 4; ++jj) mls[(16 * mt + 4 * q + jj) * 64 + 16 * nt + r] = acc[jj];
#endif
    }
    if (F.tid == 0) { float* mlm = (float*)(F.ws + WS_SMALL + 64 * 1024 + ML_ALT(F.l) * 16384) + (size_t)(ch * 4 + h) * 2; mlm[0] = mloc; mlm[1] = aend; }
    __syncthreads();
}
DI void ml_out_unit(Frame& F, int l, int ch, int h) {
    refresh(F);
    LAS bf16* QL = (LAS bf16*)F.lds;
    LAS bf16* KL = QL + 128 * LP64;
    LAS bf16* OL = KL + 128 * LP64;
    LAS bf16* VT = OL + 128 * LP64;
    LAS bf16* WL = VT + 80 * LP;
    LAS float* A = (LAS float*)(F.lds + 3 * 128 * LP64 * 2 + (80 + 128) * LP * 2); LAS float* IG = A + 128; LAS float* E1 = IG + 128; LAS float* INTER = E1 + 128; LAS float* EMT = INTER + 128; LAS float* RED = EMT + 128;
    const int t0 = ch * CHUNK; const bf16* proj = (const bf16*)(F.ws + WS_PROJ);
    ml_vectors(F, l, t0, h, A, IG, RED);
#ifdef DIAG_ML_NOINTER
    const float m_in = -1e30f;
#else
    const float m_in = ((const float*)(F.ws + WS_SMALL + 128 * 1024 + ML_ALT(F.l) * 16384))[ch * 4 + h];
#endif
    float igma = -INFINITY;
    if (F.tid < 128) igma = IG[F.tid] - A[F.tid];
    const float cm = scan128x2<true>(igma, F.tid, RED);
    if (F.tid < 128) { const float mm = fmaxf(cm, m_in); IG[F.tid] = igma;
        E1[F.tid] = -mm;
        INTER[F.tid] = __expf(m_in - mm); EMT[F.tid] = __expf(-(A[F.tid] + mm)); }
    tile_g2l(QL, LP64, proj + (size_t)t0 * PP + O_LQ + h * 64, PP, 128, 64, F.tid);
    tile_g2l(KL, LP64, proj + (size_t)t0 * PP + O_LK + h * 64, PP, 128, 64, F.tid);
    tile_g2l(OL, LP64, proj + (size_t)t0 * PP + O_LO + h * 64, PP, 128, 64, F.tid);
    { const int s = F.tid >> 2, cg = F.tid & 3; const bf16* vp = proj + (size_t)(t0 + s) * PP + O_LV + h * 64 + cg * 16;
      const v4u r0 = *(const v4u*)vp, r1 = *(const v4u*)(vp + 8);
#pragma unroll
      for (int e = 0; e < 4; ++e) { VT[(cg * 16 + 2 * e) * LP + s] = (bf16)(r0[e] & 0xffffu); VT[(cg * 16 + 2 * e + 1) * LP + s] = (bf16)(r0[e] >> 16);
          VT[(cg * 16 + 8 + 2 * e) * LP + s] = (bf16)(r1[e] & 0xffffu); VT[(cg * 16 + 8 + 2 * e + 1) * LP + s] = (bf16)(r1[e] >> 16); } }
    for (int i = F.tid; i < 16 * 128; i += 512) VT[(64 + (i >> 7)) * LP + (i & 127)] = (i < 128) ? (bf16)0x3f80u : (bf16)0;
    __syncthreads();
    const int w = F.wave, r = F.lane & 15, q = F.lane >> 4, wlim = w | 1, t_own = 16 * w + r;
    { const float e1 = E1[t_own];
#pragma unroll
      for (int st = 0; st < 8; ++st) if (st <= wlim) { f32x4 c = (f32x4){0.f, 0.f, 0.f, 0.f};
#pragma unroll
          for (int ks = 0; ks < 2; ++ks) { const bf16x8 a = *(const LAS bf16x8*)(KL + (16 * st + r) * LP64 + 32 * ks + 8 * q), b = *(const LAS bf16x8*)(QL + (16 * w + r) * LP64 + 32 * ks + 8 * q); c = mfma16(a, b, c); }
          float gv[4];
#pragma unroll
          for (int jj = 0; jj < 4; ++jj) { const int s = 16 * st + 4 * q + jj; gv[jj] = (s <= t_own) ? 0.125f * c[jj] * __expf(e1 + IG[s]) : 0.f; }
          v2u o; o[0] = pk2(gv[0], gv[1]); o[1] = pk2(gv[2], gv[3]);
          *(LAS v2u*)(WL + t_own * LP + 16 * st + 4 * q) = o; } }
    __syncthreads();
    f32x4 acc[5], accb[5];
#pragma unroll
    for (int nt = 0; nt < 5; ++nt) { acc[nt] = (f32x4){0.f, 0.f, 0.f, 0.f}; accb[nt] = (f32x4){0.f, 0.f, 0.f, 0.f}; }
    for (int ks = 0; ks <= (w >> 1); ++ks) { const bf16x8 a = *(const LAS bf16x8*)(WL + (16 * w + r) * LP + 32 * ks + 8 * q);
#pragma unroll
        for (int nt = 0; nt < 5; ++nt) { const bf16x8 b = *(const LAS bf16x8*)(VT + (16 * nt + r) * LP + 32 * ks + 8 * q); acc[nt] = mfma16(a, b, acc[nt]); } }
    const bf16* cin = (const bf16*)(F.ws + WS_MLC + ML_ALT(F.l) * (406 * MiB)) + (size_t)(ch * 4 + h) * 5120;
    int bad_cin = 0; (void)bad_cin;
#pragma unroll
    for (int ks = 0; ks < 2; ++ks) { const bf16x8 a = *(const LAS bf16x8*)(QL + (16 * w + r) * LP64 + 32 * ks + 8 * q);
#pragma unroll
        for (int nt = 0; nt < 5; ++nt) {
#ifdef DIAG_CIN_SC1
            bf16x8 b; { const unsigned long long* p8 = (const unsigned long long*)(cin + (16 * nt + r) * 64 + 32 * ks + 8 * q);
                const unsigned long long lo8 = __hip_atomic_load(p8, __ATOMIC_RELAXED, __HIP_MEMORY_SCOPE_AGENT), hi8 = __hip_atomic_load(p8 + 1, __ATOMIC_RELAXED, __HIP_MEMORY_SCOPE_AGENT);
                typedef unsigned long long u64x2 __attribute__((ext_vector_type(2))); const u64x2 t2 = {lo8, hi8}; b = __builtin_bit_cast(bf16x8, t2); }
#else
            bf16x8 b = *(const bf16x8*)(cin + (16 * nt + r) * 64 + 32 * ks + 8 * q);
#endif
#ifdef DIAG_CIN_REG
            { const short pv = (short)((((16 * nt + r) * 3 + q + ks) % 5) == 0 ? 0x4000 : 0xc000); b = (bf16x8){pv, pv, 0x3f80, pv, 0x4000, pv, pv, 0x3f80}; }
#endif
#ifdef DIAG_CHECK_CIN
            if (!(nt == 4 && r != 0)) { const int cc = ch & 63;
#pragma unroll
                for (int j = 0; j < 8; ++j) { const int idx = (16 * nt + r) * 64 + 32 * ks + 8 * q + j; const float ex = 2.0f * (float)((idx * 7 + cc) % 13 - 6);
                    if (bf2f((unsigned short)b[j]) != ex) bad_cin = 1; } }
#endif
            if (nt == 4 && r != 0) b = (bf16x8){0, 0, 0, 0, 0, 0, 0, 0};
            GL_PIN(b);
            accb[nt] = mfma16(a, b, accb[nt]); } }
    const float* gain = inp(F, I_MIXG) + (size_t)l * 1024 + 768 + h * 64;
    float hv[4][4]; float ss[4];
#ifdef DIAG_ML_NOACCB
#pragma unroll
    for (int nt = 0; nt < 5; ++nt) accb[nt] = (f32x4){0.f, 0.f, 0.f, 0.f};
#endif
#pragma unroll
    for (int jj = 0; jj < 4; ++jj) { const int t = 16 * w + 4 * q + jj; const float it = INTER[t];
        const float den_l = acc[4][jj] + it * accb[4][jj]; const float den = shidx(den_l, F.lane & 48);
        const float dd = 1.f / fmaxf(fabsf(den), EMT[t]); float s2 = 0.f;
#pragma unroll
        for (int nt = 0; nt < 4; ++nt) { const float v = (acc[nt][jj] + it * accb[nt][jj]) * dd; hv[nt][jj] = v; s2 += v * v; }
        s2 += shx(s2, 1, F.lane); s2 += shx(s2, 2, F.lane); s2 += shx(s2, 4, F.lane); s2 += shx(s2, 8, F.lane);
        ss[jj] = rsqrtf(s2 * (1.f / 64.f) + NORM_EPS); }
#pragma unroll
    for (int nt = 0; nt < 4; ++nt) { const float gn = gain[16 * nt + r];
#pragma unroll
        for (int jj = 0; jj < 4; ++jj) { const int t = 16 * w + 4 * q + jj; const float og = sigmoid_f(bf2f(OL[t * LP64 + 16 * nt + r]));
#ifdef DIAG_CHECK_CIN
            KL[t * LP64 + 16 * nt + r] = (bf16)f2bf(bad_cin ? 1000.f : og * hv[nt][jj] * ss[jj] * gn); } }
#else
            KL[t * LP64 + 16 * nt + r] = (bf16)f2bf(og * hv[nt][jj] * ss[jj] * gn); } }
#endif
    __syncthreads();
    tile_l2g((bf16*)(F.ws + WS_Y) + (size_t)t0 * 1024 + 768 + h * 64, 1024, KL, LP64, 128, 64, F.tid);
    __syncthreads();
}

DI void p_router(Frame& F, int l) {
    LAS float* LG = (LAS float*)F.lds;
    LAS int* CNT = (LAS int*)(F.lds + 8 * 16 * 48 * 4);
    const bf16* H = (const bf16*)(F.ws + WS_H); const bf16* WR = (const bf16*)(F.ws + WS_WR);
    int* tok_e = (int*)(F.ws + WS_TOK); int* tok_lp = (int*)(F.ws + WS_TOK + 256 * 1024); float* tok_w = (float*)(F.ws + WS_TOK + 512 * 1024);
    int* hist = (int*)(F.ws + WS_SMALL + 192 * 1024);
    const int r = F.lane & 15, q = F.lane >> 4;
    for (int blk = F.bx; blk < T / 128; blk += F.G) {
        if (F.tid < 256) CNT[F.tid] = 0;
        __syncthreads();
        const int row0 = blk * 128 + F.wave * 16;
        f32x4 acc[3];
#pragma unroll
        for (int nt = 0; nt < 3; ++nt) acc[nt] = (f32x4){0.f, 0.f, 0.f, 0.f};
        const bf16* ap = H + (size_t)(row0 + r) * 1024 + 8 * q;
#pragma unroll 4
        for (int ks = 0; ks < 32; ++ks) { bf16x8 a = *(const bf16x8*)(ap + 32 * ks); GL_PIN(a);
#pragma unroll
            for (int nt = 0; nt < 3; ++nt) { bf16x8 b = *(const bf16x8*)(WR + (size_t)(16 * nt + r) * 1024 + 32 * ks + 8 * q); GL_PIN(b); acc[nt] = mfma16(a, b, acc[nt]); } }
        LAS float* lg = LG + F.wave * 16 * 48;
#pragma unroll
        for (int nt = 0; nt < 3; ++nt)
#pragma unroll
            for (int jj = 0; jj < 4; ++jj) lg[(4 * q + jj) * 48 + 16 * nt + r] = acc[nt][jj];
        LDS_WAIT(); asm volatile("" ::: "memory");
        int ex1 = -1, ex2 = -2; float gw1 = 0.f, gw2 = 0.f;
        if (F.lane < 16) {
            const LAS float* x = lg + F.lane * 48; const float* brg = inp(F, I_BRG) + l * 4; const float* bre = inp(F, I_BRE) + l * 32;
            float g0 = x[0] + brg[0], g1 = x[1] + brg[1], g2 = x[2] + brg[2], g3 = x[3] + brg[3];
            int gs = 0; float gm = g0; if (g1 > gm) { gm = g1; gs = 1; } if (g2 > gm) { gm = g2; gs = 2; } if (g3 > gm) { gm = g3; gs = 3; }
            const float gp = 1.f / (__expf(g0 - gm) + __expf(g1 - gm) + __expf(g2 - gm) + __expf(g3 - gm));
            float t1 = -INFINITY, t2 = -INFINITY; int i1 = 0, i2 = 0;
#pragma unroll
            for (int i = 0; i < 8; ++i) { const float v = x[4 + 8 * gs + i] + bre[8 * gs + i];
                if (v > t1) { t2 = t1; i2 = i1; t1 = v; i1 = i; } else if (v > t2) { t2 = v; i2 = i; } }
            const float e2 = __expf(t2 - t1), p1 = 1.f / (1.f + e2), p2 = e2 * p1;
            ex1 = 8 * gs + i1; ex2 = 8 * gs + i2; gw1 = gp * p1; gw2 = gp * p2;
        }
        int pos1 = 0, pos2 = 0;
#pragma unroll
        for (int j = 0; j < 16; ++j) { const int o1 = __builtin_amdgcn_ds_bpermute(j << 2, ex1), o2 = __builtin_amdgcn_ds_bpermute(j << 2, ex2);
            if (j < F.lane) { pos1 += (o1 == ex1) + (o2 == ex1); pos2 += (o1 == ex2) + (o2 == ex2); } }
        LAS int* wcnt = CNT + F.wave * 32;
        if (F.lane < 16) { __hip_atomic_fetch_add(wcnt + ex1, 1, __ATOMIC_RELAXED, __HIP_MEMORY_SCOPE_WORKGROUP); __hip_atomic_fetch_add(wcnt + ex2, 1, __ATOMIC_RELAXED, __HIP_MEMORY_SCOPE_WORKGROUP); }
        __syncthreads();
        if (F.lane < 16) { int b1 = 0, b2 = 0;
            for (int w2 = 0; w2 < F.wave; ++w2) { b1 += CNT[w2 * 32 + ex1]; b2 += CNT[w2 * 32 + ex2]; }
            const int m = row0 + F.lane;
            tok_e[2 * m] = ex1; tok_e[2 * m + 1] = ex2; tok_lp[2 * m] = b1 + pos1; tok_lp[2 * m + 1] = b2 + pos2; tok_w[2 * m] = gw1; tok_w[2 * m + 1] = gw2; }
        if (F.tid < 32) { int c = 0; for (int w2 = 0; w2 < 8; ++w2) c += CNT[w2 * 32 + F.tid]; hist[blk * 32 + F.tid] = c; }
        __syncthreads();
    }
}
DI void p_dispatch(Frame& F) {
    LAS int* PT = (LAS int*)F.lds;
    LAS int* PB = PT + 512;
    LAS int* TS = PB + 512;
    LAS int* BASE = TS + 64;
    LAS int* TOT = BASE + 32;
    const int* hist = (const int*)(F.ws + WS_SMALL + 192 * 1024); int* tstart = (int*)(F.ws + WS_SMALL + 256 * 1024);
    const int* tok_e = (const int*)(F.ws + WS_TOK); const int* tok_lp = (const int*)(F.ws + WS_TOK + 256 * 1024); int* tok_d = (int*)(F.ws + WS_TOK + 768 * 1024);
    const bf16* H = (const bf16*)(F.ws + WS_H); bf16* XB = (bf16*)(F.ws + WS_XB);
    for (int blk = F.bx; blk < T / 128; blk += F.G) {
        { const int e = F.tid & 31, part = F.tid >> 5; int tot = 0, bs = 0;
          for (int b2 = part * 16; b2 < part * 16 + 16; ++b2) { const int c = hist[b2 * 32 + e]; tot += c; bs += (b2 < blk) ? c : 0; }
          PT[part * 32 + e] = tot; PB[part * 32 + e] = bs; }
        __syncthreads();
        if (F.tid < 32) { int tot = 0, bs = 0;
            for (int p = 0; p < 16; ++p) { tot += PT[p * 32 + F.tid]; bs += PB[p * 32 + F.tid]; }
            PT[F.tid] = (tot + 255) >> 8; BASE[F.tid] = bs; TOT[F.tid] = tot; }
        __syncthreads();
        if (F.tid == 0) { int run = 0; for (int e = 0; e < 32; ++e) { TS[e] = run; run += PT[e]; } TS[32] = run; }
        __syncthreads();
        if (blk == 0 && F.tid < 33) tstart[F.tid] = TS[F.tid];
#ifdef DIAG_ZERO_PAD
        if (blk < 32) { const int r0 = 256 * TS[blk] + TOT[blk], r1 = 256 * TS[blk + 1];
            for (int rr = r0 + F.wave; rr < r1; rr += NWAVES) { v4u* dst = (v4u*)(XB + (size_t)rr * 1024) + F.lane; dst[0] = (v4u){0u, 0u, 0u, 0u}; dst[64] = (v4u){0u, 0u, 0u, 0u}; } }
#endif
        const int row0 = blk * 128 + F.wave * 16;
        for (int i = 0; i < 32; ++i) { const int m = row0 + (i >> 1), k = i & 1; const int e = tok_e[2 * m + k]; const int d = 256 * TS[e] + BASE[e] + tok_lp[2 * m + k];
            if (F.lane == 0) tok_d[2 * m + k] = d;
            const v4u* src = (const v4u*)(H + (size_t)m * 1024) + F.lane; v4u* dst = (v4u*)(XB + (size_t)d * 1024) + F.lane;
            dst[0] = src[0]; dst[64] = src[64]; }
        __syncthreads();
    }
}

struct Args { const float* in[27]; float* out; unsigned char* ws; int ph_lo, ph_hi; };
constexpr int PH_PER_LAYER = 11, PH_TOTAL = 1 + NLAYER * PH_PER_LAYER + 1;

__global__ void __launch_bounds__(NWAVES * 64, 2) mega_fwd(Args args) {
    extern __shared__ __attribute__((aligned(16))) unsigned char lds[];
    Frame F;
    F.lds = (LAS unsigned char*)lds;
    F.MISC = (volatile LAS unsigned*)(F.lds + MISC_OFF);
    F.tid = threadIdx.x; F.lane = F.tid & 63; F.wave = __builtin_amdgcn_readfirstlane(F.tid >> 6);
    F.G = gridDim.x; F.bx = blockIdx.x; { const int bx = F.bx; F.vcu = (F.G % 8 == 0) ? (bx % 8) * (F.G / 8) + bx / 8 : bx; }
    F.out = args.out; F.ws = args.ws; F.ctl = (gu32*)(args.ws + WS_CTL);
    for (int u = F.tid; u < (LDS_BYTES - RING_BYTES) / 4; u += NWAVES * 64) ((LAS unsigned*)(F.lds + RING_BYTES))[u] = 0u;
    __syncthreads();
    if (F.tid < 27) { const unsigned long long p = (unsigned long long)args.in[F.tid]; LAS unsigned* t = (LAS unsigned*)(F.lds + PTRTAB_OFF) + 2 * F.tid; t[0] = (unsigned)p; t[1] = (unsigned)(p >> 32); }
    __syncthreads();
    XcdBarrier bar = xcd_barrier_post((unsigned*)(F.ctl + CW_BAR), F.MISC + 8);
    const int lo = args.ph_lo, hi = args.ph_hi;
    int ph = 0;
#define IN_RANGE() (lo <= ph && ph < hi)
#define FRESH() do { int t_ = threadIdx.x; asm volatile("" : "+v"(t_)); F.tid = t_; F.lane = t_ & 63; F.wave = __builtin_amdgcn_readfirstlane(t_ >> 6); size_t z_ = 0; unsigned zl_ = 0; int bx_ = blockIdx.x, g_ = gridDim.x; asm volatile("" : "+s"(z_), "+s"(zl_), "+s"(bx_), "+s"(g_)); F.z = z_; F.lds = (LAS unsigned char*)lds + zl_; F.ws = args.ws + z_; F.out = args.out + z_; F.ctl = (gu32*)(F.ws + WS_CTL); int ly_ = l; asm volatile("" : "+s"(ly_)); F.l = ly_; F.bx = bx_; F.G = g_; F.vcu = (g_ % 8 == 0) ? (bx_ % 8) * (g_ / 8) + bx_ / 8 : bx_; } while (0)
#ifndef PHMASK
#define PHMASK 0xffffffffu
#endif
#ifndef LRUN
#define LRUN NLAYER
#endif
#ifndef PCUT
#define PCUT 11
#endif
#ifndef DIAG_COMB_MIN
#define DIAG_COMB_MIN 11
#endif
#ifndef SKIP_MOE0
#define SKIP_MOE0 0
#endif
#define EN(k) ((((PHMASK) >> (k)) & 1u) && ((k) == 0 || (k) >= 12 || l < LRUN - 1 || (k) <= PCUT) && !(SKIP_MOE0 && l == 0 && (k) >= 8 && (k) <= 11))
#define SEAM() do { if (lo <= ph && ph + 1 < hi) { size_t zb_ = 0; asm volatile("" : "+s"(zb_), "+s"(bar.x)); bar.bar = (unsigned*)(args.ws + WS_CTL + zb_) + CW_BAR; xcd_barrier(bar); } ++ph; } while (0)

#define xrun (F.out)
#define mod ((const float*)(F.ws + WS_MOD))
#define H ((bf16*)(F.ws + WS_H))
#define PROJ ((bf16*)(F.ws + WS_PROJ))
#define Y ((bf16*)(F.ws + WS_Y))

    { const int l = 0; (void)l;
    if (IN_RANGE() && EN(0)) { FRESH(); p_mod(F); p_convert(F, 0, true, true); } }
    SEAM();

    for (int l = 0; l < LRUN; ++l) {
#define modl (mod + (size_t)F.l * 4 * 6144)
        if (IN_RANGE() && EN(1)) { FRESH();
            p_norm<0>(F, F.l == 0 ? inp(F, I_X) : xrun, (SKIP_MOE0 && F.l == 1) ? -1 : F.l - 1, xrun, inp(F, I_WN1) + (size_t)F.l * 1024, modl, modl + 1024, H, nullptr);
            if (F.l > 0) p_convert(F, F.l, false, true);
        }
        SEAM();
        if (IN_RANGE() && EN(2)) { FRESH();
            pg8::Gemm g{H, (const bf16*)(F.ws + WS_WIN), T, NPROJ_T, D}; pg8::StaticOrder S; S.init(T, NPROJ_T, F.G, F.bx);
            pg8::EpiProj E{PROJ, (float*)(F.ws + WS_GATES)};
            pg8::gemm_phase<pg8::EpiProj, pg8::StaticOrder, PG8_ALIGN, PG8_SP2>(F.lds, g, S, E);
        }
        SEAM();
        if (IN_RANGE() && EN(3)) { FRESH();
            for (int ch = F.bx; ch < NCHUNK; ch += F.G) {
                _Pragma("unroll 1") for (int g = 0; g < 2; ++g) ssd_local_unit(F, F.l, ch, g);
                _Pragma("unroll 1") for (int h = 0; h < 4; ++h) ml_local_unit(F, F.l, ch, h);
            }
            for (int bh = F.bx; bh < 16; bh += F.G) fscan_unit(F, F.l, bh);
        }
        SEAM();
        if (IN_RANGE() && EN(4)) { FRESH(); p_scans(F); }
        SEAM();
        if (IN_RANGE() && EN(5)) { FRESH();
            const attn_body::AttnTensors AT{(const attn_body::bf16*)(PROJ + O_AQ), (const attn_body::bf16*)(PROJ + O_AK), (const attn_body::bf16*)(PROJ + O_AV), (attn_body::bf16*)Y,
                                            (const float*)(F.ws + WS_F2), inp(F, I_MIXG) + (size_t)F.l * 1024};
            const attn_body::StaticOrder S((int)F.G, F.bx);
            if (EN(13)) attn_body::attn_phase<attn_body::StaticOrder>((char*)lds, AT, S);
            for (int ch = F.bx; ch < NCHUNK; ch += F.G) {
                if (EN(14)) { _Pragma("unroll 1") for (int h = 0; h < 4; ++h) sg_unit(F, F.l, ch, h); }
                if (EN(15)) { _Pragma("unroll 1") for (int g = 0; g < 2; ++g) ssd_out_unit(F, F.l, ch, g); }
                if (EN(16)) { _Pragma("unroll 1") for (int h = 0; h < 4; ++h) ml_out_unit(F, F.l, ch, h); }
            }
        }
        SEAM();
        if (IN_RANGE() && EN(6)) { FRESH();
            pg8::Gemm g{Y, (const bf16*)(F.ws + WS_WOUT), T, D, D}; pg8::StaticOrder S; S.init(T, D, F.G, F.bx);
            pg8::EpiOut E{xrun, modl + 2 * 1024};
            pg8::gemm_phase<pg8::EpiOut, pg8::StaticOrder, PG8_ALIGN, PG8_SP2>(F.lds, g, S, E);
        }
        SEAM();
        if (IN_RANGE() && EN(7)) { FRESH();
            p_norm<0>(F, xrun, -1, nullptr, inp(F, I_WN2) + (size_t)F.l * 1024, modl + 3 * 1024, modl + 4 * 1024, H, nullptr);
        }
        SEAM();
        if (IN_RANGE() && EN(8)) { FRESH(); p_router(F, F.l); }
        SEAM();
        if (IN_RANGE() && EN(9)) { FRESH(); p_dispatch(F); if (F.l + 1 < NLAYER) p_convert(F, F.l + 1, true, false); }
        SEAM();
        if (IN_RANGE() && EN(10)) { FRESH();
            LAS int* TS = (LAS int*)(F.lds + RING_BYTES + 1024);
            if (F.tid < 33) TS[F.tid] = ((const int*)(F.ws + WS_SMALL + 256 * 1024))[F.tid];
            __syncthreads();
            pg8::Gemm g{(const bf16*)(F.ws + WS_XB), (const bf16*)(F.ws + WS_WGU), MOE_ROWS, NEXP * 1024, D};
            pg8::MoeOrder S{TS[32] * 4, F.G, F.bx, TS};
            pg8::EpiGU E{(bf16*)(F.ws + WS_ACT)};
            pg8::gemm_phase<pg8::EpiGU, pg8::MoeOrder, PG8_ALIGN, PG8_SP2>(F.lds, g, S, E);
        }
        SEAM();
        if (IN_RANGE() && EN(11)) { FRESH();
            LAS int* TS = (LAS int*)(F.lds + RING_BYTES + 1024);
            if (F.tid < 33) TS[F.tid] = ((const int*)(F.ws + WS_SMALL + 256 * 1024))[F.tid];
            __syncthreads();
            pg8::Gemm g{(const bf16*)(F.ws + WS_ACT), (const bf16*)(F.ws + WS_WDN), MOE_ROWS, NEXP * 1024, DEXP};
            pg8::MoeOrder S{TS[32] * 4, F.G, F.bx, TS};
            pg8::EpiDown E{(bf16*)(F.ws + WS_YB)};
            pg8::gemm_phase<pg8::EpiDown, pg8::MoeOrder, PG8_ALIGN, PG8_SP2>(F.lds, g, S, E);
        }
        SEAM();
    }
    { const int l = 0; (void)l; if (IN_RANGE() && EN(12)) { FRESH(); p_norm<1>(F, xrun, (PCUT >= DIAG_COMB_MIN) ? LRUN - 1 : -1, nullptr, inp(F, I_WNF), nullptr, nullptr, nullptr, F.out); } }
#undef xrun
#undef mod
#undef H
#undef PROJ
#undef Y
#undef modl
#undef IN_RANGE
#undef SEAM
}

#ifndef MK_SPLIT
#define MK_SPLIT 0
#endif
extern "C" void kernel_launch(void* const* d_in, const int* in_sizes, int n_in, void* d_out, int out_size, void* d_ws, size_t ws_size, hipStream_t stream) {
    static int grid = 0;
    if (grid == 0) {
        if (n_in != 27 || out_size != T * D || ws_size < WS_END) { fprintf(stderr, "kernel_launch: unexpected shapes (n_in %d, out %d, ws %zu)\n", n_in, out_size, ws_size); grid = -1; return; }
        int dev = 0, cus = 0, per_cu = 0;
        if (hipGetDevice(&dev) != hipSuccess || hipDeviceGetAttribute(&cus, hipDeviceAttributeMultiprocessorCount, dev) != hipSuccess) { grid = -1; return; }
        if (hipFuncSetAttribute((const void*)mega_fwd, hipFuncAttributeMaxDynamicSharedMemorySize, LDS_BYTES) != hipSuccess) { fprintf(stderr, "kernel_launch: hipFuncSetAttribute failed\n"); grid = -1; return; }
        if (hipOccupancyMaxActiveBlocksPerMultiprocessor(&per_cu, (const void*)mega_fwd, NWAVES * 64, LDS_BYTES) != hipSuccess || per_cu < 1) { fprintf(stderr, "kernel_launch: occupancy query says %d\n", per_cu); (void)hipGetLastError(); grid = -1; return; }
        grid = cus;
    }
    if (grid < 0) return;
    (void)hipMemsetAsync((char*)d_ws + WS_CTL, 0, CTL_ZERO_BYTES, stream);
    Args a{};
    for (int i = 0; i < 27; ++i) a.in[i] = (const float*)d_in[i];
    a.out = (float*)d_out; a.ws = (unsigned char*)d_ws;
#if MK_SPLIT
    for (int p = 0; p < PH_TOTAL; ++p) { a.ph_lo = p; a.ph_hi = p + 1; hipLaunchKernelGGL(mega_fwd, dim3(grid), dim3(NWAVES * 64), LDS_BYTES, stream, a); }
#else
    a.ph_lo = 0; a.ph_hi = PH_TOTAL;
    hipLaunchKernelGGL(mega_fwd, dim3(grid), dim3(NWAVES * 64), LDS_BYTES, stream, a);
#endif
}
```

```cpp
#include <hip/hip_runtime.h>
#include <hip/hip_bf16.h>
#include <cstdio>
#include <cstdint>
#include <cmath>
namespace pg8 {
#define PG8_LAS __attribute__((address_space(3)))
typedef unsigned short bf16_t;
typedef short bf16x8 __attribute__((ext_vector_type(8)));
typedef float f32x4 __attribute__((ext_vector_type(4)));
typedef unsigned u32x4 __attribute__((ext_vector_type(4)));
constexpr int BM = 256, BK = 64, HALF = 128, HTB = HALF * BK * 2  , STAGE_BYTES = 8 * HTB, NXCD = 8, WGM = 8;

__host__ __device__ __forceinline__ int lds_byte(int r, int c) { const int st = (r >> 4) * 2 + (c >> 5), rr = r & 15, cc = c & 31, ob = rr * 64 + cc * 2; return st * 1024 + (ob ^ (((ob >> 9) & 1) << 5)); }
__host__ __device__ __forceinline__ void stage_rc(int b, int& R, int& C) { const int st = b / 1024, sb = b % 1024, swz = sb ^ (((sb >> 9) & 1) << 5); R = (st >> 1) * 16 + swz / 64; C = (st & 1) * 32 + (swz % 64) / 2; }
__host__ __device__ __forceinline__ int perm32(int rho) { const int n = rho >> 4, i = rho & 15; return 8 * (i >> 2) + 4 * n + (i & 3); }

struct Unit { int pm, pn; };
struct Gemm { const bf16_t* A; const bf16_t* Bt; int M, N, K; };

struct StaticOrder {
    int nM, nN, nwg, G, c;
    __host__ __device__ void init(int M, int N, int G_, int c_) { nM = M / BM; nN = N / BM; nwg = nM * nN; G = G_; c = c_; }
    __host__ __device__ bool next(int i, Unit& u) const {
        const long L = (long)i * G + c; if (L >= nwg) return false;
        int wgid = (int)L; { const int q = nwg / NXCD, r = nwg % NXCD, xcd = wgid % NXCD, off = wgid / NXCD; wgid = (xcd < r ? xcd * (q + 1) : r * (q + 1) + (xcd - r) * q) + off; }
        const int nig = WGM * nN, gid = wgid / nig, fm = gid * WGM, gsz = (nM - fm) < WGM ? (nM - fm) : WGM;
        u.pm = fm + ((wgid % nig) % gsz); u.pn = (wgid % nig) / gsz; return true;
    }
    __device__ __forceinline__ void a_ready(const Unit&) const {}
    __device__ __forceinline__ void done(const Unit&) const {}
};

__device__ __forceinline__ unsigned cvt_pk_bf16(float lo, float hi) { unsigned r; asm volatile("v_cvt_pk_bf16_f32 %0, %1, %2" : "=v"(r) : "v"(lo), "v"(hi)); return r; }
typedef float f32x2 __attribute__((ext_vector_type(2)));
template <class Epi, class Sched, bool ALIGN_EPI = false, bool SP2 = false, bool GATHER = false>
__device__ __forceinline__ void gemm_phase(PG8_LAS unsigned char* lds, const Gemm g, const Sched& S, const Epi& E, const PG8_LAS int* rt = nullptr) {
    int tid_ = threadIdx.x; asm volatile("" : "+v"(tid_));
    const int tid = tid_, wid = __builtin_amdgcn_readfirstlane(tid >> 6), lane = tid & 63, wr = wid >> 2, wc = wid & 3, fr = lane & 15, fq = lane >> 4;
    const int K = g.K, nt = K / BK;
    unsigned voffA[2], voffB[2];
#pragma unroll
    for (int i = 0; i < 2; ++i) { int R, C; stage_rc(tid * 16 + i * 8192, R, C); const int Rb = Epi::PERM ? ((R & ~31) + perm32(R & 31)) : R;
        voffA[i] = (unsigned)(R * K + C) * 2u; voffB[i] = (unsigned)(Rb * K + C) * 2u; }
    const size_t kstep = (size_t)(BK * 2);
    static_assert(!GATHER || SP2, "gather needs the SP2 loop");
#define PG8_GROWS(d0, d1, ui_) do { _Pragma("unroll") for (int _i = 0; _i < 2; ++_i) { int R_, C_; stage_rc(tid * 16 + _i * 8192, R_, C_); \
        d0[_i] = (unsigned)(rt[(ui_) * 256 + R_] * K + C_) * 2u; d1[_i] = (unsigned)(rt[(ui_) * 256 + 128 + R_] * K + C_) * 2u; } } while (0)
    const size_t hstep = (size_t)HALF * K * 2;
    const size_t tstep = 2 * hstep;
    const unsigned ldsw = (unsigned)wid * 1024u;
    const int aoff = lds_byte(wr * 64 + fr, fq * 8), boff = lds_byte(wc * 32 + fr, fq * 8);
#define PG8_SA(b, h) (((b) * 2 + (h)) * HTB)
#define PG8_SB(b, h) ((4 + (b) * 2 + (h)) * HTB)
#define PG8_STAGE(bufoff, gbase, voff) do { _Pragma("unroll") for (int _i = 0; _i < 2; ++_i) \
        __builtin_amdgcn_global_load_lds((const unsigned*)((const char*)(gbase) + (voff)[_i]), (PG8_LAS unsigned*)(lds + (bufoff) + ldsw + _i * 8192), 16, 0, 0); } while (0)
#define PG8_LDA(dst, b, h) do { _Pragma("unroll") for (int m = 0; m < 4; ++m) _Pragma("unroll") for (int k = 0; k < 2; ++k) dst[m][k] = *(const PG8_LAS bf16x8*)(lds + PG8_SA(b, h) + aoff + m * 2048 + k * 1024); } while (0)
#define PG8_LDB(dst, b, h) do { _Pragma("unroll") for (int n = 0; n < 2; ++n) _Pragma("unroll") for (int k = 0; k < 2; ++k) dst[n][k] = *(const PG8_LAS bf16x8*)(lds + PG8_SB(b, h) + boff + n * 2048 + k * 1024); } while (0)
#define PG8_MMA(ai, bj, At, Bt) do { __builtin_amdgcn_s_setprio(1); _Pragma("unroll") for (int m = 0; m < 4; ++m) _Pragma("unroll") for (int n = 0; n < 2; ++n) _Pragma("unroll") for (int k = 0; k < 2; ++k) \
        acc[ai][bj][m][n] = __builtin_amdgcn_mfma_f32_16x16x32_bf16(Bt[n][k], At[m][k], acc[ai][bj][m][n], 0, 0, 0); __builtin_amdgcn_s_setprio(0); } while (0)
#define PG8_WAIT_V(n) asm volatile("s_waitcnt vmcnt(" #n ")" ::: "memory")
#define PG8_WAIT_L(n) asm volatile("s_waitcnt lgkmcnt(" #n ")" ::: "memory")
#define PG8_BAR __builtin_amdgcn_s_barrier()
#define PG8_SCHED __builtin_amdgcn_sched_barrier(0)
    Unit cur, nxt;
    if (!S.next(0, cur)) return;
    f32x4 acc[2][2][4][2];
#pragma unroll
    for (int a = 0; a < 2; ++a)
#pragma unroll
        for (int b = 0; b < 2; ++b)
#pragma unroll
            for (int m = 0; m < 4; ++m)
#pragma unroll
                for (int n = 0; n < 2; ++n) acc[a][b][m][n] = (f32x4){0.f, 0.f, 0.f, 0.f};
    bf16x8 At[4][2], B0[2][2], B1[2][2];
    const char* cA = (const char*)g.A + (GATHER ? (size_t)0 : (size_t)cur.pm * tstep); const char* cB = (const char*)g.Bt + (size_t)cur.pn * tstep;
#define PG8_STAGE_A(bufoff, kbase, half, nextsel) do { if constexpr (GATHER) { unsigned o_[2]; const int un_ = ((nextsel) && has_next_) ? ui + 1 : ui; \
            _Pragma("unroll") for (int _j = 0; _j < 2; ++_j) { int R_, C_; stage_rc(tid * 16 + _j * 8192, R_, C_); o_[_j] = (unsigned)(rt[un_ * 256 + (half) * 128 + R_] * K + C_) * 2u; } \
            PG8_STAGE(bufoff, kbase, o_); } \
        else PG8_STAGE(bufoff, (kbase) + ((half) ? hstep : 0), voffA); } while (0)
    bool has_next_ = false; int ui = 0;
    S.a_ready(cur);
    if constexpr (SP2) {
        PG8_STAGE(PG8_SB(0, 0), cB, voffB); PG8_STAGE(PG8_SB(0, 1), cB + hstep, voffB); PG8_STAGE_A(PG8_SA(0, 0), cA, 0, false); PG8_STAGE_A(PG8_SA(0, 1), cA, 1, false);
        if (wr == 1) PG8_BAR;
        PG8_WAIT_V(2); PG8_BAR;
        PG8_STAGE(PG8_SB(1, 0), cB + kstep, voffB); PG8_STAGE_A(PG8_SA(1, 0), cA + kstep, 0, false); PG8_STAGE(PG8_SB(1, 1), cB + hstep + kstep, voffB);
        PG8_WAIT_V(6); PG8_BAR;
    } else {
        PG8_STAGE(PG8_SB(0, 0), cB, voffB); PG8_STAGE(PG8_SA(0, 0), cA, voffA); PG8_STAGE(PG8_SB(0, 1), cB + hstep, voffB); PG8_STAGE(PG8_SA(0, 1), cA + hstep, voffA);
        if (wr == 1) PG8_BAR;
        PG8_WAIT_V(4); PG8_BAR;
        PG8_STAGE(PG8_SB(1, 0), cB + kstep, voffB); PG8_STAGE(PG8_SA(1, 0), cA + kstep, voffA); PG8_STAGE(PG8_SB(1, 1), cB + hstep + kstep, voffB);
        PG8_WAIT_V(6); PG8_BAR;
    }
    for (;;) {
        const bool has_next = S.next(ui + 1, nxt);
        const char* nA = (has_next && !GATHER) ? (const char*)g.A + (size_t)nxt.pm * tstep : cA;
        has_next_ = has_next; const char* nB = has_next ? (const char*)g.Bt + (size_t)nxt.pn * tstep : cB;
        for (int t = 0; t < nt; t += 2) {
            const bool last = (t == nt - 2);
            const char* a1 = cA + (size_t)(t + 1) * kstep;
            const char* a2 = last ? nA : cA + (size_t)(t + 2) * kstep; const char* b2 = last ? nB : cB + (size_t)(t + 2) * kstep;
            const char* a3 = a2 + kstep; const char* b3 = b2 + kstep;
            if (last && has_next) S.a_ready(nxt);
            if constexpr (SP2) {
            PG8_LDB(B0, 0, 0); PG8_LDB(B1, 0, 1); PG8_SCHED; PG8_LDA(At, 0, 0); PG8_STAGE_A(PG8_SA(1, 1), a1, 1, false);
            PG8_WAIT_V(8); PG8_WAIT_L(0); PG8_BAR; PG8_MMA(0, 0, At, B0); PG8_MMA(0, 1, At, B1); PG8_BAR; PG8_SCHED;
            PG8_LDA(At, 0, 1); PG8_STAGE(PG8_SB(0, 0), b2, voffB); PG8_STAGE(PG8_SB(0, 1), b2 + hstep, voffB); PG8_STAGE_A(PG8_SA(0, 0), a2, 0, last);
            PG8_WAIT_V(8); PG8_WAIT_L(0); PG8_BAR; PG8_MMA(1, 0, At, B0); PG8_MMA(1, 1, At, B1); PG8_BAR; PG8_SCHED;
            PG8_LDB(B0, 1, 0); PG8_LDB(B1, 1, 1); PG8_SCHED; PG8_LDA(At, 1, 0); PG8_STAGE_A(PG8_SA(0, 1), a2, 1, last);
            PG8_WAIT_V(8); PG8_WAIT_L(0); PG8_BAR; PG8_MMA(0, 0, At, B0); PG8_MMA(0, 1, At, B1); PG8_BAR; PG8_SCHED;
            PG8_LDA(At, 1, 1); PG8_STAGE(PG8_SB(1, 0), b3, voffB); PG8_STAGE(PG8_SB(1, 1), b3 + hstep, voffB); PG8_STAGE_A(PG8_SA(1, 0), a3, 0, last);
            PG8_WAIT_V(8); PG8_WAIT_L(0); PG8_BAR; PG8_MMA(1, 0, At, B0); PG8_MMA(1, 1, At, B1); PG8_BAR; PG8_SCHED;
            } else {
            PG8_LDB(B0, 0, 0); PG8_SCHED; PG8_LDA(At, 0, 0); PG8_STAGE(PG8_SA(1, 1), a1 + hstep, voffA);
            PG8_WAIT_L(8); PG8_BAR; PG8_WAIT_L(0); PG8_MMA(0, 0, At, B0); PG8_BAR; PG8_SCHED;
            PG8_LDB(B1, 0, 1); PG8_STAGE(PG8_SB(0, 0), b2, voffB);
            PG8_BAR; PG8_WAIT_L(0); PG8_MMA(0, 1, At, B1); PG8_BAR;
            PG8_LDA(At, 0, 1); PG8_STAGE(PG8_SA(0, 0), a2, voffA);
            PG8_BAR; PG8_WAIT_L(0); PG8_MMA(1, 0, At, B0); PG8_BAR; PG8_SCHED;
            PG8_STAGE(PG8_SB(0, 1), b2 + hstep, voffB);
            PG8_WAIT_V(6); PG8_BAR; PG8_MMA(1, 1, At, B1); PG8_BAR;
            PG8_LDB(B0, 1, 0); PG8_SCHED; PG8_LDA(At, 1, 0); PG8_STAGE(PG8_SA(0, 1), a2 + hstep, voffA);
            PG8_WAIT_L(8); PG8_BAR; PG8_WAIT_L(0); PG8_MMA(0, 0, At, B0); PG8_BAR; PG8_SCHED;
            PG8_LDB(B1, 1, 1); PG8_STAGE(PG8_SB(1, 0), b3, voffB);
            PG8_BAR; PG8_WAIT_L(0); PG8_MMA(0, 1, At, B1); PG8_BAR;
            PG8_LDA(At, 1, 1); PG8_STAGE(PG8_SA(1, 0), a3, voffA);
            PG8_BAR; PG8_WAIT_L(0); PG8_MMA(1, 0, At, B0); PG8_BAR; PG8_SCHED;
            PG8_STAGE(PG8_SB(1, 1), b3 + hstep, voffB);
            PG8_WAIT_V(6); PG8_BAR; PG8_MMA(1, 1, At, B1); PG8_BAR;
            }
        }
        if constexpr (ALIGN_EPI) { if (wr == 0) PG8_BAR; }
        if constexpr (!Epi::AFTER_DRAIN) { E(acc, cur, wr, wc, fr, fq); S.done(cur); }
        if (!has_next) break;
#pragma unroll
        for (int a = 0; a < 2; ++a)
#pragma unroll
            for (int b = 0; b < 2; ++b)
#pragma unroll
                for (int m = 0; m < 4; ++m)
#pragma unroll
                    for (int n = 0; n < 2; ++n) acc[a][b][m][n] = (f32x4){0.f, 0.f, 0.f, 0.f};
        cur = nxt; cA = nA; cB = nB; ++ui;

        if constexpr (ALIGN_EPI) { if (wr == 1) PG8_BAR; }
    }
    PG8_WAIT_V(0);
    if constexpr (!ALIGN_EPI) { if (wr == 0) PG8_BAR; }
    PG8_BAR;
    if constexpr (Epi::AFTER_DRAIN) { E.fused(acc, cur, wr, wc, fr, fq, lds, wid, lane); S.done(cur); }
#undef PG8_SA
#undef PG8_STAGE_A
#undef PG8_GROWS
#undef PG8_SB
#undef PG8_STAGE
#undef PG8_LDA
#undef PG8_LDB
#undef PG8_MMA
#undef PG8_WAIT_V
#undef PG8_WAIT_L
#undef PG8_BAR
#undef PG8_SCHED
}
}

#ifndef PG8_SP2
#define PG8_SP2 true
#endif
#ifndef PG8_ALIGN
#define PG8_ALIGN true
#endif
#include <hip/hip_bf16.h>
#include <cmath>
namespace attn_body {
using bf16=__hip_bfloat16;
using bf16x8=__attribute__((ext_vector_type(8)))short;
using s16x4=__attribute__((ext_vector_type(4)))short;
using f32x16=__attribute__((ext_vector_type(16)))float;
using u32x4=__attribute__((ext_vector_type(4)))unsigned;
typedef float f32x4_t __attribute__((ext_vector_type(4)));
constexpr int BATCH=4,NHEAD=4,SEQ=8192,D=64,DM=3328,DO=1024;
constexpr int NW=8,QBLK=32,QB=QBLK*NW,KVBLK=64,NQB=SEQ/QB;
constexpr int ATTN_UNIT_ROWS=QB;
__device__ __forceinline__ int crow(int r,int hi){return (r&3)+8*(r>>2)+4*hi;}
#define SBAR() __builtin_amdgcn_sched_barrier(0)
__device__ __forceinline__ void cmask(f32x16&p0,f32x16&p1,int jb,int qrel,int hi){
  const float NEG=-INFINITY; int kb=64*jb+4*hi;
  #pragma unroll
  for(int r=0;r<16;++r){int kv=kb+(r&3)+8*(r>>2); if(kv>qrel)p0[r]=NEG; if(kv+32>qrel)p1[r]=NEG;}
}

constexpr int NSLOT=3, SLOTB=8192;
constexpr int LDS_K=0, LDS_V=NSLOT*SLOTB, LDS_WS=2*NSLOT*SLOTB, LDS_OST=LDS_WS+NW*64*4, LDS_F2=LDS_OST+NW*4096, LDS_BYTES=LDS_F2+SEQ*4;
constexpr float C2=0.125f*1.4426950408889634f;
__device__ __forceinline__ void glds16(const void*gsrc,unsigned lds_dst){unsigned keep;
  asm volatile("s_mov_b32 %0, m0\n\ts_mov_b32 m0, %2\n\ts_nop 0\n\tglobal_load_lds_dwordx4 %1, off\n\ts_mov_b32 m0, %0":"=&s"(keep):"v"(gsrc),"s"(lds_dst):"memory");}
__device__ __forceinline__ float max3f(float a,float b,float c){float r;asm("v_max3_f32 %0, %1, %2, %3":"=v"(r):"v"(a),"v"(b),"v"(c));return r;}
__device__ __forceinline__ float max2f(float a,float b){float r;asm("v_max_f32_e32 %0, %1, %2":"=v"(r):"v"(a),"v"(b));return r;}
__device__ __forceinline__ float fadd_s(float a,float b){float r;asm("v_add_f32_e32 %0, %1, %2":"=v"(r):"v"(a),"v"(b));return r;}
__device__ __forceinline__ float fsub_s(float a,float b){float r;asm("v_sub_f32_e32 %0, %1, %2":"=v"(r):"v"(a),"v"(b));return r;}
typedef float f32x2_t __attribute__((ext_vector_type(2))); typedef __bf16 bf16x2_t __attribute__((ext_vector_type(2)));
__device__ __forceinline__ unsigned cvtpk_s(float lo,float hi){f32x2_t v={lo,hi};bf16x2_t b=__builtin_convertvector(v,bf16x2_t);return __builtin_bit_cast(unsigned,b);}
#define WAIT_BAR(N) asm volatile("s_waitcnt vmcnt(" #N ") lgkmcnt(0)\n\ts_barrier":::"memory")

__device__ __forceinline__ void qkt(f32x16&p0,f32x16&p1,const char*Kslot,const bf16x8*qr,const f32x16&negm,int r32,int hi){
  const char*kb=Kslot+hi*1024+r32*16;
  #pragma unroll
  for(int d0=0;d0<4;++d0){
    const bf16x8 b0=*reinterpret_cast<const bf16x8*>(kb+d0*2048);
    const bf16x8 b1=*reinterpret_cast<const bf16x8*>(kb+d0*2048+512);
    if(d0==0){p0=__builtin_amdgcn_mfma_f32_32x32x16_bf16(b0,qr[0],negm,0,0,0);p1=__builtin_amdgcn_mfma_f32_32x32x16_bf16(b1,qr[0],negm,0,0,0);}
    else{p0=__builtin_amdgcn_mfma_f32_32x32x16_bf16(b0,qr[d0],p0,0,0,0);p1=__builtin_amdgcn_mfma_f32_32x32x16_bf16(b1,qr[d0],p1,0,0,0);}}
}
typedef __attribute__((address_space(3))) const char* lds_cptr;
typedef short v4i16_t __attribute__((ext_vector_type(4)));
__device__ __forceinline__ void kload8(bf16x8*kf,lds_cptr kp){
  kf[0]=*(const __attribute__((address_space(3))) bf16x8*)(kp);      kf[1]=*(const __attribute__((address_space(3))) bf16x8*)(kp+512);
  kf[2]=*(const __attribute__((address_space(3))) bf16x8*)(kp+2048); kf[3]=*(const __attribute__((address_space(3))) bf16x8*)(kp+2560);
  kf[4]=*(const __attribute__((address_space(3))) bf16x8*)(kp+4096); kf[5]=*(const __attribute__((address_space(3))) bf16x8*)(kp+4608);
  kf[6]=*(const __attribute__((address_space(3))) bf16x8*)(kp+6144); kf[7]=*(const __attribute__((address_space(3))) bf16x8*)(kp+6656);
}
__device__ __forceinline__ void kload2(bf16x8*kf,lds_cptr kp,int j){ kf[2*j]=*(const __attribute__((address_space(3))) bf16x8*)(kp+j*2048); kf[2*j+1]=*(const __attribute__((address_space(3))) bf16x8*)(kp+j*2048+512); }
__device__ __forceinline__ s16x4 vtr(lds_cptr p){ return __builtin_bit_cast(s16x4,__builtin_amdgcn_ds_read_tr16_b64_v4i16((__attribute__((address_space(3))) v4i16_t*)p)); }
__device__ __forceinline__ float rowmax(const f32x16&p0,const f32x16&p1){
  float a=max3f(p0[0],p0[1],p1[0]),b=max3f(p0[2],p0[3],p1[1]);a=max3f(a,p1[2],p1[3]);
  #pragma unroll
  for(int r=4;r<16;r+=4){a=max3f(a,p0[r],p0[r+1]);b=max3f(b,p0[r+2],p0[r+3]);a=max3f(a,p1[r],p1[r+1]);b=max3f(b,p1[r+2],p1[r+3]);}
  const float m=max2f(a,b);
  auto rr=__builtin_amdgcn_permlane32_swap(__float_as_uint(m),__float_as_uint(m),false,false);
  return max2f(__uint_as_float(rr[0]),__uint_as_float(rr[1]));
}
__device__ __forceinline__ void pv(f32x16*o,int vb,bf16x8 pa0,bf16x8 pa1,bf16x8 pa2,bf16x8 pa3){
  #pragma unroll
  for(int d0=0;d0<2;++d0){s16x4 lo[4],hi[4];
    #pragma unroll
    for(int ks=0;ks<4;++ks){
      asm volatile("ds_read_b64_tr_b16 %0,%1 offset:%c2":"=&v"(lo[ks]):"v"(vb),"i"(d0*4096+ks*1024):"memory");
      asm volatile("ds_read_b64_tr_b16 %0,%1 offset:%c2":"=&v"(hi[ks]):"v"(vb),"i"(d0*4096+ks*1024+512):"memory");}
    asm volatile("s_waitcnt lgkmcnt(0)":::"memory");SBAR();
    #define PK(k) (bf16x8){lo[k][0],lo[k][1],lo[k][2],lo[k][3],hi[k][0],hi[k][1],hi[k][2],hi[k][3]}
    o[d0]=__builtin_amdgcn_mfma_f32_32x32x16_bf16(pa0,PK(0),o[d0],0,0,0);
    o[d0]=__builtin_amdgcn_mfma_f32_32x32x16_bf16(pa1,PK(1),o[d0],0,0,0);
    o[d0]=__builtin_amdgcn_mfma_f32_32x32x16_bf16(pa2,PK(2),o[d0],0,0,0);
    o[d0]=__builtin_amdgcn_mfma_f32_32x32x16_bf16(pa3,PK(3),o[d0],0,0,0);
    #undef PK
  }
}

#ifndef ATTN_STORE16
#define ATTN_STORE16(p,v) (*(u32x4*)(p)=(v))
#endif
template<int THRL> __device__ __forceinline__ void attn_unit(int b,int h,int qb,const bf16*Q,const bf16*__restrict__ K,const bf16*__restrict__ V,bf16*O,const float*__restrict__ F2g,const float*__restrict__ gain,float qkb,char*shm){
  int tid_=threadIdx.x; asm volatile("":"+v"(tid_)); const int tid=tid_,lane=tid&63,r32=lane&31,hi=lane>>5; const int wid=__builtin_amdgcn_readfirstlane(tid>>6);
  const long rowbase=(long)b*SEQ; const int q0=qb*QB;
  const bf16*Qw=Q+(rowbase+q0+wid*QBLK)*DM+h*D;
  const float*f2row=F2g+((long)b*NHEAD+h)*SEQ;
  int t0;
  { const int NTf=(q0+QB)/KVBLK; const float thr=f2row[q0]+qkb+40.0f; const int ta=lane,tb=lane+64;
    const bool va=(ta<NTf-4)&&(f2row[64*ta+63]>thr), vb=(tb<NTf-4)&&(f2row[64*tb+63]>thr);
    t0=(__builtin_popcountll(__ballot(va))+__builtin_popcountll(__ballot(vb)))&~1; t0=__builtin_amdgcn_readfirstlane(t0); }
  const bf16*Kh=K+(rowbase+(long)t0*KVBLK)*DM+h*D,*Vh=V+(rowbase+(long)t0*KVBLK)*DM+h*D;
  const lds_cptr shm3=(lds_cptr)shm;
  const unsigned lds0=(unsigned)(uintptr_t)shm;
  float*wsf=(float*)(shm+LDS_WS)+wid*64;
  const bf16*ksrc=Kh+(long)lane*DM+wid*8;
  const bf16*vsrc=Vh+(long)(16*(wid&3)+(lane>>2))*DM+(wid>>2)*32+(lane&3)*8;
  const unsigned kdst=lds0+LDS_K+wid*1024, vdst=lds0+LDS_V+wid*1024;
  #define DMA_K(t,slot) glds16(ksrc+(long)(t)*KVBLK*DM,(unsigned)__builtin_amdgcn_readfirstlane(kdst+(slot)))
  #define DMA_V(t,slot) glds16(vsrc+(long)(t)*KVBLK*DM,(unsigned)__builtin_amdgcn_readfirstlane(vdst+(slot)))
  const int vb0=(int)(lds0+LDS_V)+((lane>>4)&1)*32+(lane&3)*8+(4*hi+((lane&15)>>2))*64;
  const char*Kbase=shm+LDS_K; bf16x8 kf[8];
  const lds_cptr kp0=shm3+LDS_K+hi*1024+r32*16; const lds_cptr vp0=shm3+LDS_V+((lane>>4)&1)*32+(lane&3)*8+(4*hi+((lane&15)>>2))*64;
  const int NT=(q0+QB)/KVBLK-t0;
  { const float*f2src=f2row+(long)t0*KVBLK; __attribute__((address_space(3))) float*f2l=(__attribute__((address_space(3))) float*)(shm3+LDS_F2);
    for(int i=tid;i<NT*KVBLK/4;i+=NW*64){ const f32x4_t v=*(const f32x4_t*)(f2src+4*i); *(__attribute__((address_space(3))) f32x4_t*)(f2l+4*i)=v; } }
  const __attribute__((address_space(3))) float*F2L=(const __attribute__((address_space(3))) float*)(shm3+LDS_F2)+4*hi;
  DMA_K(0,0);DMA_V(0,0);DMA_K(1,SLOTB);
  bf16x8 qr[4];
  #pragma unroll
  for(int d0=0;d0<4;++d0)qr[d0]=*reinterpret_cast<const bf16x8*>(&Qw[(long)r32*DM+d0*16+hi*8]);
  float mhat=0.f,l_reg=0.f;f32x16 o[2];o[0]=f32x16{};o[1]=f32x16{};f32x16 negm=f32x16{};asm volatile("":"+v"(negm));
  const int qrel=wid*QBLK+r32;
  #define CMASK(P0,P1,t) do{int jb_=(t)-(NT-4); if(jb_>=0)cmask(P0,P1,jb_,qrel,hi);}while(0)
  #define BIAS(P0,P1,t) do{ const __attribute__((address_space(3))) float*fb_=F2L+(t)*64; \
    const f32x4_t b00_=*(const __attribute__((address_space(3))) f32x4_t*)(fb_),    b01_=*(const __attribute__((address_space(3))) f32x4_t*)(fb_+8),  b02_=*(const __attribute__((address_space(3))) f32x4_t*)(fb_+16), b03_=*(const __attribute__((address_space(3))) f32x4_t*)(fb_+24); \
    const f32x4_t b10_=*(const __attribute__((address_space(3))) f32x4_t*)(fb_+32), b11_=*(const __attribute__((address_space(3))) f32x4_t*)(fb_+40), b12_=*(const __attribute__((address_space(3))) f32x4_t*)(fb_+48), b13_=*(const __attribute__((address_space(3))) f32x4_t*)(fb_+56); \
    _Pragma("unroll") for(int e_=0;e_<4;++e_){ P0[e_]-=b00_[e_]; P0[4+e_]-=b01_[e_]; P0[8+e_]-=b02_[e_]; P0[12+e_]-=b03_[e_]; P1[e_]-=b10_[e_]; P1[4+e_]-=b11_[e_]; P1[8+e_]-=b12_[e_]; P1[12+e_]-=b13_[e_]; } }while(0)
  bool resc=false;
  #define START(P0,P1) do{ const float rm=rowmax(P0,P1); resc=false; \
    { const float dl=rm; mhat=fadd_s(mhat,dl); \
      _Pragma("unroll") for(int r=0;r<16;++r){P0[r]=fsub_s(P0[r],dl);P1[r]=fsub_s(P1[r],dl);} \
      _Pragma("unroll") for(int r=0;r<16;++r)negm[r]=-mhat; asm volatile("":"+v"(negm)); } \
    _Pragma("unroll") for(int r=0;r<16;++r)P0[r]=__builtin_amdgcn_exp2f(P0[r]); }while(0)
  #define RESC() do{ if(resc){ asm volatile("s_waitcnt lgkmcnt(0)":::"memory"); \
      _Pragma("unroll") for(int d_=0;d_<2;++d_) _Pragma("unroll") for(int r=0;r<16;++r)o[d_][r]*=wsf[crow(r,hi)]; } }while(0)
  f32x16 pA0,pA1,pB0,pB1;
  int sl_prev=0,sl_cur=0,sl_next=SLOTB;
  #define ROT() do{sl_prev=sl_cur;sl_cur=sl_next;sl_next=(sl_next==(NSLOT-1)*SLOTB)?0:sl_next+SLOTB;}while(0)
  DMA_K(2,2*SLOTB);
  WAIT_BAR(3);
  qkt(pA0,pA1,Kbase,qr,negm,r32,hi);asm volatile("s_nop 15\n\ts_nop 7":"+v"(pA0),"+v"(pA1));BIAS(pA0,pA1,0);CMASK(pA0,pA1,0);
  START(pA0,pA1);
  _Pragma("unroll") for(int r=0;r<16;++r)pA1[r]=__builtin_amdgcn_exp2f(pA1[r]);
  WAIT_BAR(0);
  DMA_K(3,0);DMA_V(1,SLOTB);
  ROT();
  kload8(kf,kp0+sl_cur);
  WAIT_BAR(2);
  s16x4 vlo[8],vhi[8]; u32x4 pw0,pw1,pw2,pw3;
  #define PKW(P,B) cvtpk_s(P[B],P[B+1])
  #define PAF(k) __builtin_bit_cast(bf16x8,pw##k)
  #define VFR(i) (bf16x8){vlo[i][0],vlo[i][1],vlo[i][2],vlo[i][3],vhi[i][0],vhi[i][1],vhi[i][2],vhi[i][3]}
  #define PIN(x) asm volatile("":"+v"(x))
  #define MX3(a,b,c) __builtin_fmaxf(__builtin_fmaxf((a),(b)),(c))
  #define GAPA(MF,A0,A1,A2,A3,W0,W1,PW) do{ MF; sacc+=A0; sacc+=A1; sacc+=A2; sacc+=A3; PIN(sacc); W0; W1; PIN(PW); SBAR(); }while(0)
  #define EX(v) __builtin_amdgcn_exp2f(v)
  #define GAPB(MF,X,B) do{ MF; X[B]=EX(X[B]); X[B+1]=EX(X[B+1]); X[B+2]=EX(X[B+2]); X[B+3]=EX(X[B+3]); PIN(X); SBAR(); }while(0)
  #define VRD(i) do{ vlo[i]=vtr(vp_+(((i)>>2)*4096+((i)&3)*1024)); vhi[i]=vtr(vp_+(((i)>>2)*4096+((i)&3)*1024+512)); }while(0)
  #define KRD(G,j) do{ if(G){ kload2(kf,kp0+sl_next,j); SBAR(); } }while(0)
  #define STEP(C0,C1,P0,P1,t,GK,GV,GL) do{ SBAR(); \
    const lds_cptr vp_=vp0+sl_prev; \
    VRD(0); SBAR(); float sacc=(P0[0]+P0[1]); \
    GAPA(C0=__builtin_amdgcn_mfma_f32_32x32x16_bf16(kf[0],qr[0],negm,0,0,0), P0[2],P0[3],P0[4],P0[5],     pw0[0]=PKW(P0,0), pw0[1]=PKW(P0,2), pw0); \
    VRD(4); SBAR(); GAPA(C1=__builtin_amdgcn_mfma_f32_32x32x16_bf16(kf[1],qr[0],negm,0,0,0), P0[6],P0[7],P0[8],P0[9],     pw0[2]=PKW(P0,4), pw0[3]=PKW(P0,6), pw0); \
    VRD(1); SBAR(); GAPA(C0=__builtin_amdgcn_mfma_f32_32x32x16_bf16(kf[2],qr[1],C0,0,0,0),   P0[10],P0[11],P0[12],P0[13], pw1[0]=PKW(P0,8), pw1[1]=PKW(P0,10), pw1); \
    VRD(5); SBAR(); GAPA(C1=__builtin_amdgcn_mfma_f32_32x32x16_bf16(kf[3],qr[1],C1,0,0,0),   P0[14],P0[15],P1[0],P1[1],   pw1[2]=PKW(P0,12),pw1[3]=PKW(P0,14), pw1); \
    VRD(2); SBAR(); GAPA(C0=__builtin_amdgcn_mfma_f32_32x32x16_bf16(kf[4],qr[2],C0,0,0,0),   P1[2],P1[3],P1[4],P1[5],     pw2[0]=PKW(P1,0), pw2[1]=PKW(P1,2), pw2); \
    VRD(6); SBAR(); GAPA(C1=__builtin_amdgcn_mfma_f32_32x32x16_bf16(kf[5],qr[2],C1,0,0,0),   P1[6],P1[7],P1[8],P1[9],     pw2[2]=PKW(P1,4), pw2[3]=PKW(P1,6), pw2); \
    VRD(3); SBAR(); GAPA(C0=__builtin_amdgcn_mfma_f32_32x32x16_bf16(kf[6],qr[3],C0,0,0,0),   P1[10],P1[11],P1[12],P1[13], pw3[0]=PKW(P1,8), pw3[1]=PKW(P1,10), pw3); \
    VRD(7); SBAR(); GAPA(C1=__builtin_amdgcn_mfma_f32_32x32x16_bf16(kf[7],qr[3],C1,0,0,0),   P1[14],P1[15],0.f,0.f,       pw3[2]=PKW(P1,12),pw3[3]=PKW(P1,14), pw3); \
    l_reg+=sacc; \
    if(GK){DMA_K((t)+3,sl_cur);} if(GV){DMA_V((t)+1,sl_next);} \
    BIAS(C0,C1,t); CMASK(C0,C1,t); \
    { float a=MX3(C0[0],C0[1],C1[0]),b=MX3(C0[2],C0[3],C1[1]); a=MX3(a,C1[2],C1[3]); \
      _Pragma("unroll") for(int r=4;r<16;r+=4){a=MX3(a,C0[r],C0[r+1]);b=MX3(b,C0[r+2],C0[r+3]);a=MX3(a,C1[r],C1[r+1]);b=MX3(b,C1[r+2],C1[r+3]);} \
      float rm=__builtin_fmaxf(a,b); { auto rr=__builtin_amdgcn_permlane32_swap(__float_as_uint(rm),__float_as_uint(rm),false,false); rm=__builtin_fmaxf(__uint_as_float(rr[0]),__uint_as_float(rr[1])); } \
      resc=false; \
      if(__builtin_expect(__any(rm>(float)THRL),0)){ const float dl=__builtin_fmaxf(rm,0.f); mhat+=dl; \
        _Pragma("unroll") for(int r=0;r<16;++r){C0[r]-=dl;C1[r]-=dl;} \
        _Pragma("unroll") for(int r=0;r<16;++r)negm[r]=-mhat; asm volatile("":"+v"(negm)); \
        const float f=__builtin_amdgcn_exp2f(-dl); l_reg*=f; if(hi==0)wsf[r32]=f; resc=true; } } \
    SBAR(); \
    GAPB(o[0]=__builtin_amdgcn_mfma_f32_32x32x16_bf16(PAF(0),VFR(0),o[0],0,0,0), C0,0); \
    GAPB(o[1]=__builtin_amdgcn_mfma_f32_32x32x16_bf16(PAF(0),VFR(4),o[1],0,0,0), C0,4); \
    KRD(GL,0); GAPB(o[0]=__builtin_amdgcn_mfma_f32_32x32x16_bf16(PAF(1),VFR(1),o[0],0,0,0), C0,8); \
    KRD(GL,1); GAPB(o[1]=__builtin_amdgcn_mfma_f32_32x32x16_bf16(PAF(1),VFR(5),o[1],0,0,0), C0,12); \
    KRD(GL,2); GAPB(o[0]=__builtin_amdgcn_mfma_f32_32x32x16_bf16(PAF(2),VFR(2),o[0],0,0,0), C1,0); \
    KRD(GL,3); GAPB(o[1]=__builtin_amdgcn_mfma_f32_32x32x16_bf16(PAF(2),VFR(6),o[1],0,0,0), C1,4); \
    GAPB(o[0]=__builtin_amdgcn_mfma_f32_32x32x16_bf16(PAF(3),VFR(3),o[0],0,0,0), C1,8); \
    GAPB(o[1]=__builtin_amdgcn_mfma_f32_32x32x16_bf16(PAF(3),VFR(7),o[1],0,0,0), C1,12); \
    }while(0)
  int t=1;
  #undef CMASK
  #define CMASK(P0,P1,t) do{}while(0)
  for(;t+5<NT;t+=2){
    STEP(pB0,pB1,pA0,pA1,t,true,true,true);     WAIT_BAR(2); RESC(); ROT();
    STEP(pA0,pA1,pB0,pB1,t+1,true,true,true);   WAIT_BAR(2); RESC(); ROT();
  }
  #undef CMASK
  #define CMASK(P0,P1,t) do{int jb_=(t)-(NT-4); if(jb_>=0)cmask(P0,P1,jb_,qrel,hi);}while(0)
  #define ENDW(tt) do{ if((tt)+3<NT){WAIT_BAR(2);} else if((tt)+2<NT){WAIT_BAR(1);} else {WAIT_BAR(0);} }while(0)
  for(;t+1<NT;t+=2){
    STEP(pB0,pB1,pA0,pA1,t,(t+3<NT),(t+1<NT),(t+1<NT));       ENDW(t);   RESC(); ROT();
    STEP(pA0,pA1,pB0,pB1,t+1,(t+4<NT),(t+2<NT),(t+2<NT));     ENDW(t+1); RESC(); ROT();
  }
  STEP(pB0,pB1,pA0,pA1,NT-1,false,false,false); RESC();
  { float sacc=pB0[0]+pB0[1]; _Pragma("unroll") for(int r=2;r<16;++r)sacc+=pB0[r]; _Pragma("unroll") for(int r=0;r<16;++r)sacc+=pB1[r]; l_reg+=sacc;
    pw0=(u32x4){PKW(pB0,0),PKW(pB0,2),PKW(pB0,4),PKW(pB0,6)};pw1=(u32x4){PKW(pB0,8),PKW(pB0,10),PKW(pB0,12),PKW(pB0,14)};pw2=(u32x4){PKW(pB1,0),PKW(pB1,2),PKW(pB1,4),PKW(pB1,6)};pw3=(u32x4){PKW(pB1,8),PKW(pB1,10),PKW(pB1,12),PKW(pB1,14)};
    SBAR(); pv(o,vb0+sl_cur,PAF(0),PAF(1),PAF(2),PAF(3)); }
  #undef PKW
  #undef PAF
  #undef VFR
  #undef PIN
  #undef MX3
  #undef GAPA
  #undef GAPB
  #undef EX
  #undef VRD
  #undef KRD
  #undef STEP
  #undef ENDW
  {auto rr=__builtin_amdgcn_permlane32_swap(__float_as_uint(l_reg),__float_as_uint(l_reg),false,false);l_reg=__uint_as_float(rr[0])+__uint_as_float(rr[1]);}
  if(hi==0)wsf[32+r32]=l_reg;asm volatile("s_waitcnt lgkmcnt(0)":::"memory");
  float rli[16];
  #pragma unroll
  for(int r=0;r<16;++r)rli[r]=__builtin_amdgcn_rcpf(wsf[32+crow(r,hi)]);
  bf16*Ow=O+(rowbase+q0+wid*QBLK)*DO+h*D;
  { bf16*stg=(bf16*)(shm+LDS_OST)+wid*2048;
    #pragma unroll
    for(int r=0;r<16;++r){const int orow=crow(r,hi);
      #pragma unroll
      for(int d0=0;d0<2;++d0)stg[orow*64+d0*32+r32]=__float2bfloat16(o[d0][r]*rli[r]);}
    asm volatile("s_waitcnt lgkmcnt(0)":::"memory");
    const f32x4_t g0=*(const f32x4_t*)(gain+h*D+(lane&7)*8), g1=*(const f32x4_t*)(gain+h*D+(lane&7)*8+4);
    #pragma unroll
    for(int i=0;i<4;++i){const int row=i*8+(lane>>3),ch=lane&7; const u32x4 v=*(const u32x4*)(stg+row*64+ch*8);
      float x[8];
      #pragma unroll
      for(int e=0;e<4;++e){ x[2*e]=__uint_as_float(v[e]<<16); x[2*e+1]=__uint_as_float(v[e]&0xffff0000u); }
      float ss=0.f;
      #pragma unroll
      for(int e=0;e<8;++e)ss+=x[e]*x[e];
      ss+=__int_as_float(__builtin_amdgcn_ds_bpermute((lane^1)<<2,__float_as_int(ss))); ss+=__int_as_float(__builtin_amdgcn_ds_bpermute((lane^2)<<2,__float_as_int(ss))); ss+=__int_as_float(__builtin_amdgcn_ds_bpermute((lane^4)<<2,__float_as_int(ss)));
      const float rs=rsqrtf(ss*(1.0f/64.0f)+1e-6f);
      u32x4 w; w[0]=cvtpk_s(x[0]*rs*g0[0],x[1]*rs*g0[1]); w[1]=cvtpk_s(x[2]*rs*g0[2],x[3]*rs*g0[3]); w[2]=cvtpk_s(x[4]*rs*g1[0],x[5]*rs*g1[1]); w[3]=cvtpk_s(x[6]*rs*g1[2],x[7]*rs*g1[3]);
      ATTN_STORE16(Ow+(long)row*DO+ch*8,w);} }
  asm volatile("s_waitcnt lgkmcnt(0)\n\ts_barrier":::"memory");
  #undef DMA_K
  #undef DMA_V
  #undef CMASK
  #undef START
  #undef RESC
  #undef ROT
}
constexpr int ATTN_LDS_BYTES=LDS_BYTES;
struct AttnTensors { const bf16* Q; const bf16* K; const bf16* V; bf16* O; const float* F2; const float* gain; const unsigned* qkn; };
struct AttnUnit { int bh; int qb; };
struct StaticOrder {
  int vcu, G;
  __device__ __forceinline__ explicit StaticOrder(int grid,int block):vcu((grid%8==0)?(block%8)*(grid/8)+block/8:block),G(grid){}
  __device__ __forceinline__ bool next(int i,AttnUnit&u)const{ const int pair=vcu+(i>>1)*G; if(pair>=256)return false; const int s=pair&15; u.bh=pair>>4; u.qb=(i&1)?31-s:s; return true; }
  __device__ __forceinline__ void a_ready(const AttnUnit&)const{}
  __device__ __forceinline__ void done(const AttnUnit&)const{}
};
template<class Sched,int THRL=8> __device__ __forceinline__ void attn_phase(char*lds,const AttnTensors&T,const Sched&S){
  AttnUnit u;
  for(int i=0;S.next(i,u);++i){ S.a_ready(u); attn_unit<THRL>(u.bh/NHEAD,u.bh%NHEAD,u.qb,T.Q,T.K,T.V,T.O,T.F2,T.gain,2.0f*sqrtf(__uint_as_float(T.qkn[2*u.bh])*__uint_as_float(T.qkn[2*u.bh+1])),lds); S.done(u); }
}
#undef SBAR
#undef WAIT_BAR
}
#define GAS __attribute__((address_space(1)))
#define LAS __attribute__((address_space(3)))
typedef unsigned short bf16;
typedef unsigned v4u __attribute__((ext_vector_type(4)));
typedef float f32x4 __attribute__((ext_vector_type(4)));
typedef short bf16x8 __attribute__((ext_vector_type(8)));
typedef GAS unsigned gu32;
typedef GAS unsigned long long gu64;
#define RLX_AGENT __ATOMIC_RELAXED, __HIP_MEMORY_SCOPE_AGENT
#define LDS_WAIT() asm volatile("s_waitcnt lgkmcnt(0)" ::: "memory")
#define VM_WAIT() asm volatile("s_waitcnt vmcnt(0)" ::: "memory")
__device__ __forceinline__ unsigned long long rt() { return __builtin_amdgcn_s_memrealtime(); }
__device__ __forceinline__ unsigned f2bf(float f) { unsigned u = __builtin_bit_cast(unsigned, f); return (u + 0x7fffu + ((u >> 16) & 1u)) >> 16; }
__device__ __forceinline__ unsigned pk2(float lo, float hi) { return f2bf(lo) | (f2bf(hi) << 16); }

#define XB_TMO      128
#define XB_XCNT(j)  (256  + 64 * (j))
#define XB_XSUB(j)  (1280 + 64 * (j))
#define XB_XGEN(j)  (2304 + 64 * (j))
#define XB_TOP      3328
#define XB_TOPGEN   3392
#define XCD_BAR_WORDS 3456
#define XB_SPIN_CAP (1u << 18)
#ifndef XB_SCOPE
#define XB_SCOPE ""
#endif

__device__ __forceinline__ unsigned xb_ld(unsigned* p)              { return __hip_atomic_load(p, __ATOMIC_RELAXED, __HIP_MEMORY_SCOPE_AGENT); }
__device__ __forceinline__ unsigned xb_add(unsigned* p, unsigned v) { return __hip_atomic_fetch_add(p, v, __ATOMIC_RELAXED, __HIP_MEMORY_SCOPE_AGENT); }
__device__ __forceinline__ unsigned xb_xcc_id() { return (unsigned)__builtin_amdgcn_s_getreg((3 << 11) | 20) & 0xFu; }
#define XB_SPIN(cond, bar) do { unsigned _sp = 0; while (cond) { __builtin_amdgcn_s_sleep(1); \
    if ((++_sp & 255u) == 0u) { if (xb_ld(&(bar)[XB_TMO])) break; if (_sp > XB_SPIN_CAP) { atomicAdd(&(bar)[XB_TMO], 1u); break; } } } } while (0)

struct XcdBarrier {
    unsigned* bar; unsigned x;
    volatile LAS unsigned* st;
};

__device__ __forceinline__ XcdBarrier xcd_barrier_post(unsigned* bar, volatile LAS unsigned* st) {
    XcdBarrier b; b.bar = bar; b.x = xb_xcc_id(); b.st = st;
    if (threadIdx.x == 0) (void)xb_add(&bar[XB_XCNT(b.x)], 1u);
    return b;
}
__device__ __forceinline__ void xcd_barrier_complete(unsigned* bar, unsigned x, unsigned& nloc, unsigned& nx) {
    const unsigned G = gridDim.x * gridDim.y * gridDim.z;
    unsigned sum, cnt, mine, sp = 0u;
    for (;;) {
        sum = 0u; cnt = 0u; mine = 0u;
#pragma unroll
        for (unsigned j = 0; j < 16; ++j) { const unsigned c = xb_ld(&bar[XB_XCNT(j)]); sum += c; cnt += (c > 0u) ? 1u : 0u; mine = (j == x) ? c : mine; }
        if (sum == G) break;
        __builtin_amdgcn_s_sleep(1);
        if ((++sp & 255u) == 0u) { if (xb_ld(&bar[XB_TMO])) break; if (sp > XB_SPIN_CAP) { atomicAdd(&bar[XB_TMO], 1u); break; } }
    }
    nloc = mine > 0u ? mine : 1u; nx = cnt > 0u ? cnt : 1u;
}

__device__ __forceinline__ void xcd_barrier(const XcdBarrier& b) {
    asm volatile("s_waitcnt vmcnt(0)" ::: "memory");
    __syncthreads();
    if (threadIdx.x == 0) {
        unsigned* bar = b.bar;
        __builtin_amdgcn_s_waitcnt(0);
        unsigned nloc = b.st[0], nx = b.st[1];
        if (nloc == 0u) { xcd_barrier_complete(bar, b.x, nloc, nx); b.st[0] = nloc; b.st[1] = nx; }
        const unsigned old = xb_add(&bar[XB_XSUB(b.x)], 1u);
        const unsigned gen = old / nloc;
        if (old + 1u == (gen + 1u) * nloc) {
            __builtin_amdgcn_fence(__ATOMIC_RELEASE, XB_SCOPE);
            asm volatile("s_waitcnt vmcnt(0)" ::: "memory");
            const unsigned og = xb_add(&bar[XB_TOP], 1u);
            const unsigned tg = og / nx;
            if (og + 1u == (tg + 1u) * nx) xb_add(&bar[XB_TOPGEN], 1u);
            else XB_SPIN(xb_ld(&bar[XB_TOPGEN]) == tg, bar);
            __builtin_amdgcn_fence(__ATOMIC_ACQUIRE, XB_SCOPE);
            xb_add(&bar[XB_XGEN(b.x)], 1u);
            asm volatile("s_waitcnt vmcnt(0)" ::: "memory");
        } else {
            XB_SPIN(xb_ld(&bar[XB_XGEN(b.x)]) == gen, bar);
            __builtin_amdgcn_fence(__ATOMIC_ACQUIRE, XB_SCOPE);
            asm volatile("s_waitcnt vmcnt(0)" ::: "memory");
        }
    }
    __syncthreads();
}

constexpr int NWAVES = 8;
constexpr int T = 32768, D = 1024, SEQ = 8192, NBATCH = 4, NLAYER = 4, CHUNK = 128, NCHUNK = T / CHUNK, CPB = SEQ / CHUNK;
constexpr int DINP = 3344, PP = 3328, NPROJ_T = 3584;
constexpr int O_AQ = 0, O_AK = 256, O_AV = 512, O_SU = 768, O_SV = 1024, O_MZ = 1280, O_LQ = 2304, O_LK = 2560, O_LV = 2816, O_LO = 3072;
constexpr int O_XBC = 1536;
constexpr int XC = 768;
constexpr int NEXP = 32, DEXP = 512, MOE_TILES = 288, MOE_ROWS = MOE_TILES * 256;
constexpr float NORM_EPS = 1e-6f;
constexpr float ATT_C2 = 0.125f * 1.4426950408889634f;
constexpr float LOG2E = 1.4426950408889634f;

constexpr size_t MiB = 1u << 20;
constexpr size_t WS_CTL = 0, CTL_ZERO_BYTES = 256 * 1024;
constexpr size_t WS_MOD = 1 * MiB;
constexpr size_t WS_F2 = 2 * MiB;
constexpr size_t WS_SMALL = 3 * MiB;
constexpr size_t WS_TOK = 4 * MiB;
constexpr size_t WS_GATES = 5 * MiB;
constexpr size_t WS_WR = 7 * MiB;
constexpr size_t WS_WIN = 8 * MiB;
constexpr size_t WS_WOUT = 15 * MiB;
constexpr size_t WS_WGU = 17 * MiB;
constexpr size_t WS_WDN = 81 * MiB;
constexpr size_t WS_H = 113 * MiB;
constexpr size_t WS_PROJ = 177 * MiB;
constexpr size_t WS_Y = 385 * MiB;
constexpr size_t WS_XBCC = 449 * MiB;
constexpr size_t WS_SST = 497 * MiB;
constexpr size_t WS_SHIN = 529 * MiB;
constexpr size_t WS_MLS = 545 * MiB;
constexpr size_t WS_MLC = 565 * MiB;
constexpr size_t WS_XB = 575 * MiB;
constexpr size_t WS_ACT = 719 * MiB;
constexpr size_t WS_YB = 791 * MiB;
constexpr size_t WS_XDT = 935 * MiB;
constexpr size_t WS_SLOT = 951 * MiB;
constexpr size_t WS_XRES = 985 * MiB;
constexpr size_t WS_END = 1049 * MiB;
constexpr int CW_TMO = 0, CW_BAR = 4096, CW_QKN = 8192  , CW_Q = 8192 + 1024  , CW_QX = 8192 + 4096  , CW_PAN = 16384  , CW_CVQ = 8192 + 2048  ;
constexpr size_t EXP_ALT = 558 * MiB;
constexpr int RING_BYTES = 131072, MISC_OFF = RING_BYTES + 320, LDS_BYTES = 147456;

#define DI __device__ __forceinline__
typedef unsigned v2u __attribute__((ext_vector_type(2)));
namespace pg8 {
struct EpiProj { static constexpr bool PERM = true, AFTER_DRAIN = false;
    bf16_t* P; float* G;
    __device__ __forceinline__ void operator()(const f32x4 (&acc)[2][2][4][2], const Unit& u, int wr, int wc, int fr, int fq) const {
        const int row0 = u.pm * BM + wr * 64 + fr;
        if (u.pn < 13) {
            const int col0 = u.pn * BM + wc * 32 + 8 * fq;
#pragma unroll
            for (int ai = 0; ai < 2; ++ai)
#pragma unroll
                for (int m = 0; m < 4; ++m) { bf16_t* rowp = P + (size_t)(row0 + ai * HALF + m * 16) * 3328 + col0;
#pragma unroll
                    for (int bj = 0; bj < 2; ++bj) { const f32x4 v0 = acc[ai][bj][m][0], v1 = acc[ai][bj][m][1];
                        u32x4 w; w.x = cvt_pk_bf16(v0[0], v0[1]); w.y = cvt_pk_bf16(v0[2], v0[3]); w.z = cvt_pk_bf16(v1[0], v1[1]); w.w = cvt_pk_bf16(v1[2], v1[3]);
                        *(u32x4*)(rowp + bj * HALF) = w; } }
        } else if (wc == 0 && fq < 2) {
#pragma unroll
            for (int ai = 0; ai < 2; ++ai)
#pragma unroll
                for (int m = 0; m < 4; ++m) { float* gp = G + (size_t)(row0 + ai * HALF + m * 16) * 16 + 8 * fq;
                    *(f32x4*)(gp) = acc[ai][0][m][0]; *(f32x4*)(gp + 4) = acc[ai][0][m][1]; }
        }
    }
};
struct EpiOut { static constexpr bool PERM = true, AFTER_DRAIN = false;
    bf16_t* X; const float* gate;
    __device__ __forceinline__ void operator()(const f32x4 (&acc)[2][2][4][2], const Unit& u, int wr, int wc, int fr, int fq) const {
        const int row0 = u.pm * BM + wr * 64 + fr, col0 = u.pn * BM + wc * 32 + 8 * fq;
        const float* gb = gate + (size_t)((u.pm * BM) >> 13) * 6144 + col0;
        f32x4 gv[2][2];
#pragma unroll
        for (int bj = 0; bj < 2; ++bj)
#pragma unroll
            for (int n = 0; n < 2; ++n) gv[bj][n] = *(const f32x4*)(gb + bj * HALF + n * 4);
#pragma unroll
        for (int ai = 0; ai < 2; ++ai)
#pragma unroll
            for (int m = 0; m < 4; ++m) { bf16_t* rowp = X + (size_t)(row0 + ai * HALF + m * 16) * 1024 + col0;
#pragma unroll
                for (int bj = 0; bj < 2; ++bj) { const u32x4 xr = *(const u32x4*)(rowp + bj * HALF);
                    f32x4 x0, x1; x0[0] = __uint_as_float(xr.x << 16); x0[1] = __uint_as_float(xr.x & 0xffff0000u); x0[2] = __uint_as_float(xr.y << 16); x0[3] = __uint_as_float(xr.y & 0xffff0000u);
                    x1[0] = __uint_as_float(xr.z << 16); x1[1] = __uint_as_float(xr.z & 0xffff0000u); x1[2] = __uint_as_float(xr.w << 16); x1[3] = __uint_as_float(xr.w & 0xffff0000u);
                    x0 = x0 + gv[bj][0] * acc[ai][bj][m][0]; x1 = x1 + gv[bj][1] * acc[ai][bj][m][1];
                    u32x4 w; w.x = cvt_pk_bf16(x0[0], x0[1]); w.y = cvt_pk_bf16(x0[2], x0[3]); w.z = cvt_pk_bf16(x1[0], x1[1]); w.w = cvt_pk_bf16(x1[2], x1[3]);
                    *(u32x4*)(rowp + bj * HALF) = w; } }
    }
};
struct EpiOutNorm { static constexpr bool PERM = false, AFTER_DRAIN = true;
    float* X; const float* gate; const float* w2; const float* shift2; const float* scale2; bf16_t* Hout; float* slots; unsigned* cnt; unsigned* tmo;
    __device__ __forceinline__ void fused(f32x4 (&acc)[2][2][4][2], const Unit& u, int wr, int wc, int fr, int fq, PG8_LAS unsigned char* lds, int wid, int lane) const {
        PG8_LAS float* P = (PG8_LAS float*)lds;
        PG8_LAS float* S = (PG8_LAS float*)(lds + 4096);
        const int row0 = u.pm * BM + wr * 64 + fr, col0 = u.pn * BM + wc * 32 + 4 * fq; const size_t bo = (size_t)((u.pm * BM) >> 13) * 6144;
#pragma unroll
        for (int ai = 0; ai < 2; ++ai)
#pragma unroll
            for (int m = 0; m < 4; ++m) { float* rowp = X + (size_t)(row0 + ai * HALF + m * 16) * 1024 + col0; float ss = 0.f;
#pragma unroll
                for (int bj = 0; bj < 2; ++bj)
#pragma unroll
                    for (int n = 0; n < 2; ++n) { const f32x4 x = *(const f32x4*)(rowp + bj * HALF + n * 16), g = *(const f32x4*)(gate + bo + col0 + bj * HALF + n * 16);
                        const f32x4 v = x + g * acc[ai][bj][m][n]; acc[ai][bj][m][n] = v; *(f32x4*)(rowp + bj * HALF + n * 16) = v; ss += (v[0] * v[0] + v[1] * v[1]) + (v[2] * v[2] + v[3] * v[3]); }
                ss += __int_as_float(__builtin_amdgcn_ds_bpermute((lane ^ 16) << 2, __float_as_int(ss))); ss += __int_as_float(__builtin_amdgcn_ds_bpermute((lane ^ 32) << 2, __float_as_int(ss)));
                if (fq == 0) P[(ai * HALF + wr * 64 + m * 16 + fr) * 4 + wc] = ss; }
        asm volatile("s_waitcnt lgkmcnt(0)" ::: "memory"); __builtin_amdgcn_s_barrier(); asm volatile("" ::: "memory");
        const int row = wid * 32 + (lane & 31);
        if (lane < 32) { const float t = (P[row * 4 + 0] + P[row * 4 + 1]) + (P[row * 4 + 2] + P[row * 4 + 3]);
            __hip_atomic_store((unsigned*)slots + ((size_t)(u.pm * BM + row) * 4 + u.pn), __float_as_uint(t), __ATOMIC_RELAXED, __HIP_MEMORY_SCOPE_AGENT); }
        asm volatile("s_waitcnt vmcnt(0)" ::: "memory");
        if (lane == 0) __hip_atomic_fetch_add(cnt + 64 * u.pm, 1u, __ATOMIC_RELAXED, __HIP_MEMORY_SCOPE_AGENT);
        if (wid == 0) { const unsigned long long t0 = __builtin_amdgcn_s_memrealtime();
            for (;;) { if ((unsigned)__builtin_amdgcn_readfirstlane(__hip_atomic_load(cnt + 64 * u.pm, __ATOMIC_RELAXED, __HIP_MEMORY_SCOPE_AGENT)) >= 32u) break;
                if (__builtin_amdgcn_s_memrealtime() - t0 > 2000000ull) { if (lane == 0) __hip_atomic_store(tmo, 1u, __ATOMIC_RELAXED, __HIP_MEMORY_SCOPE_AGENT); break; }
                __builtin_amdgcn_s_sleep(2); }
            __builtin_amdgcn_fence(__ATOMIC_ACQUIRE, "agent"); }
        asm volatile("s_waitcnt vmcnt(0) lgkmcnt(0)" ::: "memory"); __builtin_amdgcn_s_barrier(); asm volatile("" ::: "memory");
        if (lane < 32) { const unsigned* sl = (const unsigned*)slots + (size_t)(u.pm * BM + row) * 4; float t4[4];
#pragma unroll
            for (int t = 0; t < 4; ++t) t4[t] = __uint_as_float(__hip_atomic_load(sl + t, __ATOMIC_RELAXED, __HIP_MEMORY_SCOPE_AGENT));
            S[row] = rsqrtf(((t4[0] + t4[1]) + (t4[2] + t4[3])) * (1.0f / 1024.0f) + 1e-6f); }
        asm volatile("s_waitcnt lgkmcnt(0)" ::: "memory"); __builtin_amdgcn_s_barrier(); asm volatile("" ::: "memory");
        f32x4 wv[2][2], sc[2][2], sh[2][2];
#pragma unroll
        for (int bj = 0; bj < 2; ++bj)
#pragma unroll
            for (int n = 0; n < 2; ++n) { const int c = col0 + bj * HALF + n * 16; wv[bj][n] = *(const f32x4*)(w2 + c); sc[bj][n] = *(const f32x4*)(scale2 + bo + c) + 1.f; sh[bj][n] = *(const f32x4*)(shift2 + bo + c); wv[bj][n] = wv[bj][n] * sc[bj][n]; }
#pragma unroll
        for (int ai = 0; ai < 2; ++ai)
#pragma unroll
            for (int m = 0; m < 4; ++m) { const int r = ai * HALF + wr * 64 + m * 16 + fr; const float rs = S[r]; bf16_t* hp = Hout + (size_t)(u.pm * BM + r) * 1024 + col0;
#pragma unroll
                for (int bj = 0; bj < 2; ++bj)
#pragma unroll
                    for (int n = 0; n < 2; ++n) { const f32x4 h = acc[ai][bj][m][n] * rs * wv[bj][n] + sh[bj][n];
                        typedef unsigned u32x2 __attribute__((ext_vector_type(2))); u32x2 w; w.x = cvt_pk_bf16(h[0], h[1]); w.y = cvt_pk_bf16(h[2], h[3]);
                        *(u32x2*)(hp + bj * HALF + n * 16) = w; } }
    }
};
struct OneRound { StaticOrder so; int round;
    __device__ __forceinline__ bool next(int i, Unit& u) const { return i == 0 && so.next(round, u); }
    __device__ __forceinline__ void a_ready(const Unit&) const {}
    __device__ __forceinline__ void done(const Unit&) const {}
};
struct EpiGU { static constexpr bool PERM = true, AFTER_DRAIN = false;
    bf16_t* A;
    __device__ __forceinline__ void operator()(const f32x4 (&acc)[2][2][4][2], const Unit& u, int wr, int wc, int fr, int fq) const {
        const int row0 = u.pm * BM + wr * 64 + fr, col0 = (u.pn & 3) * 128 + wc * 16 + 4 * fq;
#pragma unroll
        for (int ai = 0; ai < 2; ++ai)
#pragma unroll
            for (int m = 0; m < 4; ++m) { bf16_t* rowp = A + (size_t)(row0 + ai * HALF + m * 16) * 512 + col0;
#pragma unroll
                for (int bj = 0; bj < 2; ++bj) { const f32x4 g = acc[ai][bj][m][0], up = acc[ai][bj][m][1]; f32x4 a;
#pragma unroll
                    for (int e = 0; e < 4; ++e) a[e] = g[e] * __builtin_amdgcn_rcpf(1.f + __expf(-g[e])) * up[e];
                    typedef unsigned u32x2 __attribute__((ext_vector_type(2)));
                    u32x2 w; w.x = cvt_pk_bf16(a[0], a[1]); w.y = cvt_pk_bf16(a[2], a[3]);
                    *(u32x2*)(rowp + bj * 64) = w; } }
    }
};
struct EpiDown { static constexpr bool PERM = true, AFTER_DRAIN = false;
    bf16_t* Yb;
    __device__ __forceinline__ void operator()(const f32x4 (&acc)[2][2][4][2], const Unit& u, int wr, int wc, int fr, int fq) const {
        const int row0 = u.pm * BM + wr * 64 + fr, col0 = (u.pn & 3) * BM + wc * 32 + 8 * fq;
#pragma unroll
        for (int ai = 0; ai < 2; ++ai)
#pragma unroll
            for (int m = 0; m < 4; ++m) { bf16_t* rowp = Yb + (size_t)(row0 + ai * HALF + m * 16) * 1024 + col0;
#pragma unroll
                for (int bj = 0; bj < 2; ++bj) { const f32x4 v0 = acc[ai][bj][m][0], v1 = acc[ai][bj][m][1];
                    u32x4 w; w.x = cvt_pk_bf16(v0[0], v0[1]); w.y = cvt_pk_bf16(v0[2], v0[3]); w.z = cvt_pk_bf16(v1[0], v1[1]); w.w = cvt_pk_bf16(v1[2], v1[3]);
                    *(u32x4*)(rowp + bj * HALF) = w; } }
    }
};
struct MoeOrder {
    int G, c; const PG8_LAS int* xt;
    __device__ __forceinline__ bool next(int i, Unit& u) const {
        int ul = i * (G >> 3) + (c >> 3);
        if (ul >= xt[4]) return false;
        const int s = (ul >= xt[1] ? 1 : 0) + (ul >= xt[2] ? 1 : 0) + (ul >= xt[3] ? 1 : 0);
        ul -= xt[s];
        u.pm = xt[8 + s] + (ul >> 2); u.pn = 4 * ((c & 7) + 8 * s) + (ul & 3); return true;
    }
    __device__ __forceinline__ void a_ready(const Unit&) const {}
    __device__ __forceinline__ void done(const Unit&) const {}
};
}

DI float bf2f(unsigned b) { return __uint_as_float(b << 16); }
typedef float f32x2h_t __attribute__((ext_vector_type(2))); typedef __bf16 bf16x2h_t __attribute__((ext_vector_type(2)));
DI unsigned pk2h(float lo, float hi) { const f32x2h_t v = {lo, hi}; return __builtin_bit_cast(unsigned, __builtin_convertvector(v, bf16x2h_t)); }
DI float silu_f(float x) { return x * __builtin_amdgcn_rcpf(1.f + __expf(-x)); }
DI float sigmoid_f(float x) { return __builtin_amdgcn_rcpf(1.f + __expf(-x)); }
DI float gelu_tanh_f(float x) { const float z = 0.7978845608028654f * (x + 0.044715f * x * x * x); return x * __builtin_amdgcn_rcpf(1.f + __expf(-2.f * z)); }
DI float log_sigmoid_f(float x) { return fminf(x, 0.f) - log1pf(__expf(-fabsf(x))); }
DI float softplus_f(float x) { return fmaxf(x, 0.f) + log1pf(__expf(-fabsf(x))); }
DI float shx(float v, int o, int lane) { return __int_as_float(__builtin_amdgcn_ds_bpermute((lane ^ o) << 2, __float_as_int(v))); }
DI float shup(float v, int o, int lane) { return __int_as_float(__builtin_amdgcn_ds_bpermute(((lane - o) & 63) << 2, __float_as_int(v))); }
DI float shidx(float v, int src) { return __int_as_float(__builtin_amdgcn_ds_bpermute(src << 2, __float_as_int(v))); }
DI float wave_sum(float v, int lane) {
#pragma unroll
    for (int o = 1; o < 64; o <<= 1) v += shx(v, o, lane);
    return v;
}
DI f32x4 mfma16(bf16x8 a, bf16x8 b, f32x4 c) { asm volatile("s_nop 3" : "+v"(a), "+v"(b)); return __builtin_amdgcn_mfma_f32_16x16x32_bf16(a, b, c, 0, 0, 0); }
#define GL_PIN(x) asm volatile("s_nop 4" : "+v"(x))
#define GL_PIN4(a, b, c, d) asm volatile("s_nop 4" : "+v"(a), "+v"(b), "+v"(c), "+v"(d))
DI void unpack8(const v4u w, float (&x)[8]) {
#pragma unroll
    for (int e = 0; e < 4; ++e) { x[2 * e] = __uint_as_float(w[e] << 16); x[2 * e + 1] = __uint_as_float(w[e] & 0xffff0000u); }
}

struct Frame {
    LAS unsigned char* lds;
    volatile LAS unsigned* MISC;
    gu32* ctl;
    int tid, lane, wave, vcu, G, bx, l; size_t z;
    float* out; unsigned char* ws;
};
constexpr int PTRTAB_OFF = 131072 + 2048;
DI const float* inp(const Frame& F, int i) {
    const LAS unsigned* t = (const LAS unsigned*)(F.lds + PTRTAB_OFF) + 2 * i;
    const unsigned lo = __builtin_amdgcn_readfirstlane(t[0]), hi = __builtin_amdgcn_readfirstlane(t[1]);
    return (const float*)(const GAS float*)(((unsigned long long)hi << 32) | lo);
}
enum { I_X = 0, I_C, I_WIN, I_WOUT, I_MIXG, I_AFB, I_SGW, I_SGB, I_CONVW, I_CONVB, I_DTB, I_ALOG, I_DSKIP, I_IB, I_FB, I_WADA, I_BADA, I_WN1, I_WN2, I_WRG, I_BRG, I_WRE, I_BRE, I_WEG, I_WEU, I_WED, I_WNF };

DI void refresh(Frame& F) { int t_ = F.tid; asm volatile("" : "+v"(t_)); F.tid = t_; F.lane = t_ & 63; F.wave = __builtin_amdgcn_readfirstlane(t_ >> 6); size_t z_ = 0; unsigned zl_ = 0; asm volatile("" : "+s"(z_), "+s"(zl_)); F.ws = F.ws + z_; F.lds = F.lds + zl_; }
DI void tile_g2l(LAS bf16* dst, int lp, const bf16* src, size_t gp, int rows, int cols, int tid) {
    const int cpr = cols >> 3, n = rows * cpr;
    if (n % (4 * NWAVES * 64) == 0) {
        for (int i0 = tid; i0 < n; i0 += 4 * NWAVES * 64) { v4u t[4];
#pragma unroll
            for (int j = 0; j < 4; ++j) { const int i = i0 + j * NWAVES * 64, r = i / cpr, c = (i % cpr) * 8; t[j] = *(const v4u*)(src + (size_t)r * gp + c); }
#pragma unroll
            for (int j = 0; j < 4; ++j) { const int i = i0 + j * NWAVES * 64, r = i / cpr, c = (i % cpr) * 8; *(LAS v4u*)(dst + r * lp + c) = t[j]; } }
        return; }
    for (int i = tid; i < n; i += NWAVES * 64) { const int r = i / cpr, c = (i % cpr) * 8; *(LAS v4u*)(dst + r * lp + c) = *(const v4u*)(src + (size_t)r * gp + c); }
}
DI void tile_l2g(bf16* dst, size_t gp, const LAS bf16* src, int lp, int rows, int cols, int tid) {
    const int cpr = cols >> 3, n = rows * cpr;
    for (int i = tid; i < n; i += NWAVES * 64) { const int r = i / cpr, c = (i % cpr) * 8; *(v4u*)(dst + (size_t)r * gp + c) = *(const LAS v4u*)(src + r * lp + c); }
}
template <bool IS_MAX> DI float scan128(float x, int tid, LAS float* red) {
    const int lane = tid & 63;
#pragma unroll
    for (int o = 1; o < 64; o <<= 1) { const float y = shup(x, o, lane); if (lane >= o) x = IS_MAX ? fmaxf(x, y) : x + y; }
    if (tid == 63) red[0] = x;
    __syncthreads();
    if (tid >= 64 && tid < 128) { const float p = red[0]; x = IS_MAX ? fmaxf(x, p) : x + p; }
    __syncthreads();
    return x;
}

DI void p_mod(Frame& F) {
    LAS float* SC = (LAS float*)F.lds;
    LAS float* RED = SC + 4096;
    const float* c = inp(F, I_C);
    for (int i = F.tid; i < 4096; i += 512) SC[i] = silu_f(c[i]);
    __syncthreads();
    float* mod = (float*)(F.ws + WS_MOD);
    const int jj = F.tid & 63, kg = F.tid >> 6;
    for (int u = F.bx; u < NLAYER * 96; u += F.G) {
        const int l = u / 96, j0 = (u % 96) * 64;
        const float* w = inp(F, I_WADA) + ((size_t)l * 1024 + kg * 128) * 6144 + j0 + jj;
        float a0 = 0.f, a1 = 0.f, a2 = 0.f, a3 = 0.f;
#pragma unroll 16
        for (int k = 0; k < 128; ++k) { const float wv = __builtin_nontemporal_load(w + (size_t)k * 6144); const int kk = kg * 128 + k; a0 += SC[kk] * wv; a1 += SC[1024 + kk] * wv; a2 += SC[2048 + kk] * wv; a3 += SC[3072 + kk] * wv; }
        RED[(kg * 4 + 0) * 64 + jj] = a0; RED[(kg * 4 + 1) * 64 + jj] = a1; RED[(kg * 4 + 2) * 64 + jj] = a2; RED[(kg * 4 + 3) * 64 + jj] = a3;
        __syncthreads();
        if (F.tid < 256) { const int b = F.tid >> 6; float s = inp(F, I_BADA)[(size_t)l * 6144 + j0 + jj];
#pragma unroll
            for (int g = 0; g < 8; ++g) s += RED[(g * 4 + b) * 64 + jj];
            mod[((size_t)l * 4 + b) * 6144 + j0 + jj] = s; }
        __syncthreads();
    }
}

struct CvItem { const float* gp; size_t N; bf16* WT; int d0, K, k0; float sc; };
DI void cv_load(const CvItem& d, int lane, f32x4 (&v)[16]) {
    const int kp = lane >> 4;
#pragma unroll
    for (int i = 0; i < 8; ++i) { const int p = 4 * i + kp; v[2 * i] = (f32x4){0.f, 0.f, 0.f, 0.f}; v[2 * i + 1] = v[2 * i];
        if (d.gp) { v[2 * i] = __builtin_nontemporal_load((const f32x4*)(d.gp + (size_t)(d.k0 + 2 * p) * d.N)); v[2 * i + 1] = __builtin_nontemporal_load((const f32x4*)(d.gp + (size_t)(d.k0 + 2 * p + 1) * d.N)); } }
}
DI void cv_finish(const CvItem& d, const f32x4 (&v)[16], LAS unsigned* scr, int lane) {
    const int kp = lane >> 4, gi = lane & 15;
#pragma unroll
    for (int i = 0; i < 8; ++i) { const int p = 4 * i + kp;
#pragma unroll
        for (int e = 0; e < 4; ++e) scr[(4 * gi + e) * 33 + p] = pk2h(v[2 * i][e] * d.sc, v[2 * i + 1][e] * d.sc); }
    LDS_WAIT(); asm volatile("" ::: "memory");
    const int c = lane & 7;
#pragma unroll
    for (int j = 0; j < 8; ++j) { const int n = (lane >> 3) + 8 * j; const LAS unsigned* s = scr + n * 33 + 4 * c;
        v4u o; o.x = s[0]; o.y = s[1]; o.z = s[2]; o.w = s[3];
        __builtin_nontemporal_store(o, (GAS v4u*)(d.WT + (size_t)(d.d0 + n) * d.K + d.k0 + 8 * c)); }
    LDS_WAIT(); asm volatile("" ::: "memory");
}
constexpr int CV_IN = 13 * 4 * 16, CV_INS = 16, CV_OUT = 256, CV_R = 16, CV_DENSE = CV_IN + CV_INS + CV_OUT + CV_R, CV_GU = 32 * 256, CV_DN = 32 * 128, CV_EXP = CV_GU + CV_DN, CV_WIN = CV_IN + CV_INS, CV_ALL = CV_DENSE + CV_EXP;
DI CvItem cv_decode(Frame& F, int l, int it, int gi) {
    int r = it;
    if (r < CV_IN) { const int tile = r >> 6, blk = (r >> 4) & 3, kb = r & 15;
        const int so = tile == 0 ? 0 : tile == 1 ? 256 : tile == 2 ? 512 : tile == 3 ? 772 : tile == 4 ? 1028 : tile == 5 ? 1284 : tile == 6 ? 1540 : tile == 7 ? 1796 : tile == 8 ? 2052 : tile == 9 ? 2312 : tile == 10 ? 2568 : tile == 11 ? 2824 : 3080;
        return CvItem{inp(F, I_WIN) + (size_t)l * 1024 * DINP + so + blk * 64 + 4 * gi, DINP, (bf16*)(F.ws + WS_WIN), tile * 256 + blk * 64, 1024, kb * 64, tile == 0 ? ATT_C2 : 1.f}; }
    r -= CV_IN;
    if (r < CV_INS) { const int col = gi == 0 ? 768 : gi == 1 ? 2308 : gi == 2 ? 3336 : gi == 3 ? 3340 : -1;
        return CvItem{col >= 0 ? inp(F, I_WIN) + (size_t)l * 1024 * DINP + col : nullptr, DINP, (bf16*)(F.ws + WS_WIN), 3328, 1024, r * 64, 1.f}; }
    r -= CV_INS;
    if (r < CV_OUT) { const int blk = r >> 4, kb = r & 15;
        return CvItem{inp(F, I_WOUT) + (size_t)l * 1024 * 1024 + blk * 64 + 4 * gi, 1024, (bf16*)(F.ws + WS_WOUT), blk * 64, 1024, kb * 64, 1.f}; }
    r -= CV_OUT;
    if (r < CV_R) { const float* cp = gi == 0 ? inp(F, I_WRG) + (size_t)l * 1024 * 4 : gi <= 8 ? inp(F, I_WRE) + (size_t)l * 1024 * 32 + 4 * (gi - 1) : nullptr;
        return CvItem{cp, (size_t)(gi == 0 ? 4 : 32), (bf16*)(F.ws + WS_WR), 0, 1024, r * 64, 1.f}; }
    r -= CV_R;
    if (r < CV_GU) { const int e = r >> 8, blk = (r >> 4) & 15, kb = r & 15, rr = blk * 64 + 4 * gi, j = rr >> 8, cc = rr & 255;
        const int which = (cc >> 2) & 1, uu = 128 * j + 64 * (cc >> 7) + ((cc & 127) >> 3) * 4;
        return CvItem{(which ? inp(F, I_WEU) : inp(F, I_WEG)) + ((size_t)(l * 32 + e) * 1024) * 512 + uu, 512, (bf16*)(F.ws + WS_WGU + (size_t)(l & 1) * EXP_ALT) + (size_t)e * 1024 * 1024, blk * 64, 1024, kb * 64, 1.f}; }
    r -= CV_GU;
    { const int e = r >> 7, blk = (r >> 3) & 15, kb = r & 7;
        return CvItem{inp(F, I_WED) + ((size_t)(l * 32 + e) * 512) * 1024 + blk * 64 + 4 * gi, 1024, (bf16*)(F.ws + WS_WDN + (size_t)(l & 1) * EXP_ALT) + (size_t)e * 1024 * 512, blk * 64, 512, kb * 64, 1.f}; }
}
DI void p_convert(Frame& F, int l, int n0, int n1, int gw = -1, int NGW = 0) {
    LAS unsigned* scr = (LAS unsigned*)(F.lds + F.wave * 16384);
    if (gw < 0) { gw = F.vcu * NWAVES + F.wave; NGW = F.G * NWAVES; }
    const int gi = F.lane & 15;
    int it = n0 + gw; if (it >= n1) return;
    CvItem da = cv_decode(F, l, it, gi), db = da; f32x4 va[16], vb[16]; cv_load(da, F.lane, va);
    _Pragma("unroll 1") for (;;) {
        { const int nx = it + NGW; const bool more = nx < n1;
          if (more) { db = cv_decode(F, l, nx, gi); cv_load(db, F.lane, vb); }
          cv_finish(da, va, scr, F.lane);
          if (!more) break;
          it = nx; }
        { const int nx = it + NGW; const bool more = nx < n1;
          if (more) { da = cv_decode(F, l, nx, gi); cv_load(da, F.lane, va); }
          cv_finish(db, vb, scr, F.lane);
          if (!more) break;
          it = nx; }
    }
}

DI void p_convert_np(Frame& F, int l, int n0, int n1, int gw, int NGW) {
    LAS unsigned* scr = (LAS unsigned*)(F.lds + F.wave * 16384);
    const int gi = F.lane & 15;
    _Pragma("unroll 1") for (int it = n0 + gw; it < n1; it += NGW) { CvItem da = cv_decode(F, l, it, gi); f32x4 va[16]; cv_load(da, F.lane, va); cv_finish(da, va, scr, F.lane); }
}

DI int cvq_grab(gu32* ctr, int lane) { unsigned v = 0u; if (lane == 0) v = __hip_atomic_fetch_add(ctr, 1u, __ATOMIC_RELAXED, __HIP_MEMORY_SCOPE_AGENT); return (int)__builtin_amdgcn_readfirstlane(v); }
DI void p_convert_q(Frame& F, int lconv, gu32* ctr, int cap) {
    LAS unsigned* scr = (LAS unsigned*)(F.lds + F.wave * 16384);
    const int gi = F.lane & 15;
    int it = cvq_grab(ctr, F.lane); if (it >= CV_EXP) return;
    CvItem da = cv_decode(F, lconv, CV_DENSE + it, gi); f32x4 va[16]; cv_load(da, F.lane, va);
    int ndone = 1;
    for (;;) {
        const int nx = (cap < 0 || ndone < cap) ? cvq_grab(ctr, F.lane) : CV_EXP; const bool more = nx < CV_EXP;
        CvItem db = da; f32x4 vb[16];
#pragma unroll
        for (int i = 0; i < 16; ++i) vb[i] = va[i];
        if (more) { db = cv_decode(F, lconv, CV_DENSE + nx, gi); cv_load(db, F.lane, vb); }
        cv_finish(da, va, scr, F.lane);
        if (!more) break;
        da = db; ++ndone;
#pragma unroll
        for (int i = 0; i < 16; ++i) va[i] = vb[i];
    }
}

template <int MODE> DI void p_norm(Frame& F, const void* xin, const bool xbf, int comb_l, bf16* xout, const float* wn, const float* shift, const float* scale, bf16* hout, float* fout, const int blk = -1) {
    const int gw0 = F.vcu * NWAVES + F.wave; const int gw = blk < 0 ? gw0 : blk * 128 + F.wave * 16, NGW = blk < 0 ? F.G * NWAVES : 1, TE = blk < 0 ? T : blk * 128 + F.wave * 16 + 16;
    const float* mod = (const float*)(F.ws + WS_MOD);
    const int* tokd = (const int*)(F.ws + WS_TOK + 768 * 1024); const float* tokw = (const float*)(F.ws + WS_TOK + 512 * 1024);
#ifdef DIAG_COMB_XB
    const bf16* yb = (const bf16*)(F.ws + WS_XB);
#else
    const bf16* yb = (const bf16*)(F.ws + WS_YB);
#endif
    const bool comb = comb_l >= 0;
    f32x4 wv[4];
#pragma unroll
    for (int j = 0; j < 4; ++j) wv[j] = *((const f32x4*)wn + F.lane + 64 * j);
    struct Tok { v2u d, w; };
    struct Row { v2u xb[4]; f32x4 xf[4]; v2u ya[4], yc[4]; };
    auto ld_tok = [&](const int m, Tok& t) { t.d = *(const v2u*)(tokd + 2 * m); t.w = *(const v2u*)((const unsigned*)tokw + 2 * m); };
    auto ld_row = [&](const int m, const Tok& t, Row& R) {
        if (xbf) { const GAS v2u* xr = (const GAS v2u*)((const bf16*)xin + (size_t)m * D) + F.lane;
#pragma unroll
            for (int j = 0; j < 4; ++j) R.xb[j] = __builtin_nontemporal_load(xr + 64 * j);
        } else { const GAS f32x4* xr = (const GAS f32x4*)((const float*)xin + (size_t)m * D) + F.lane;
#pragma unroll
            for (int j = 0; j < 4; ++j) R.xf[j] = __builtin_nontemporal_load(xr + 64 * j); }
        if (comb) {
#pragma unroll
            for (int j = 0; j < 4; ++j) { R.ya[j] = __builtin_nontemporal_load((const v2u*)(yb + (size_t)t.d[0] * 1024) + F.lane + 64 * j); R.yc[j] = __builtin_nontemporal_load((const v2u*)(yb + (size_t)t.d[1] * 1024) + F.lane + 64 * j); } } };
    Tok tA, tB; Row RA;
    tA.d = (v2u){0u, 0u}; tA.w = tA.d; tB = tA;
    if (gw < TE) { if (comb) { ld_tok(gw, tA); if (gw + NGW < TE) ld_tok(gw + NGW, tB); } ld_row(gw, tA, RA); }
    for (int m = gw; m < TE; m += NGW) {
        Row RN; Tok tN; tN.d = (v2u){0u, 0u}; tN.w = tN.d;
        if (m + NGW < TE) { ld_row(m + NGW, tB, RN); if (comb && m + 2 * NGW < TE) ld_tok(m + 2 * NGW, tN); }
        const int b = m >> 13;
        f32x4 v[4];
        if (xbf) {
#pragma unroll
            for (int j = 0; j < 4; ++j) { const v2u a = RA.xb[j];
                v[j][0] = __uint_as_float(a[0] << 16); v[j][1] = __uint_as_float(a[0] & 0xffff0000u); v[j][2] = __uint_as_float(a[1] << 16); v[j][3] = __uint_as_float(a[1] & 0xffff0000u); }
        } else {
#pragma unroll
            for (int j = 0; j < 4; ++j) v[j] = RA.xf[j];
        }
        if (comb) {
            const float w0 = __uint_as_float(tA.w[0]), w1 = __uint_as_float(tA.w[1]);
            const float* g2 = mod + ((size_t)comb_l * 4 + b) * 6144 + 5 * 1024;
#pragma unroll
            for (int j = 0; j < 4; ++j) { const v2u a = RA.ya[j], c = RA.yc[j];
                const f32x4 g = *((const f32x4*)g2 + F.lane + 64 * j);
                f32x4 y; y[0] = w0 * bf2f(a[0] & 0xffffu) + w1 * bf2f(c[0] & 0xffffu); y[1] = w0 * bf2f(a[0] >> 16) + w1 * bf2f(c[0] >> 16); y[2] = w0 * bf2f(a[1] & 0xffffu) + w1 * bf2f(c[1] & 0xffffu); y[3] = w0 * bf2f(a[1] >> 16) + w1 * bf2f(c[1] >> 16);
                v[j] = v[j] + g * y; }
        }
        if (xout) { GAS v2u* xo = (GAS v2u*)(xout + (size_t)m * D) + F.lane;
#pragma unroll
            for (int j = 0; j < 4; ++j) { v2u o; o[0] = pk2h(v[j][0], v[j][1]); o[1] = pk2h(v[j][2], v[j][3]); __builtin_nontemporal_store(o, xo + 64 * j); } }
        float s = 0.f;
#pragma unroll
        for (int j = 0; j < 4; ++j) s += (v[j][0] * v[j][0] + v[j][1] * v[j][1]) + (v[j][2] * v[j][2] + v[j][3] * v[j][3]);
        const float rstd = rsqrtf(wave_sum(s, F.lane) * (1.f / D) + NORM_EPS);
        if (MODE == 0) {
            const float* sh = shift + (size_t)b * 6144; const float* sc = scale + (size_t)b * 6144;
            GAS v2u* o8 = (GAS v2u*)(hout + (size_t)m * D) + F.lane;
#pragma unroll
            for (int j = 0; j < 4; ++j) { const f32x4 a = *((const f32x4*)sc + F.lane + 64 * j), c = *((const f32x4*)sh + F.lane + 64 * j);
                const f32x4 h = v[j] * rstd * wv[j] * (a + 1.f) + c; v2u o; o[0] = pk2h(h[0], h[1]); o[1] = pk2h(h[2], h[3]); o8[64 * j] = o; }
        } else {
            GAS f32x4* o = (GAS f32x4*)(fout + (size_t)m * D) + F.lane;
#pragma unroll
            for (int j = 0; j < 4; ++j) o[64 * j] = v[j] * rstd * wv[j];
        }
        RA = RN; tA = tB; tB = tN;
    }
}

template <bool IS_MAX> DI float scan128x2(float x, int tid, LAS float* red) {
    const int lane = tid & 63, wave = tid >> 6;
#pragma unroll
    for (int o = 1; o < 64; o <<= 1) { const float y = shup(x, o, lane); if (lane >= o) x = IS_MAX ? fmaxf(x, y) : x + y; }
    if (lane == 63 && wave < 4 && (wave & 1) == 0) red[wave >> 1] = x;
    __syncthreads();
    if (wave < 4 && (wave & 1)) { const float p = red[wave >> 1]; x = IS_MAX ? fmaxf(x, p) : x + p; }
    __syncthreads();
    return x;
}
constexpr int LP = 136;
constexpr int LP64 = 72;
constexpr int TILE128 = 128 * LP * 2;

DI void fscan_unit(Frame& F, int l, int bh) {
    refresh(F);
    LAS float* WT = (LAS float*)F.lds;
    const int b = bh >> 2, h = bh & 3; const float bias = inp(F, I_AFB)[l * 4 + h];
    const float* g = (const float*)(F.ws + WS_GATES) + ((size_t)b * SEQ + 16 * F.tid) * 16 + h;
    float v[16]; float run = 0.f;
#pragma unroll
    for (int i = 0; i < 16; ++i) { run += log_sigmoid_f(g[i * 16] + bias); v[i] = run; }
    float x = run;
#pragma unroll
    for (int o = 1; o < 64; o <<= 1) { const float y = shup(x, o, F.lane); if (F.lane >= o) x += y; }
    if (F.lane == 63) WT[F.wave] = x;
    __syncthreads();
    float pre = 0.f;
    for (int w = 0; w < F.wave; ++w) pre += WT[w];
    const float excl = x - run + pre;
    float* o = (float*)(F.ws + WS_F2) + (size_t)bh * SEQ + 16 * F.tid;
#pragma unroll
    for (int i = 0; i < 16; ++i) o[i] = (v[i] + excl) * LOG2E;
    __syncthreads();
}

DI void qknorm_unit(Frame& F, int u, gu32* qkn) {
    refresh(F);
    const int bh = u >> 4, seg = u & 15, b = bh >> 2, h = bh & 3;
    const bf16* proj = (const bf16*)(F.ws + WS_PROJ);
    float qm = 0.f, km = 0.f;
#pragma unroll
    for (int i = 0; i < 1; ++i) { const size_t row = (size_t)b * SEQ + seg * 512 + F.tid + i; float qs = 0.f, ks = 0.f;
#pragma unroll
        for (int c = 0; c < 8; ++c) { float x[8];
            unpack8(*(const v4u*)(proj + row * PP + O_AQ + h * 64 + 8 * c), x);
#pragma unroll
            for (int e = 0; e < 8; ++e) qs += x[e] * x[e];
            unpack8(*(const v4u*)(proj + row * PP + O_AK + h * 64 + 8 * c), x);
#pragma unroll
            for (int e = 0; e < 8; ++e) ks += x[e] * x[e]; }
        qm = fmaxf(qm, qs); km = fmaxf(km, ks); }
#pragma unroll
    for (int o = 1; o < 64; o <<= 1) { qm = fmaxf(qm, shx(qm, o, F.lane)); km = fmaxf(km, shx(km, o, F.lane)); }
    if (F.lane == 0) { __hip_atomic_fetch_max(qkn + 2 * bh, __float_as_uint(qm), __ATOMIC_RELAXED, __HIP_MEMORY_SCOPE_AGENT); __hip_atomic_fetch_max(qkn + 2 * bh + 1, __float_as_uint(km), __ATOMIC_RELAXED, __HIP_MEMORY_SCOPE_AGENT); }
}

template <bool IS_MAX> DI void wscan2(float& x0, float& x1, int lane) {
    x1 = IS_MAX ? fmaxf(x0, x1) : x0 + x1;
    float s = x1;
#pragma unroll
    for (int o = 1; o < 64; o <<= 1) { const float y = shup(s, o, lane); if (lane >= o) s = IS_MAX ? fmaxf(s, y) : s + y; }
    const float ex = shup(s, 1, lane);
    if (lane > 0) { x0 = IS_MAX ? fmaxf(x0, ex) : x0 + ex; x1 = IS_MAX ? fmaxf(x1, ex) : x1 + ex; }
}
DI void ssd_vectors(Frame& F, int l, int t0, int g, LAS float* DT, LAS float* AC, LAS float* RED) {
    (void)RED;
    if (F.wave < 2) {
        const int r2 = F.wave, head = 2 * g + r2, s0 = 2 * F.lane; const float* gp = (const float*)(F.ws + WS_GATES) + (size_t)(t0 + s0) * 16 + 4 + head;
        const float db = inp(F, I_DTB)[l * 4 + head], na = -__expf(inp(F, I_ALOG)[l * 4 + head]);
        const float d0 = softplus_f(gp[0] + db), d1 = softplus_f(gp[16] + db); float a0 = na * d0, a1 = na * d1;
        wscan2<false>(a0, a1, F.lane);
        DT[r2 * 128 + s0] = d0; DT[r2 * 128 + s0 + 1] = d1; AC[r2 * 128 + s0] = a0; AC[r2 * 128 + s0 + 1] = a1; }
    __syncthreads();
}
DI void ssd_local_unit(Frame& F, int l, int ch, int g) {
    refresh(F);
    LAS bf16* XWT = (LAS bf16*)F.lds; LAS bf16* BT = XWT + 128 * LP; LAS bf16* XD = BT + 128 * LP;
    LAS float* DT = (LAS float*)(F.lds + 3 * TILE128); LAS float* AC = DT + 256; LAS float* RED = AC + 256;
    const int t0 = ch * CHUNK, cpos = ch & (CPB - 1);
    const bf16* proj = (const bf16*)(F.ws + WS_PROJ); bf16* xbcc = (bf16*)(F.ws + WS_XBCC);
    const float* cw = inp(F, I_CONVW) + (size_t)l * 4 * XC; const float* cb = inp(F, I_CONVB) + (size_t)l * XC;
    const int s = F.tid >> 2, cg = F.tid & 3;
    float okm[4]; int spc[4];
#pragma unroll
    for (int j = 0; j < 4; ++j) { const int sp = s - 3 + j; const bool ok = cpos * CHUNK + sp >= 0; okm[j] = ok ? 1.f : 0.f; spc[j] = ok ? sp : s; }
    auto load_part = [&](const int part, v4u (&raw)[4][4]) {
#pragma unroll
        for (int cc = 0; cc < 4; ++cc)
#pragma unroll
            for (int j = 0; j < 4; ++j) raw[cc][j] = *(const v4u*)(proj + (size_t)(t0 + spc[j]) * PP + O_XBC + part * 256 + g * 128 + cg * 32 + cc * 8); };
    auto do_part = [&](const int part, const v4u (&raw)[4][4]) {
#pragma unroll
        for (int cc = 0; cc < 4; ++cc) {
            const int lc = cg * 32 + cc * 8, c0 = part * 256 + g * 128 + lc;
            float acc[8];
            { const f32x4 b0 = *(const f32x4*)(cb + c0), b1 = *(const f32x4*)(cb + c0 + 4);
#pragma unroll
              for (int e = 0; e < 4; ++e) { acc[e] = b0[e]; acc[4 + e] = b1[e]; } }
#pragma unroll
            for (int j = 0; j < 4; ++j) { float x[8]; unpack8(raw[cc][j], x);
                const f32x4 w0 = *(const f32x4*)(cw + j * XC + c0), w1 = *(const f32x4*)(cw + j * XC + c0 + 4);
#pragma unroll
                for (int e = 0; e < 4; ++e) { acc[e] += w0[e] * okm[j] * x[e]; acc[4 + e] += w1[e] * okm[j] * x[4 + e]; } }
#pragma unroll
            for (int e = 0; e < 8; ++e) acc[e] = silu_f(acc[e]);
            v4u o; o.x = pk2h(acc[0], acc[1]); o.y = pk2h(acc[2], acc[3]); o.z = pk2h(acc[4], acc[5]); o.w = pk2h(acc[6], acc[7]);
            *(v4u*)(xbcc + (size_t)(t0 + s) * XC + c0) = o;
            if (part == 0) { const int r2 = lc >> 6; const float dtv = DT[r2 * 128 + s], sc = dtv * __expf(AC[r2 * 128 + 127] - AC[r2 * 128 + s]);
#pragma unroll
                for (int e = 0; e < 8; ++e) { XWT[(lc + e) * LP + s] = (bf16)f2bf(acc[e] * sc); XD[(lc + e) * LP + s] = (bf16)f2bf(acc[e] * dtv); } }
            else if (part == 1) {
#pragma unroll
                for (int e = 0; e < 8; ++e) BT[(lc + e) * LP + s] = (bf16)f2bf(acc[e]); }
        } };
    v4u ra[4][4], rb[4][4];
    load_part(1, ra);
    ssd_vectors(F, l, t0, g, DT, AC, RED);
    load_part(2, rb);
    do_part(1, ra);
    load_part(0, ra);
    do_part(2, rb);
    do_part(0, ra);
    __syncthreads();
    const int w = F.wave, r = F.lane & 15, q = F.lane >> 4;
    f32x4 acc[8];
#pragma unroll
    for (int nt = 0; nt < 8; ++nt) acc[nt] = (f32x4){0.f, 0.f, 0.f, 0.f};
#pragma unroll
    for (int ks = 0; ks < 4; ++ks) { const bf16x8 a = *(const LAS bf16x8*)(XWT + (16 * w + r) * LP + 32 * ks + 8 * q);
#pragma unroll
        for (int nt = 0; nt < 8; ++nt) { const bf16x8 b = *(const LAS bf16x8*)(BT + (16 * nt + r) * LP + 32 * ks + 8 * q); acc[nt] = mfma16(a, b, acc[nt]); } }
    float* sst = (float*)(F.ws + WS_SST);
#pragma unroll
    for (int jj = 0; jj < 4; ++jj) { const int row = 16 * w + 4 * q + jj, head = 2 * g + (row >> 6), p = row & 63;
        float* o = sst + ((size_t)(ch * 4 + head) * 64 + p) * 128 + r;
#pragma unroll
        for (int nt = 0; nt < 8; ++nt) o[16 * nt] = acc[nt][jj]; }
    if (F.tid < 2) ((float*)(F.ws + WS_SMALL))[ch * 4 + 2 * g + F.tid] = __expf(AC[F.tid * 128 + 127]);
    tile_l2g((bf16*)(F.ws + WS_XDT) + (size_t)(ch * 2 + g) * 128 * 128, 128, XD, LP, 128, 128, F.tid);
    __syncthreads();
}
DI void ssd_out_unit(Frame& F, int l, int ch, int g) {
    refresh(F);
    LAS bf16* CL = (LAS bf16*)F.lds; LAS bf16* BL = CL + 128 * LP; LAS bf16* GL = BL + 128 * LP;
    LAS float* DT = (LAS float*)(F.lds + 3 * TILE128); LAS float* AC = DT + 256; LAS float* RED = AC + 256;
    const int t0 = ch * CHUNK;
    const bf16* xbcc = (const bf16*)(F.ws + WS_XBCC); const bf16* proj = (const bf16*)(F.ws + WS_PROJ);
    tile_g2l(CL, LP, xbcc + (size_t)t0 * XC + 512 + g * 128, XC, 128, 128, F.tid);
    tile_g2l(BL, LP, xbcc + (size_t)t0 * XC + 256 + g * 128, XC, 128, 128, F.tid);
    ssd_vectors(F, l, t0, g, DT, AC, RED);
    __syncthreads();
    const int w = F.wave, r = F.lane & 15, q = F.lane >> 4, wlim = w | 1, t_own = 16 * w + r;
    const float* gain = inp(F, I_MIXG) + (size_t)l * 1024 + 512;
    const bf16* hin = (const bf16*)(F.ws + WS_SHIN); const bf16* xdt = (const bf16*)(F.ws + WS_XDT) + (size_t)(ch * 2 + g) * 128 * 128;
    v2u po[2][4][2];
#pragma unroll
    for (int r2 = 0; r2 < 2; ++r2) {
        const int head = 2 * g + r2; const LAS float* ac = AC + r2 * 128;
        bf16x8 hb[4][4];
#pragma unroll
        for (int ks = 0; ks < 4; ++ks)
#pragma unroll
            for (int pt = 0; pt < 4; ++pt) hb[ks][pt] = *(const bf16x8*)(hin + ((size_t)(ch * 4 + head) * 64 + 16 * pt + r) * 128 + 32 * ks + 8 * q);
        bf16x8 xb[4][4];
#pragma unroll
        for (int ks = 0; ks < 4; ++ks)
#pragma unroll
            for (int pt = 0; pt < 4; ++pt) { if (ks <= (w >> 1)) xb[ks][pt] = *(const bf16x8*)(xdt + (size_t)(64 * r2 + 16 * pt + r) * 128 + 32 * ks + 8 * q); else xb[ks][pt] = (bf16x8){0, 0, 0, 0, 0, 0, 0, 0}; }
        bf16 xsr[4][4], zr[4][4];
#pragma unroll
        for (int pt = 0; pt < 4; ++pt)
#pragma unroll
            for (int jj = 0; jj < 4; ++jj) { const int t = 16 * w + 4 * q + jj, p = 16 * pt + r;
                xsr[pt][jj] = xbcc[(size_t)(t0 + t) * XC + g * 128 + r2 * 64 + p]; zr[pt][jj] = proj[(size_t)(t0 + t) * PP + O_MZ + head * 64 + p]; }
        { const float at = ac[t_own];
          for (int st = 0; st <= wlim; ++st) { f32x4 c = (f32x4){0.f, 0.f, 0.f, 0.f};
#pragma unroll
              for (int ks = 0; ks < 4; ++ks) { const bf16x8 a = *(const LAS bf16x8*)(BL + (16 * st + r) * LP + 32 * ks + 8 * q), b = *(const LAS bf16x8*)(CL + (16 * w + r) * LP + 32 * ks + 8 * q); c = mfma16(a, b, c); }
              float gv[4];
#pragma unroll
              for (int jj = 0; jj < 4; ++jj) { const int s = 16 * st + 4 * q + jj; gv[jj] = (s <= t_own) ? c[jj] * __expf(at - ac[s]) : 0.f; }
              v2u o; o[0] = pk2h(gv[0], gv[1]); o[1] = pk2h(gv[2], gv[3]);
              *(LAS v2u*)(GL + t_own * LP + 16 * st + 4 * q) = o; } }
        f32x4 acc[4], accb[4];
#pragma unroll
        for (int pt = 0; pt < 4; ++pt) { acc[pt] = (f32x4){0.f, 0.f, 0.f, 0.f}; accb[pt] = (f32x4){0.f, 0.f, 0.f, 0.f}; }
#pragma unroll
        for (int ks = 0; ks < 4; ++ks) if (ks <= (w >> 1)) { const bf16x8 a = *(const LAS bf16x8*)(GL + (16 * w + r) * LP + 32 * ks + 8 * q);
            GL_PIN4(xb[ks][0], xb[ks][1], xb[ks][2], xb[ks][3]);
#pragma unroll
            for (int pt = 0; pt < 4; ++pt) acc[pt] = mfma16(a, xb[ks][pt], acc[pt]); }
#pragma unroll
        for (int ks = 0; ks < 4; ++ks) GL_PIN4(hb[ks][0], hb[ks][1], hb[ks][2], hb[ks][3]);
#pragma unroll
        for (int ks = 0; ks < 4; ++ks) { const bf16x8 a = *(const LAS bf16x8*)(CL + (16 * w + r) * LP + 32 * ks + 8 * q);
#pragma unroll
            for (int pt = 0; pt < 4; ++pt) accb[pt] = mfma16(a, hb[ks][pt], accb[pt]); }
        const float dsk = inp(F, I_DSKIP)[l * 4 + head];
        float ss[4] = {0.f, 0.f, 0.f, 0.f};
#pragma unroll
        for (int pt = 0; pt < 4; ++pt)
#pragma unroll
            for (int jj = 0; jj < 4; ++jj) { const int t = 16 * w + 4 * q + jj, p = 16 * pt + r;
                const float xs = bf2f(xsr[pt][jj]), z = bf2f(zr[pt][jj]); (void)p;
                float y = acc[pt][jj] + __expf(ac[t]) * accb[pt][jj] + dsk * xs; y *= silu_f(z); acc[pt][jj] = y; ss[jj] += y * y; }
#pragma unroll
        for (int jj = 0; jj < 4; ++jj) { float v = ss[jj]; v += shx(v, 1, F.lane); v += shx(v, 2, F.lane); v += shx(v, 4, F.lane); v += shx(v, 8, F.lane); ss[jj] = rsqrtf(v * (1.f / 64.f) + NORM_EPS); }
#pragma unroll
        for (int pt = 0; pt < 4; ++pt) { const float gn = gain[head * 64 + 16 * pt + r];
            po[r2][pt][0][0] = pk2h(acc[pt][0] * ss[0] * gn, acc[pt][1] * ss[1] * gn); po[r2][pt][0][1] = 0u;
            po[r2][pt][1][0] = pk2h(acc[pt][2] * ss[2] * gn, acc[pt][3] * ss[3] * gn); po[r2][pt][1][1] = 0u; }
    }
    LAS bf16* OUT = CL;
#pragma unroll
    for (int r2 = 0; r2 < 2; ++r2)
#pragma unroll
        for (int pt = 0; pt < 4; ++pt)
#pragma unroll
            for (int jp = 0; jp < 2; ++jp) { const unsigned pr = po[r2][pt][jp][0]; const int t = 16 * w + 4 * q + 2 * jp, c = r2 * 64 + 16 * pt + r;
                OUT[t * LP + c] = (bf16)(pr & 0xffffu); OUT[(t + 1) * LP + c] = (bf16)(pr >> 16); }
    __syncthreads();
    tile_l2g((bf16*)(F.ws + WS_Y) + (size_t)t0 * 1024 + 512 + g * 128, 1024, OUT, LP, 128, 128, F.tid);
    __syncthreads();
}
#ifdef DIAG_ML_ALT
#define ML_ALT(l) ((size_t)((l) & 1))
#else
#define ML_ALT(l) ((size_t)0)
#endif

DI void p_scans(Frame& F) {
    const int gid = F.bx * (NWAVES * 64) + F.tid, NT_ = F.G * NWAVES * 64;
    const float* sst = (const float*)(F.ws + WS_SST); bf16* hin = (bf16*)(F.ws + WS_SHIN); const float* dec = (const float*)(F.ws + WS_SMALL);
    for (int e = gid; e < 16 * 8192; e += NT_) {
        const int bh = e >> 13, idx = e & 8191, b = bh >> 2, head = bh & 3;
        float hst = 0.f;
        for (int cb = 0; cb < CPB; cb += 32) { float xs[32], ds[32];
#pragma unroll
            for (int i = 0; i < 32; ++i) { const size_t u = (size_t)((b * CPB + cb + i) * 4 + head); xs[i] = __builtin_nontemporal_load(sst + u * 8192 + idx); ds[i] = dec[u]; }
#pragma unroll
            for (int i = 0; i < 32; ++i) { const size_t u = (size_t)((b * CPB + cb + i) * 4 + head); hin[u * 8192 + idx] = (bf16)f2bf(hst); hst = ds[i] * hst + xs[i]; } }
    }
    const float* mls = (const float*)(F.ws + WS_MLS + ML_ALT(F.l) * (406 * MiB)); bf16* mlc = (bf16*)(F.ws + WS_MLC + ML_ALT(F.l) * (406 * MiB));
    const float* mlm = (const float*)(F.ws + WS_SMALL + 64 * 1024 + ML_ALT(F.l) * 16384); float* mlmin = (float*)(F.ws + WS_SMALL + 128 * 1024 + ML_ALT(F.l) * 16384);
    const int slot = (F.wave == 0) ? 0 : (F.wave == 4) ? 1 : (F.wave == 1) ? 2 : (F.wave == 5) ? 3 : -1;
    if (slot >= 0)
    for (int wt = slot * F.G + F.bx; wt < 520; wt += 4 * F.G) {
        const int e = wt * 64 + F.lane;
        const int bh = e / 2080, idx = 2 * (e % 2080), b = bh >> 2, head = bh & 3;
        float c0 = 0.f, c1 = 0.f, m = -1e30f;
        typedef float f32x2n __attribute__((ext_vector_type(2)));
        for (int cb = 0; cb < CPB; cb += 16) { f32x2n sv[16]; float ml[16], ae[16];
#pragma unroll
            for (int i = 0; i < 16; ++i) { const size_t u = (size_t)((b * CPB + cb + i) * 4 + head); ml[i] = mlm[2 * u]; ae[i] = mlm[2 * u + 1]; sv[i] = __builtin_nontemporal_load((const f32x2n*)(mls + u * 5120 + idx)); }
#pragma unroll
            for (int i = 0; i < 16; ++i) { const size_t u = (size_t)((b * CPB + cb + i) * 4 + head);
                __hip_atomic_store((unsigned*)(mlc + u * 5120 + idx), pk2h(c0, c1), __ATOMIC_RELAXED, __HIP_MEMORY_SCOPE_AGENT); if (idx == 0) mlmin[u] = m;
                const float mnew = fmaxf(ae[i] + m, ml[i]); const float fa = __expf(ae[i] + m - mnew), fb = __expf(ml[i] - mnew);
                c0 = fa * c0 + fb * sv[i].x; c1 = fa * c1 + fb * sv[i].y; m = mnew; } }
    }
}

struct SgPre { v4u u[2], v0, v1; f32x4 w[8]; };
DI void sg_load(Frame& F, int ch, int h, SgPre& P) {
    const bf16* proj = (const bf16*)(F.ws + WS_PROJ); const size_t t0 = (size_t)ch * CHUNK;
#pragma unroll
    for (int j = 0; j < 2; ++j) { const int i = F.tid + 512 * j, r = i >> 3, c = (i & 7) * 8; P.u[j] = *(const v4u*)(proj + (t0 + r) * PP + O_SU + h * 64 + c); }
    { const int s = F.tid >> 2, cg = F.tid & 3; const bf16* vp = proj + (t0 + s) * PP + O_SV + h * 64 + cg * 16; P.v0 = *(const v4u*)vp; P.v1 = *(const v4u*)(vp + 8); }
    { const float* wsrc = inp(F, I_SGW) + ((size_t)(F.l * 4 + h)) * 128 * 128;
#pragma unroll
      for (int i = 0; i < 8; ++i) { const int idx = F.tid + 512 * i, t = idx >> 5, s4 = (idx & 31) * 4; P.w[i] = *(const f32x4*)(wsrc + t * 128 + s4); } }
}
DI void sg_unit(Frame& F, int l, int ch, int h, const SgPre& P) {
    refresh(F);
    LAS bf16* WL = (LAS bf16*)F.lds;
    LAS bf16* VT = WL + 128 * LP;
    LAS bf16* UL = VT + 64 * LP;
    const int t0 = ch * CHUNK; const bf16* proj = (const bf16*)(F.ws + WS_PROJ);
#pragma unroll
    for (int j = 0; j < 2; ++j) { const int i = F.tid + 512 * j, r = i >> 3, c = (i & 7) * 8; *(LAS v4u*)(UL + r * LP64 + c) = P.u[j]; }
    { const int s = F.tid >> 2, cg = F.tid & 3; (void)proj;
      const v4u r0 = P.v0, r1 = P.v1; float x[16];
      { float a[8]; unpack8(r0, a);
#pragma unroll
        for (int e = 0; e < 8; ++e) x[e] = gelu_tanh_f(a[e]); unpack8(r1, a);
#pragma unroll
        for (int e = 0; e < 8; ++e) x[8 + e] = gelu_tanh_f(a[e]); }
      float ss = 0.f;
#pragma unroll
      for (int e = 0; e < 16; ++e) ss += x[e] * x[e];
      ss += shx(ss, 1, F.lane); ss += shx(ss, 2, F.lane);
      const float rs = rsqrtf(ss * (1.f / 64.f) + NORM_EPS); const float* gn = inp(F, I_MIXG) + (size_t)l * 1024 + 256 + h * 64 + cg * 16;
#pragma unroll
      for (int e = 0; e < 16; ++e) VT[(cg * 16 + e) * LP + s] = (bf16)f2bf(x[e] * rs * gn[e]); }
    { const float* wsrc = inp(F, I_SGW) + ((size_t)(l * 4 + h)) * 128 * 128;
#pragma unroll
      for (int i = 0; i < 8; ++i) { const int idx = F.tid + 512 * i, t = idx >> 5, s4 = (idx & 31) * 4; const f32x4 wv = P.w[i]; (void)wsrc;
          v2u o; o[0] = pk2h(s4 <= t ? wv[0] : 0.f, s4 + 1 <= t ? wv[1] : 0.f); o[1] = pk2h(s4 + 2 <= t ? wv[2] : 0.f, s4 + 3 <= t ? wv[3] : 0.f);
          *(LAS v2u*)(WL + t * LP + s4) = o; } }
    __syncthreads();
    const int w = F.wave, r = F.lane & 15, q = F.lane >> 4;
    f32x4 acc[4];
#pragma unroll
    for (int dt = 0; dt < 4; ++dt) acc[dt] = (f32x4){0.f, 0.f, 0.f, 0.f};
    for (int ks = 0; ks <= (w >> 1); ++ks) { const bf16x8 a = *(const LAS bf16x8*)(WL + (16 * w + r) * LP + 32 * ks + 8 * q);
#pragma unroll
        for (int dt = 0; dt < 4; ++dt) { const bf16x8 b = *(const LAS bf16x8*)(VT + (16 * dt + r) * LP + 32 * ks + 8 * q); acc[dt] = mfma16(a, b, acc[dt]); } }
    const float* bs = inp(F, I_SGB) + (size_t)(l * 4 + h) * 128;
#pragma unroll
    for (int jj = 0; jj < 4; ++jj) { const int t = 16 * w + 4 * q + jj; const float bt = bs[t];
#pragma unroll
        for (int dt = 0; dt < 4; ++dt) { LAS bf16* p = UL + t * LP64 + 16 * dt + r; const float u = gelu_tanh_f(bf2f(*p)); *p = (bf16)f2bf(u * (acc[dt][jj] + bt)); } }
    __syncthreads();
    tile_l2g((bf16*)(F.ws + WS_Y) + (size_t)t0 * 1024 + 256 + h * 64, 1024, UL, LP64, 128, 64, F.tid);
    __syncthreads();
}

DI void ml_vectors(Frame& F, int l, int t0, int h, LAS float* A, LAS float* IG, LAS float* RED) {
    (void)RED;
    if (F.wave == 0) {
        const int s0 = 2 * F.lane; const float* gp = (const float*)(F.ws + WS_GATES) + (size_t)(t0 + s0) * 16; const float fb = inp(F, I_FB)[l * 4 + h], ib = inp(F, I_IB)[l * 4 + h];
        float a0 = log_sigmoid_f(gp[12 + h] + fb), a1 = log_sigmoid_f(gp[16 + 12 + h] + fb);
        IG[s0] = gp[8 + h] + ib; IG[s0 + 1] = gp[16 + 8 + h] + ib;
        wscan2<false>(a0, a1, F.lane);
        A[s0] = a0; A[s0 + 1] = a1; }
    __syncthreads();
}
struct MlLPre { v4u v0, v1, k0, k1; };
DI void ml_local_load(Frame& F, int ch, int h, MlLPre& P) {
    const bf16* proj = (const bf16*)(F.ws + WS_PROJ); const int s2 = (F.tid >> 3) * 2, c0 = (F.tid & 7) * 8;
    const bf16* vp = proj + ((size_t)ch * CHUNK + s2) * PP + O_LV + h * 64 + c0; const bf16* kp = proj + ((size_t)ch * CHUNK + s2) * PP + O_LK + h * 64 + c0;
    P.v0 = *(const v4u*)vp; P.v1 = *(const v4u*)(vp + PP); P.k0 = *(const v4u*)kp; P.k1 = *(const v4u*)(kp + PP);
}
DI void ml_local_unit(Frame& F, int l, int ch, int h, const MlLPre& P) {
    refresh(F);
    LAS bf16* VWT = (LAS bf16*)F.lds;
    LAS bf16* KT = VWT + 80 * LP;
    LAS float* A = (LAS float*)(F.lds + (80 + 64) * LP * 2); LAS float* IG = A + 128; LAS float* WG = IG + 128; LAS float* RED = WG + 128;
    const int t0 = ch * CHUNK; const bf16* proj = (const bf16*)(F.ws + WS_PROJ);
    const int s2 = (F.tid >> 3) * 2, c0 = (F.tid & 7) * 8; (void)proj;
    const v4u rv0 = P.v0, rv1 = P.v1, rk0 = P.k0, rk1 = P.k1;
    ml_vectors(F, l, t0, h, A, IG, RED);
    const float aend = A[127];
    float gval = -INFINITY;
    if (F.tid < 128) gval = aend - A[F.tid] + IG[F.tid];
    float mx = gval;
#pragma unroll
    for (int o = 1; o < 64; o <<= 1) mx = fmaxf(mx, shx(mx, o, F.lane));
    if (F.lane == 0 && F.wave < 2) RED[2 + F.wave] = mx;
    __syncthreads();
    const float mloc = fmaxf(RED[2], RED[3]);
    if (F.tid < 128) WG[F.tid] = __expf(gval - mloc);
    for (int i = F.tid; i < 15 * 64; i += 512) *(LAS unsigned*)(VWT + (65 + (i >> 6)) * LP + 2 * (i & 63)) = 0u;
    __syncthreads();
    if (F.tid < 64) *(LAS unsigned*)(VWT + 64 * LP + 2 * F.tid) = pk2h(WG[2 * F.tid], WG[2 * F.tid + 1]);
    {
      const float wg0 = WG[s2], wg1 = WG[s2 + 1];
      float x0[8], x1[8];
      unpack8(rv0, x0); unpack8(rv1, x1);
#pragma unroll
      for (int e = 0; e < 8; ++e) *(LAS unsigned*)(VWT + (c0 + e) * LP + s2) = pk2h(x0[e] * wg0, x1[e] * wg1);
      unpack8(rk0, x0); unpack8(rk1, x1);
#pragma unroll
      for (int e = 0; e < 8; ++e) *(LAS unsigned*)(KT + (c0 + e) * LP + s2) = pk2h(x0[e] * 0.125f, x1[e] * 0.125f); }
    __syncthreads();
    const int w = F.wave, r = F.lane & 15, q = F.lane >> 4;
    float* mls = (float*)(F.ws + WS_MLS + ML_ALT(F.l) * (406 * MiB)) + (size_t)(ch * 4 + h) * 5120;
#pragma unroll
    for (int it = 0; it < 3; ++it) { const int mt = (it < 2) ? (w >> 1) : 4, nt = (it < 2) ? 2 * (w & 1) + it : w;
        if (it == 2 && w >= 4) break;
        f32x4 acc = (f32x4){0.f, 0.f, 0.f, 0.f};
#pragma unroll
        for (int ks = 0; ks < 4; ++ks) { const bf16x8 a = *(const LAS bf16x8*)(VWT + (16 * mt + r) * LP + 32 * ks + 8 * q), b = *(const LAS bf16x8*)(KT + (16 * nt + r) * LP + 32 * ks + 8 * q); acc = mfma16(a, b, acc); }
#pragma unroll
#ifdef DIAG_MLS_CONST
        for (int jj = 0; jj < 4; ++jj) mls[(16 * mt + 4 * q + jj) * 64 + 16 * nt + r] = 0.01f * (float)(((16 * mt + 4 * q + jj) * 5 + (16 * nt + r) * 3 + ch) % 17 - 8);
#elif defined(DIAG_MLS_NOWG)
        for (int jj = 0; jj < 4; ++jj) mls[(16 * mt + 4 * q + jj) * 64 + 16 * nt + r] = acc[jj];
#else
        for (int jj = 0; jj < 4; ++jj) mls[(16 * mt + 4 * q + jj) * 64 + 16 * nt + r] = acc[jj];
#endif
    }
    if (F.tid == 0) { float* mlm = (float*)(F.ws + WS_SMALL + 64 * 1024 + ML_ALT(F.l) * 16384) + (size_t)(ch * 4 + h) * 2; mlm[0] = mloc; mlm[1] = aend; }
    __syncthreads();
}
struct MlPre { v4u q[2], k[2], o[2], v[2]; };
DI void ml_out_load(Frame& F, int ch, int h, MlPre& P) {
    const bf16* proj = (const bf16*)(F.ws + WS_PROJ); const size_t t0 = (size_t)ch * CHUNK;
#pragma unroll
    for (int j = 0; j < 2; ++j) { const int i = F.tid + 512 * j, r = i >> 3, c = (i & 7) * 8; const bf16* p = proj + (t0 + r) * PP + h * 64 + c;
        P.q[j] = *(const v4u*)(p + O_LQ); P.k[j] = *(const v4u*)(p + O_LK); P.o[j] = *(const v4u*)(p + O_LO); }
    { const int s = F.tid >> 2, cg = F.tid & 3; const bf16* vp = proj + (t0 + s) * PP + O_LV + h * 64 + cg * 16; P.v[0] = *(const v4u*)vp; P.v[1] = *(const v4u*)(vp + 8); }
}
struct NoHook { DI void operator()() const {} };
template <class Hook = NoHook> DI void ml_out_unit(Frame& F, int l, int ch, int h, const MlPre& P, Hook mid = Hook()) {
    refresh(F);
    LAS bf16* QL = (LAS bf16*)F.lds;
    LAS bf16* KL = QL + 128 * LP64;
    LAS bf16* OL = KL + 128 * LP64;
    LAS bf16* VT = OL + 128 * LP64;
    LAS bf16* WL = VT + 80 * LP;
    LAS float* A = (LAS float*)(F.lds + 3 * 128 * LP64 * 2 + (80 + 128) * LP * 2); LAS float* IG = A + 128; LAS float* E1 = IG + 128; LAS float* INTER = E1 + 128; LAS float* EMT = INTER + 128; LAS float* RED = EMT + 128;
    const int t0 = ch * CHUNK; const bf16* proj = (const bf16*)(F.ws + WS_PROJ);
#pragma unroll
    for (int j = 0; j < 2; ++j) { const int i = F.tid + 512 * j, r = i >> 3, c = (i & 7) * 8;
        *(LAS v4u*)(QL + r * LP64 + c) = P.q[j]; *(LAS v4u*)(KL + r * LP64 + c) = P.k[j]; *(LAS v4u*)(OL + r * LP64 + c) = P.o[j]; }
    { const int s = F.tid >> 2, cg = F.tid & 3;
      const v4u r0 = P.v[0], r1 = P.v[1];
#pragma unroll
      for (int e = 0; e < 4; ++e) { VT[(cg * 16 + 2 * e) * LP + s] = (bf16)(r0[e] & 0xffffu); VT[(cg * 16 + 2 * e + 1) * LP + s] = (bf16)(r0[e] >> 16);
          VT[(cg * 16 + 8 + 2 * e) * LP + s] = (bf16)(r1[e] & 0xffffu); VT[(cg * 16 + 8 + 2 * e + 1) * LP + s] = (bf16)(r1[e] >> 16); } }
    for (int i = F.tid; i < 16 * 128; i += 512) VT[(64 + (i >> 7)) * LP + (i & 127)] = (i < 128) ? (bf16)0x3f80u : (bf16)0;
    mid();
    const bf16* cin = (const bf16*)(F.ws + WS_MLC + ML_ALT(F.l) * (406 * MiB)) + (size_t)(ch * 4 + h) * 5120;
    bf16x8 cb[2][5];
#pragma unroll
    for (int ks = 0; ks < 2; ++ks)
#pragma unroll
        for (int nt = 0; nt < 5; ++nt) { cb[ks][nt] = *(const bf16x8*)(cin + (16 * nt + (F.lane & 15)) * 64 + 32 * ks + 8 * (F.lane >> 4)); if (nt == 4 && (F.lane & 15) != 0) cb[ks][nt] = (bf16x8){0, 0, 0, 0, 0, 0, 0, 0}; }
    ml_vectors(F, l, t0, h, A, IG, RED);
#ifdef DIAG_ML_NOINTER
    const float m_in = -1e30f;
#else
    const float m_in = ((const float*)(F.ws + WS_SMALL + 128 * 1024 + ML_ALT(F.l) * 16384))[ch * 4 + h];
#endif
    if (F.wave == 0) {
        const int s0 = 2 * F.lane; const float av0 = A[s0], av1 = A[s0 + 1]; const float ig0 = IG[s0] - av0, ig1 = IG[s0 + 1] - av1; float c0 = ig0, c1 = ig1;
        wscan2<true>(c0, c1, F.lane);
        const float m0 = fmaxf(c0, m_in), m1 = fmaxf(c1, m_in);
        IG[s0] = ig0; IG[s0 + 1] = ig1;
        E1[s0] = -m0; E1[s0 + 1] = -m1;
        INTER[s0] = __expf(m_in - m0); INTER[s0 + 1] = __expf(m_in - m1); EMT[s0] = __expf(-(av0 + m0)); EMT[s0 + 1] = __expf(-(av1 + m1)); }
    __syncthreads();
    const int w = F.wave, r = F.lane & 15, q = F.lane >> 4, wlim = w | 1, t_own = 16 * w + r;
    { const float e1 = E1[t_own];
#pragma unroll
      for (int st = 0; st < 8; ++st) if (st <= wlim) { f32x4 c = (f32x4){0.f, 0.f, 0.f, 0.f};
#pragma unroll
          for (int ks = 0; ks < 2; ++ks) { const bf16x8 a = *(const LAS bf16x8*)(KL + (16 * st + r) * LP64 + 32 * ks + 8 * q), b = *(const LAS bf16x8*)(QL + (16 * w + r) * LP64 + 32 * ks + 8 * q); c = mfma16(a, b, c); }
          float gv[4];
#pragma unroll
          for (int jj = 0; jj < 4; ++jj) { const int s = 16 * st + 4 * q + jj; gv[jj] = (s <= t_own) ? 0.125f * c[jj] * __expf(e1 + IG[s]) : 0.f; }
          v2u o; o[0] = pk2h(gv[0], gv[1]); o[1] = pk2h(gv[2], gv[3]);
          *(LAS v2u*)(WL + t_own * LP + 16 * st + 4 * q) = o; } }
    __syncthreads();
    f32x4 acc[5], accb[5];
#pragma unroll
    for (int nt = 0; nt < 5; ++nt) { acc[nt] = (f32x4){0.f, 0.f, 0.f, 0.f}; accb[nt] = (f32x4){0.f, 0.f, 0.f, 0.f}; }
    for (int ks = 0; ks <= (w >> 1); ++ks) { const bf16x8 a = *(const LAS bf16x8*)(WL + (16 * w + r) * LP + 32 * ks + 8 * q);
#pragma unroll
        for (int nt = 0; nt < 5; ++nt) { const bf16x8 b = *(const LAS bf16x8*)(VT + (16 * nt + r) * LP + 32 * ks + 8 * q); acc[nt] = mfma16(a, b, acc[nt]); } }
#pragma unroll
    for (int ks = 0; ks < 2; ++ks) { GL_PIN4(cb[ks][0], cb[ks][1], cb[ks][2], cb[ks][3]); GL_PIN(cb[ks][4]); }
#pragma unroll
    for (int ks = 0; ks < 2; ++ks) { const bf16x8 a = *(const LAS bf16x8*)(QL + (16 * w + r) * LP64 + 32 * ks + 8 * q);
#pragma unroll
        for (int nt = 0; nt < 5; ++nt) accb[nt] = mfma16(a, cb[ks][nt], accb[nt]); }
    const float* gain = inp(F, I_MIXG) + (size_t)l * 1024 + 768 + h * 64;
    float hv[4][4]; float ss[4];
#ifdef DIAG_ML_NOACCB
#pragma unroll
    for (int nt = 0; nt < 5; ++nt) accb[nt] = (f32x4){0.f, 0.f, 0.f, 0.f};
#endif
#pragma unroll
    for (int jj = 0; jj < 4; ++jj) { const int t = 16 * w + 4 * q + jj; const float it = INTER[t];
        const float den_l = acc[4][jj] + it * accb[4][jj]; const float den = shidx(den_l, F.lane & 48);
        const float dd = 1.f / fmaxf(fabsf(den), EMT[t]); float s2 = 0.f;
#pragma unroll
        for (int nt = 0; nt < 4; ++nt) { const float v = (acc[nt][jj] + it * accb[nt][jj]) * dd; hv[nt][jj] = v; s2 += v * v; }
        s2 += shx(s2, 1, F.lane); s2 += shx(s2, 2, F.lane); s2 += shx(s2, 4, F.lane); s2 += shx(s2, 8, F.lane);
        ss[jj] = rsqrtf(s2 * (1.f / 64.f) + NORM_EPS); }
#pragma unroll
    for (int nt = 0; nt < 4; ++nt) { const float gn = gain[16 * nt + r];
#pragma unroll
        for (int jj = 0; jj < 4; ++jj) { const int t = 16 * w + 4 * q + jj; const float og = sigmoid_f(bf2f(OL[t * LP64 + 16 * nt + r]));
            KL[t * LP64 + 16 * nt + r] = (bf16)f2bf(og * hv[nt][jj] * ss[jj] * gn); } }
    __syncthreads();
    tile_l2g((bf16*)(F.ws + WS_Y) + (size_t)t0 * 1024 + 768 + h * 64, 1024, KL, LP64, 128, 64, F.tid);
    __syncthreads();
}

DI void p_gates(Frame& F, int blk) {
    const bf16* H = (const bf16*)(F.ws + WS_H); const bf16* WG = (const bf16*)(F.ws + WS_WIN) + (size_t)PP * 1024; float* G = (float*)(F.ws + WS_GATES);
    const int r = F.lane & 15, q = F.lane >> 4;
    const bf16* bp = WG + (size_t)r * 1024 + 8 * q;
    _Pragma("unroll 1") for (int rt = 0; rt < 2; ++rt) { const int row0 = blk * 256 + F.wave * 32 + rt * 16;
        const bf16* ap = H + (size_t)(row0 + r) * 1024 + 8 * q;
        f32x4 acc = (f32x4){0.f, 0.f, 0.f, 0.f};
#pragma unroll
        for (int kb = 0; kb < 2; ++kb) { bf16x8 av[16], bv[16];
#pragma unroll
            for (int i = 0; i < 16; ++i) { av[i] = *(const bf16x8*)(ap + 32 * (16 * kb + i)); bv[i] = *(const bf16x8*)(bp + 32 * (16 * kb + i)); }
#pragma unroll
            for (int i = 0; i < 16; i += 4) { GL_PIN4(av[i], av[i + 1], av[i + 2], av[i + 3]); GL_PIN4(bv[i], bv[i + 1], bv[i + 2], bv[i + 3]); }
#pragma unroll
            for (int i = 0; i < 16; ++i) acc = mfma16(av[i], bv[i], acc); }
#pragma unroll
        for (int jj = 0; jj < 4; ++jj) G[(size_t)(row0 + 4 * q + jj) * 16 + r] = acc[jj]; }
}
DI void p_router(Frame& F, int l) {
    constexpr int WRP = 1032;
    LAS bf16* WRL = (LAS bf16*)F.lds;
    LAS float* LG = (LAS float*)(F.lds + 48 * WRP * 2);
    LAS int* CNT = (LAS int*)(F.lds + 48 * WRP * 2 + 8 * 16 * 48 * 4);
    const bf16* H = (const bf16*)(F.ws + WS_H); const bf16* WR = (const bf16*)(F.ws + WS_WR);
    int* tok_e = (int*)(F.ws + WS_TOK); int* tok_lp = (int*)(F.ws + WS_TOK + 256 * 1024); float* tok_w = (float*)(F.ws + WS_TOK + 512 * 1024);
    int* hist = (int*)(F.ws + WS_SMALL + 192 * 1024);
    const int r = F.lane & 15, q = F.lane >> 4;
    tile_g2l(WRL, WRP, WR, 1024, 48, 1024, F.tid);
    __syncthreads();
    for (int blk = F.bx; blk < T / 128; blk += F.G) {
        if (F.tid < 256) CNT[F.tid] = 0;
        __syncthreads();
        const int row0 = blk * 128 + F.wave * 16;
        f32x4 acc[3];
#pragma unroll
        for (int nt = 0; nt < 3; ++nt) acc[nt] = (f32x4){0.f, 0.f, 0.f, 0.f};
        const bf16* ap = H + (size_t)(row0 + r) * 1024 + 8 * q;
#pragma unroll
        for (int kb = 0; kb < 2; ++kb) { bf16x8 av[16];
#pragma unroll
            for (int i = 0; i < 16; ++i) av[i] = *(const bf16x8*)(ap + 32 * (16 * kb + i));
#pragma unroll
            for (int i = 0; i < 16; i += 4) GL_PIN4(av[i], av[i + 1], av[i + 2], av[i + 3]);
#pragma unroll
            for (int i = 0; i < 16; ++i) { const int ks = 16 * kb + i;
#pragma unroll
                for (int nt = 0; nt < 3; ++nt) { const bf16x8 b = *(const LAS bf16x8*)(WRL + (16 * nt + r) * WRP + 32 * ks + 8 * q); acc[nt] = mfma16(av[i], b, acc[nt]); } } }
        LAS float* lg = LG + F.wave * 16 * 48;
#pragma unroll
        for (int nt = 0; nt < 3; ++nt)
#pragma unroll
            for (int jj = 0; jj < 4; ++jj) lg[(4 * q + jj) * 48 + 16 * nt + r] = acc[nt][jj];
        LDS_WAIT(); asm volatile("" ::: "memory");
        int ex1 = -1, ex2 = -2; float gw1 = 0.f, gw2 = 0.f;
        if (F.lane < 16) {
            const LAS float* x = lg + F.lane * 48; const float* brg = inp(F, I_BRG) + l * 4; const float* bre = inp(F, I_BRE) + l * 32;
            float g0 = x[0] + brg[0], g1 = x[1] + brg[1], g2 = x[2] + brg[2], g3 = x[3] + brg[3];
            int gs = 0; float gm = g0; if (g1 > gm) { gm = g1; gs = 1; } if (g2 > gm) { gm = g2; gs = 2; } if (g3 > gm) { gm = g3; gs = 3; }
            const float gp = 1.f / (__expf(g0 - gm) + __expf(g1 - gm) + __expf(g2 - gm) + __expf(g3 - gm));
            float t1 = -INFINITY, t2 = -INFINITY; int i1 = 0, i2 = 0;
#pragma unroll
            for (int i = 0; i < 8; ++i) { const float v = x[4 + 8 * gs + i] + bre[8 * gs + i];
                if (v > t1) { t2 = t1; i2 = i1; t1 = v; i1 = i; } else if (v > t2) { t2 = v; i2 = i; } }
            const float e2 = __expf(t2 - t1), p1 = 1.f / (1.f + e2), p2 = e2 * p1;
            ex1 = 8 * gs + i1; ex2 = 8 * gs + i2; gw1 = gp * p1; gw2 = gp * p2;
        }
        int pos1 = 0, pos2 = 0;
#pragma unroll
        for (int j = 0; j < 16; ++j) { const int o1 = __builtin_amdgcn_ds_bpermute(j << 2, ex1), o2 = __builtin_amdgcn_ds_bpermute(j << 2, ex2);
            if (j < F.lane) { pos1 += (o1 == ex1) + (o2 == ex1); pos2 += (o1 == ex2) + (o2 == ex2); } }
        LAS int* wcnt = CNT + F.wave * 32;
        if (F.lane < 16) { __hip_atomic_fetch_add(wcnt + ex1, 1, __ATOMIC_RELAXED, __HIP_MEMORY_SCOPE_WORKGROUP); __hip_atomic_fetch_add(wcnt + ex2, 1, __ATOMIC_RELAXED, __HIP_MEMORY_SCOPE_WORKGROUP); }
        __syncthreads();
        if (F.lane < 16) { int b1 = 0, b2 = 0;
            for (int w2 = 0; w2 < F.wave; ++w2) { b1 += CNT[w2 * 32 + ex1]; b2 += CNT[w2 * 32 + ex2]; }
            const int m = row0 + F.lane;
            tok_e[2 * m] = ex1; tok_e[2 * m + 1] = ex2; tok_lp[2 * m] = b1 + pos1; tok_lp[2 * m + 1] = b2 + pos2; tok_w[2 * m] = gw1; tok_w[2 * m + 1] = gw2; }
        if (F.tid < 32) { int c = 0; for (int w2 = 0; w2 < 8; ++w2) c += CNT[w2 * 32 + F.tid]; hist[blk * 32 + F.tid] = c; }
        __syncthreads();
    }
}
DI void p_dispatch(Frame& F) {
    LAS int* PT = (LAS int*)F.lds;
    LAS int* PB = PT + 512;
    LAS int* TS = PB + 512;
    LAS int* BASE = TS + 64;
    LAS int* TOT = BASE + 32;
    const int* hist = (const int*)(F.ws + WS_SMALL + 192 * 1024); int* tstart = (int*)(F.ws + WS_SMALL + 256 * 1024);
    const int* tok_e = (const int*)(F.ws + WS_TOK); const int* tok_lp = (const int*)(F.ws + WS_TOK + 256 * 1024); int* tok_d = (int*)(F.ws + WS_TOK + 768 * 1024);
    int* rowtok = (int*)(F.ws + WS_SMALL + 512 * 1024);
    for (int blk = F.bx; blk < T / 128; blk += F.G) {
        { const int e = F.tid & 31, part = F.tid >> 5; int tot = 0, bs = 0;
          for (int b2 = part * 16; b2 < part * 16 + 16; ++b2) { const int c = hist[b2 * 32 + e]; tot += c; bs += (b2 < blk) ? c : 0; }
          PT[part * 32 + e] = tot; PB[part * 32 + e] = bs; }
        __syncthreads();
        if (F.tid < 32) { int tot = 0, bs = 0;
            for (int p = 0; p < 16; ++p) { tot += PT[p * 32 + F.tid]; bs += PB[p * 32 + F.tid]; }
            PT[F.tid] = (tot + 255) >> 8; BASE[F.tid] = bs; TOT[F.tid] = tot; }
        __syncthreads();
        if (F.tid == 0) { int run = 0; for (int e = 0; e < 32; ++e) { TS[e] = run; run += PT[e]; } TS[32] = run; }
        __syncthreads();
        if (blk == 0 && F.tid < 33) tstart[F.tid] = TS[F.tid];
        const int row0 = blk * 128 + F.wave * 16;
        if (F.lane < 32) { const int m = row0 + (F.lane >> 1), k = F.lane & 1; const int e = tok_e[2 * m + k]; const int d = 256 * TS[e] + BASE[e] + tok_lp[2 * m + k];
            tok_d[2 * m + k] = d; rowtok[d] = m; }
        __syncthreads();
    }
}

struct Args { const float* in[27]; float* out; unsigned char* ws; int ph_lo, ph_hi; };
#ifndef CV_TAILN
#define CV_TAILN 1536
#endif
constexpr int PH_PER_LAYER = 11, PH_TOTAL = 1 + NLAYER * PH_PER_LAYER + 1;

__global__ void __launch_bounds__(NWAVES * 64, 2) mega_fwd(Args args) {
    extern __shared__ __attribute__((aligned(16))) unsigned char lds[];
    Frame F;
    F.lds = (LAS unsigned char*)lds;
    F.MISC = (volatile LAS unsigned*)(F.lds + MISC_OFF);
    F.tid = threadIdx.x; F.lane = F.tid & 63; F.wave = __builtin_amdgcn_readfirstlane(F.tid >> 6);
    F.G = gridDim.x; F.bx = blockIdx.x; { const int bx = F.bx; F.vcu = (F.G % 8 == 0) ? (bx % 8) * (F.G / 8) + bx / 8 : bx; }
    F.out = args.out; F.ws = args.ws; F.ctl = (gu32*)(args.ws + WS_CTL);
    for (int u = F.tid; u < (LDS_BYTES - RING_BYTES) / 4; u += NWAVES * 64) ((LAS unsigned*)(F.lds + RING_BYTES))[u] = 0u;
    __syncthreads();
    if (F.tid < 27) { const unsigned long long p = (unsigned long long)args.in[F.tid]; LAS unsigned* t = (LAS unsigned*)(F.lds + PTRTAB_OFF) + 2 * F.tid; t[0] = (unsigned)p; t[1] = (unsigned)(p >> 32); }
    __syncthreads();
    XcdBarrier bar = xcd_barrier_post((unsigned*)(F.ctl + CW_BAR), F.MISC + 8);
    const int lo = args.ph_lo, hi = args.ph_hi;
    int ph = 0;
#define IN_RANGE() (lo <= ph && ph < hi)
#define FRESH() do { int t_ = threadIdx.x; asm volatile("" : "+v"(t_)); F.tid = t_; F.lane = t_ & 63; F.wave = __builtin_amdgcn_readfirstlane(t_ >> 6); size_t z_ = 0; unsigned zl_ = 0; int bx_ = blockIdx.x, g_ = gridDim.x; asm volatile("" : "+s"(z_), "+s"(zl_), "+s"(bx_), "+s"(g_)); F.z = z_; F.lds = (LAS unsigned char*)lds + zl_; F.ws = args.ws + z_; F.out = args.out + z_; F.ctl = (gu32*)(F.ws + WS_CTL); int ly_ = l; asm volatile("" : "+s"(ly_)); F.l = ly_; F.bx = bx_; F.G = g_; F.vcu = (g_ % 8 == 0) ? (bx_ % 8) * (g_ / 8) + bx_ / 8 : bx_; } while (0)
#ifndef PHMASK
#define PHMASK 0xffffffffu
#endif
#ifndef LRUN
#define LRUN NLAYER
#endif
#ifndef PCUT
#define PCUT 11
#endif
#ifndef DIAG_COMB_MIN
#define DIAG_COMB_MIN 11
#endif
#ifndef DUPMASK
#define DUPMASK 0u
#endif
#define REPS(k) ((((DUPMASK) >> (k)) & 1u) ? 2 : 1)
#ifndef SKIP_MOE0
#define SKIP_MOE0 0
#endif
#define EN(k) ((((PHMASK) >> (k)) & 1u) && ((k) == 0 || (k) >= 12 || l < LRUN - 1 || (k) <= PCUT) && !(SKIP_MOE0 && l == 0 && (k) >= 8 && (k) <= 11))
#define SEAM() do { if (lo <= ph && ph + 1 < hi) { size_t zb_ = 0; asm volatile("" : "+s"(zb_), "+s"(bar.x)); bar.bar = (unsigned*)(args.ws + WS_CTL + zb_) + CW_BAR; xcd_barrier(bar); } ++ph; } while (0)

#define xrun ((bf16*)(F.ws + WS_XRES))
#define mod ((const float*)(F.ws + WS_MOD))
#define H ((bf16*)(F.ws + WS_H))
#define PROJ ((bf16*)(F.ws + WS_PROJ))
#define Y ((bf16*)(F.ws + WS_Y))

    { const int l = 0; (void)l;
    if (IN_RANGE() && EN(0)) for (int rep_ = 0; rep_ < REPS(0); ++rep_) { FRESH(); p_mod(F); p_convert(F, 0, 0, CV_DENSE); } }
    SEAM();

    for (int l = 0; l < LRUN; ++l) {
#define modl (mod + (size_t)F.l * 4 * 6144)
        if (IN_RANGE() && EN(1)) for (int rep_ = 0; rep_ < REPS(1); ++rep_) { FRESH();
            p_norm<0>(F, F.l == 0 ? (const void*)inp(F, I_X) : (const void*)xrun, F.l != 0, (SKIP_MOE0 && F.l == 1) ? -1 : F.l - 1, xrun, inp(F, I_WN1) + (size_t)F.l * 1024, modl, modl + 1024, H, nullptr);
        }
        SEAM();
        if (IN_RANGE() && EN(2)) for (int rep_ = 0; rep_ < REPS(2); ++rep_) { FRESH();
            const int GG = F.G;
#ifndef STAGGER
#define STAGGER 0
#endif
            if (F.bx < GG) {
                for (int d_ = 0; d_ < STAGGER * (F.bx & 7); ++d_) __builtin_amdgcn_s_sleep(28);
#ifndef GATES_TAIL
#define GATES_TAIL 0
#endif
                if (GATES_TAIL) {
                    pg8::Gemm g{H, (const bf16*)(F.ws + WS_WIN), T, PP, D}; pg8::StaticOrder S; S.init(T, PP, GG, F.bx);
                    pg8::EpiProj E{PROJ, (float*)(F.ws + WS_GATES)};
                    pg8::gemm_phase<pg8::EpiProj, pg8::StaticOrder, PG8_ALIGN, PG8_SP2>(F.lds, g, S, E);
                    const int nun_ = (T / 256) * (PP / 256), rem_ = nun_ % GG;
                    const int ntail_ = rem_ ? GG - rem_ : GG, rank_ = rem_ ? F.bx - rem_ : F.bx;
                    if (rank_ >= 0) { __syncthreads(); refresh(F);
                        for (int blk_ = rank_; blk_ < T / 256; blk_ += ntail_) p_gates(F, blk_);
                        if (rem_) p_convert(F, F.l, CV_DENSE, CV_DENSE + CV_TAILN, rank_ * NWAVES + F.wave, ntail_ * NWAVES); }
                } else {
                pg8::Gemm g{H, (const bf16*)(F.ws + WS_WIN), T, NPROJ_T, D}; pg8::StaticOrder S; S.init(T, NPROJ_T, GG, F.bx);
                pg8::EpiProj E{PROJ, (float*)(F.ws + WS_GATES)};
                pg8::gemm_phase<pg8::EpiProj, pg8::StaticOrder, PG8_ALIGN, PG8_SP2>(F.lds, g, S, E);
                }
            } else p_convert(F, F.l, CV_DENSE, CV_ALL, (F.bx - GG) * NWAVES + F.wave, (F.G - GG) * NWAVES);
        }
        SEAM();
        if (IN_RANGE() && EN(3)) for (int rep_ = 0; rep_ < REPS(3); ++rep_) { FRESH();
            for (int ch = F.bx; ch < NCHUNK; ch += F.G) {
                _Pragma("unroll 1") for (int g = 0; g < 2; ++g) ssd_local_unit(F, F.l, ch, g);
                { MlLPre PA_, PB_; ml_local_load(F, ch, 0, PA_);
                  ml_local_load(F, ch, 1, PB_); ml_local_unit(F, F.l, ch, 0, PA_);
                  ml_local_load(F, ch, 2, PA_); ml_local_unit(F, F.l, ch, 1, PB_);
                  ml_local_load(F, ch, 3, PB_); ml_local_unit(F, F.l, ch, 2, PA_);
                  ml_local_unit(F, F.l, ch, 3, PB_); }
            }
            for (int bh = F.bx; bh < 16; bh += F.G) fscan_unit(F, F.l, bh);
            for (int u = F.bx; u < 256; u += F.G) qknorm_unit(F, u, F.ctl + CW_QKN + F.l * 32);
        }
        SEAM();
        if (IN_RANGE() && EN(4)) for (int rep_ = 0; rep_ < REPS(4); ++rep_) { FRESH();
            const bool exp_here = true;
            gu32* cvq = F.ctl + CW_CVQ + 64 * F.l; (void)exp_here;
            (void)cvq;
#ifndef CV_IN_MIX
#define CV_IN_MIX 0
#endif
#ifndef CV_MIXHEAD
#define CV_MIXHEAD 4
#endif
            const bool mixhead_ = CV_MIXHEAD > 0 && (F.G % (8 * CV_MIXHEAD)) == 0;
            const int cv0_ = mixhead_ ? CV_ALL : CV_DENSE + ((GATES_TAIL && (((T / 256) * (PP / 256)) % F.G) != 0) ? CV_TAILN : 0);
            if (F.wave < 4) { p_scans(F); if (!CV_IN_MIX) p_convert(F, F.l, cv0_, CV_ALL); if (!mixhead_ && F.l + 1 < NLAYER) p_convert(F, F.l + 1, 0, CV_WIN); }
            else { if (!CV_IN_MIX) p_convert(F, F.l, cv0_, CV_ALL); if (!mixhead_ && F.l + 1 < NLAYER) p_convert(F, F.l + 1, 0, CV_WIN); p_scans(F); } }
        SEAM();
        if (IN_RANGE() && EN(5)) for (int rep_ = 0; rep_ < REPS(5); ++rep_) { FRESH();
            const attn_body::AttnTensors AT{(const attn_body::bf16*)(PROJ + O_AQ), (const attn_body::bf16*)(PROJ + O_AK), (const attn_body::bf16*)(PROJ + O_AV), (attn_body::bf16*)Y,
                                            (const float*)(F.ws + WS_F2), inp(F, I_MIXG) + (size_t)F.l * 1024, (const unsigned*)(F.ctl + CW_QKN + F.l * 32)};
            LAS int* QS = (LAS int*)(F.lds + RING_BYTES + 640);
#ifndef MLQ_AHEAD
#define MLQ_AHEAD 0
#endif
#ifndef QMODE
#define QMODE 5
#endif
#ifndef PROBE_ATT2
#define PROBE_ATT2 0
#endif
#ifndef PROBE_ML2
#define PROBE_ML2 0
#endif
            if (CV_MIXHEAD > 0 && (F.G % (8 * CV_MIXHEAD)) == 0 && ((F.bx >> 3) % CV_MIXHEAD) == 0) {
                const int rank_ = (F.bx / (8 * CV_MIXHEAD)) * 8 + (F.bx & 7), nconv_ = F.G / CV_MIXHEAD;
                p_convert(F, F.l, CV_DENSE, CV_ALL, rank_ * NWAVES + F.wave, nconv_ * NWAVES);
                if (F.l + 1 < NLAYER) p_convert(F, F.l + 1, 0, CV_WIN, rank_ * NWAVES + F.wave, nconv_ * NWAVES);
                __syncthreads(); refresh(F); }
            constexpr int CVJ = 6; int cvp = CV_IN_MIX ? 0 : CVJ;
#define CV_PIECE() do { if (cvp < CVJ) { __syncthreads(); refresh(F); p_convert_np(F, F.l, CV_DENSE, CV_ALL, (F.vcu * NWAVES + F.wave) * CVJ + cvp, F.G * NWAVES * CVJ); ++cvp; __syncthreads(); } } while (0)
            for (int pa_ = 0; pa_ <= PROBE_ATT2; ++pa_) for (;;) {
                if (F.tid == 0) QS[0] = (int)__hip_atomic_fetch_add(F.ctl + CW_Q + 64 * F.l + 4 * pa_, 1u, __ATOMIC_RELAXED, __HIP_MEMORY_SCOPE_AGENT);
                __syncthreads();
                const int idx = __builtin_amdgcn_readfirstlane(QS[0]);
                __syncthreads();
                if (idx >= ((QMODE >= 2) ? 512 : 512 + 2560)) break;
                if (idx < 512) { const attn_body::AttnUnit u{(idx & 3) * 4 + 3 - ((idx >> 2) & 3), 31 - (idx >> 4)};
                    attn_body::attn_unit<8>(u.bh / 4, u.bh % 4, u.qb, AT.Q, AT.K, AT.V, AT.O, AT.F2, AT.gain, 2.0f * sqrtf(__uint_as_float(AT.qkn[2 * u.bh]) * __uint_as_float(AT.qkn[2 * u.bh + 1])), (char*)lds); }
                else { const int j = idx - 512;
                    if (j < 1024) { SgPre P_; sg_load(F, j >> 2, j & 3, P_); sg_unit(F, F.l, j >> 2, j & 3, P_); }
                    else if (j < 1536) ssd_out_unit(F, F.l, (j - 1024) >> 1, (j - 1024) & 1);
                    else { MlPre P_; ml_out_load(F, (j - 1536) >> 2, (j - 1536) & 3, P_); ml_out_unit(F, F.l, (j - 1536) >> 2, (j - 1536) & 3, P_); } }
#ifndef CV_NO_ATT_SITE
                CV_PIECE();
#endif
            }
            if (QMODE == 6) {
                _Pragma("unroll 1") for (int ty = 0; ty < 3; ++ty) {
                    for (;;) {
                        if (F.tid == 0) QS[0] = (int)__hip_atomic_fetch_add(F.ctl + CW_Q + 64 * F.l + 8 + 8 * ty, 1u, __ATOMIC_RELAXED, __HIP_MEMORY_SCOPE_AGENT);
                        __syncthreads();
                        const int j = __builtin_amdgcn_readfirstlane(QS[0]);
                        __syncthreads();
                        if (j >= (ty == 1 ? 512 : 1024)) break;
                        if (ty == 0) { SgPre P_; sg_load(F, j >> 2, j & 3, P_); sg_unit(F, F.l, j >> 2, j & 3, P_); } else if (ty == 1) ssd_out_unit(F, F.l, j >> 1, j & 1); else { MlPre P_; ml_out_load(F, j >> 2, j & 3, P_); ml_out_unit(F, F.l, j >> 2, j & 3, P_); }
                    } }
            } else if (QMODE == 7 && (F.G & 7) == 0) {
                for (;;) {
                    if (F.tid == 0) QS[0] = (int)__hip_atomic_fetch_add(F.ctl + CW_Q + 64 * F.l + 32, 1u, __ATOMIC_RELAXED, __HIP_MEMORY_SCOPE_AGENT);
                    __syncthreads();
                    const int j = __builtin_amdgcn_readfirstlane(QS[0]);
                    __syncthreads();
                    if (j >= 1024) break;
                    { MlPre P_; ml_out_load(F, j >> 2, j & 3, P_); ml_out_unit(F, F.l, j >> 2, j & 3, P_); }
                }
                for (;;) {
                    if (F.tid == 0) QS[0] = (int)__hip_atomic_fetch_add(F.ctl + CW_QX + (F.l * 8 + (F.bx & 7)) * 64, 1u, __ATOMIC_RELAXED, __HIP_MEMORY_SCOPE_AGENT);
                    __syncthreads();
                    const int j = __builtin_amdgcn_readfirstlane(QS[0]);
                    __syncthreads();
                    if (j >= 6 * (NCHUNK / 8)) break;
                    const int ch = (F.bx & 7) + 8 * (j / 6), sub = j % 6;
                    if (sub < 4) { SgPre P_; sg_load(F, ch, sub, P_); sg_unit(F, F.l, ch, sub, P_); } else ssd_out_unit(F, F.l, ch, sub - 4);
                }
            } else if (QMODE == 5 && MLQ_AHEAD) {
                gu32* qc_ = F.ctl + CW_Q + 64 * F.l + 32;
                if (F.tid == 0) { QS[0] = (int)__hip_atomic_fetch_add(qc_, 1u, __ATOMIC_RELAXED, __HIP_MEMORY_SCOPE_AGENT); QS[1] = (int)__hip_atomic_fetch_add(qc_, 1u, __ATOMIC_RELAXED, __HIP_MEMORY_SCOPE_AGENT); }
                __syncthreads();
                int j = __builtin_amdgcn_readfirstlane(QS[0]), jn = __builtin_amdgcn_readfirstlane(QS[1]);
                __syncthreads();
                MlPre PA_; if (j < 1024) ml_out_load(F, j >> 2, j & 3, PA_);
                _Pragma("unroll 1") while (j < 1024) {
                    unsigned nx_ = 0u; if (F.tid == 0) nx_ = __hip_atomic_fetch_add(qc_, 1u, __ATOMIC_RELAXED, __HIP_MEMORY_SCOPE_AGENT);
                    MlPre PB_; const int jl = jn < 1024 ? jn : j;
                    ml_out_unit(F, F.l, j >> 2, j & 3, PA_, [&]() { ml_out_load(F, jl >> 2, jl & 3, PB_); });
                    if (F.tid == 0) QS[0] = (int)nx_;
                    __syncthreads();
                    const int jnn = __builtin_amdgcn_readfirstlane(QS[0]);
                    __syncthreads();
                    j = jn; jn = jnn; PA_ = PB_;
                }
                for (int ch = F.bx; ch < NCHUNK; ch += F.G) {
                    { SgPre PA2_, PB2_; sg_load(F, ch, 0, PA2_);
                        sg_load(F, ch, 1, PB2_); sg_unit(F, F.l, ch, 0, PA2_);
                        sg_load(F, ch, 2, PA2_); sg_unit(F, F.l, ch, 1, PB2_);
                        sg_load(F, ch, 3, PB2_); sg_unit(F, F.l, ch, 2, PA2_);
                        sg_unit(F, F.l, ch, 3, PB2_); }
                    _Pragma("unroll 1") for (int g = 0; g < 2; ++g) ssd_out_unit(F, F.l, ch, g); }
            } else if (QMODE >= 3) {
                for (;;) {
                    if (F.tid == 0) QS[0] = (int)__hip_atomic_fetch_add(F.ctl + CW_Q + 64 * F.l + 32, 1u, __ATOMIC_RELAXED, __HIP_MEMORY_SCOPE_AGENT);
                    __syncthreads();
                    const int j = __builtin_amdgcn_readfirstlane(QS[0]);
                    __syncthreads();
                    if (j >= (QMODE == 4 ? 512 : 1024)) break;
                    if (QMODE == 3) { SgPre P_; sg_load(F, j >> 2, j & 3, P_); sg_unit(F, F.l, j >> 2, j & 3, P_); } else if (QMODE == 4) ssd_out_unit(F, F.l, j >> 1, j & 1); else { MlPre P_; ml_out_load(F, j >> 2, j & 3, P_); ml_out_unit(F, F.l, j >> 2, j & 3, P_); }
                    CV_PIECE();
                }
                _Pragma("unroll 1") while (cvp < CVJ) CV_PIECE();
                for (int ch = F.bx; ch < NCHUNK; ch += F.G) {
                    if (QMODE != 3) { SgPre PA_, PB_; sg_load(F, ch, 0, PA_);
                        sg_load(F, ch, 1, PB_); sg_unit(F, F.l, ch, 0, PA_);
                        sg_load(F, ch, 2, PA_); sg_unit(F, F.l, ch, 1, PB_);
                        sg_load(F, ch, 3, PB_); sg_unit(F, F.l, ch, 2, PA_);
                        sg_unit(F, F.l, ch, 3, PB_); }
                    if (QMODE != 4) { _Pragma("unroll 1") for (int g = 0; g < 2; ++g) ssd_out_unit(F, F.l, ch, g); }
                    if (QMODE != 5) { _Pragma("unroll 1") for (int h = 0; h < 4; ++h) { MlPre P_; ml_out_load(F, ch, h, P_); ml_out_unit(F, F.l, ch, h, P_); } } }
            }
            if (QMODE == 2) for (int ch = F.bx; ch < NCHUNK; ch += F.G) {
                _Pragma("unroll 1") for (int h = 0; h < 4; ++h) { SgPre P_; sg_load(F, ch, h, P_); sg_unit(F, F.l, ch, h, P_); }
                _Pragma("unroll 1") for (int g = 0; g < 2; ++g) ssd_out_unit(F, F.l, ch, g);
                _Pragma("unroll 1") for (int h = 0; h < 4; ++h) { MlPre P_; ml_out_load(F, ch, h, P_); ml_out_unit(F, F.l, ch, h, P_); } }
        }
        SEAM();
        if (IN_RANGE() && EN(6)) for (int rep_ = 0; rep_ < REPS(6); ++rep_) { FRESH();
            pg8::Gemm g{Y, (const bf16*)(F.ws + WS_WOUT), T, D, D}; pg8::StaticOrder S; S.init(T, D, F.G, F.bx);
#ifndef FUSE_NORM2
#define FUSE_NORM2 0
#endif
            if (FUSE_NORM2 && F.G == 256) {
                pg8::EpiOutNorm E{(float*)xrun, modl + 2 * 1024, inp(F, I_WN2) + (size_t)F.l * 1024, modl + 3 * 1024, modl + 4 * 1024, H, (float*)(F.ws + WS_SLOT) + (size_t)F.l * T * 4,
                                  (unsigned*)(F.ctl + CW_PAN + F.l * 128 * 64), (unsigned*)(F.ctl + CW_TMO)};
                { pg8::OneRound S0{S, 0}; pg8::gemm_phase<pg8::EpiOutNorm, pg8::OneRound, false, PG8_SP2>(F.lds, g, S0, E); }
                __syncthreads();
                { pg8::OneRound S1{S, 1}; pg8::gemm_phase<pg8::EpiOutNorm, pg8::OneRound, false, PG8_SP2>(F.lds, g, S1, E); }
            } else {
            pg8::EpiOut E{xrun, modl + 2 * 1024};
            pg8::gemm_phase<pg8::EpiOut, pg8::StaticOrder, PG8_ALIGN, PG8_SP2>(F.lds, g, S, E);
            }
        }
        SEAM();
        if (IN_RANGE() && EN(7)) for (int rep_ = 0; rep_ < REPS(7); ++rep_) { FRESH();
            if (!(FUSE_NORM2 && F.G == 256)) p_norm<0>(F, xrun, true, -1, nullptr, inp(F, I_WN2) + (size_t)F.l * 1024, modl + 3 * 1024, modl + 4 * 1024, H, nullptr);
        }
        SEAM();
        if (IN_RANGE() && EN(8)) for (int rep_ = 0; rep_ < REPS(8); ++rep_) { FRESH(); p_router(F, F.l); }
        SEAM();
        if (IN_RANGE() && EN(9)) for (int rep_ = 0; rep_ < REPS(9); ++rep_) { FRESH(); p_dispatch(F); }
        SEAM();
        if (IN_RANGE() && EN(10)) for (int rep_ = 0; rep_ < REPS(10); ++rep_) { FRESH();
            LAS int* TS = (LAS int*)(F.lds + RING_BYTES + 1024);
            if (F.tid < 33) TS[F.tid] = ((const int*)(F.ws + WS_SMALL + 256 * 1024))[F.tid];
            __syncthreads();
            if (F.tid == 0) { int run = 0; for (int s_ = 0; s_ < 4; ++s_) { const int e_ = (F.bx & 7) + 8 * s_; TS[40 + s_] = run; TS[48 + s_] = TS[e_]; run += 4 * (TS[e_ + 1] - TS[e_]); } TS[44] = run;
                int gm_ = 0; for (int x_ = 0; x_ < 8; ++x_) { int u_ = 0; for (int s_ = 0; s_ < 4; ++s_) u_ += 4 * (TS[x_ + 8 * s_ + 1] - TS[x_ + 8 * s_]); const int r_ = (u_ + (F.G >> 3) - 1) / (F.G >> 3); gm_ = r_ > gm_ ? r_ : gm_; } TS[45] = gm_; }
            __syncthreads();
            pg8::Gemm g{H, (const bf16*)(F.ws + WS_WGU + (size_t)(F.l & 1) * EXP_ALT), MOE_ROWS, NEXP * 1024, D};
            pg8::MoeOrder S{F.G, F.bx, TS + 40};
            LAS int* RT = (LAS int*)(F.lds + RING_BYTES + 4096);
            { pg8::Unit u_; const int* rowtok = (const int*)(F.ws + WS_SMALL + 512 * 1024);
              const int nxu_ = __builtin_amdgcn_readfirstlane(TS[44]), lcu_ = F.bx >> 3, peru_ = F.G >> 3; int nu_ = nxu_ > lcu_ ? (nxu_ - lcu_ + peru_ - 1) / peru_ : 0; nu_ = nu_ > 12 ? 12 : nu_;
              _Pragma("unroll 1") for (int i_ = 0; i_ < nu_; ++i_) { (void)S.next(i_, u_); const int pm_ = __builtin_amdgcn_readfirstlane(u_.pm);
                  if (F.tid < 256) { const unsigned tk = (unsigned)rowtok[pm_ * 256 + F.tid]; RT[i_ * 256 + F.tid] = (int)(tk < (unsigned)T ? tk : (unsigned)(T - 1)); } } }
            __syncthreads();
            pg8::EpiGU E{(bf16*)(F.ws + WS_ACT)};
            pg8::gemm_phase<pg8::EpiGU, pg8::MoeOrder, PG8_ALIGN, PG8_SP2, true>(F.lds, g, S, E, RT);
            if (F.l + 1 < NLAYER) { p_convert(F, F.l + 1, CV_WIN, CV_DENSE);
                const int nx_ = __builtin_amdgcn_readfirstlane(TS[44]), lc_ = F.bx >> 3, per_ = F.G >> 3, myunits = nx_ > lc_ ? (nx_ - lc_ + per_ - 1) / per_ : 0;
                const int idle_ = __builtin_amdgcn_readfirstlane(TS[45]) - myunits;
                (void)idle_; }
        }
        SEAM();
        if (IN_RANGE() && EN(11)) for (int rep_ = 0; rep_ < REPS(11); ++rep_) { FRESH();
            LAS int* TS = (LAS int*)(F.lds + RING_BYTES + 1024);
            if (F.tid < 33) TS[F.tid] = ((const int*)(F.ws + WS_SMALL + 256 * 1024))[F.tid];
            __syncthreads();
            if (F.tid == 0) { int run = 0; for (int s_ = 0; s_ < 4; ++s_) { const int e_ = (F.bx & 7) + 8 * s_; TS[40 + s_] = run; TS[48 + s_] = TS[e_]; run += 4 * (TS[e_ + 1] - TS[e_]); } TS[44] = run;
                int gm_ = 0; for (int x_ = 0; x_ < 8; ++x_) { int u_ = 0; for (int s_ = 0; s_ < 4; ++s_) u_ += 4 * (TS[x_ + 8 * s_ + 1] - TS[x_ + 8 * s_]); const int r_ = (u_ + (F.G >> 3) - 1) / (F.G >> 3); gm_ = r_ > gm_ ? r_ : gm_; } TS[45] = gm_; }
            __syncthreads();
            pg8::Gemm g{(const bf16*)(F.ws + WS_ACT), (const bf16*)(F.ws + WS_WDN + (size_t)(F.l & 1) * EXP_ALT), MOE_ROWS, NEXP * 1024, DEXP};
            pg8::MoeOrder S{F.G, F.bx, TS + 40};
            pg8::EpiDown E{(bf16*)(F.ws + WS_YB)};
            pg8::gemm_phase<pg8::EpiDown, pg8::MoeOrder, PG8_ALIGN, PG8_SP2>(F.lds, g, S, E);
            if (F.l + 1 < NLAYER) { const int nx_ = __builtin_amdgcn_readfirstlane(TS[44]), lc_ = F.bx >> 3, per_ = F.G >> 3, myunits = nx_ > lc_ ? (nx_ - lc_ + per_ - 1) / per_ : 0;
                const int idle_ = __builtin_amdgcn_readfirstlane(TS[45]) - myunits;
                (void)idle_; }
        }
        SEAM();
    }
    { const int l = 0; (void)l; if (IN_RANGE() && EN(12)) for (int rep_ = 0; rep_ < REPS(12); ++rep_) { FRESH(); p_norm<1>(F, xrun, true, (PCUT >= DIAG_COMB_MIN) ? LRUN - 1 : -1, nullptr, inp(F, I_WNF), nullptr, nullptr, nullptr, F.out); } }
#undef xrun
#undef mod
#undef H
#undef PROJ
#undef Y
#undef modl
#undef IN_RANGE
#undef SEAM
}

#ifndef MK_SPLIT
#define MK_SPLIT 0
#endif
extern "C" void kernel_launch(void* const* d_in, const int* in_sizes, int n_in, void* d_out, int out_size, void* d_ws, size_t ws_size, hipStream_t stream) {
    static int grid = 0;
    if (grid == 0) {
        if (n_in != 27 || out_size != T * D || ws_size < WS_END) { fprintf(stderr, "kernel_launch: unexpected shapes (n_in %d, out %d, ws %zu)\n", n_in, out_size, ws_size); grid = -1; return; }
        int dev = 0, cus = 0, per_cu = 0;
        if (hipGetDevice(&dev) != hipSuccess || hipDeviceGetAttribute(&cus, hipDeviceAttributeMultiprocessorCount, dev) != hipSuccess) { grid = -1; return; }
        if (hipFuncSetAttribute((const void*)mega_fwd, hipFuncAttributeMaxDynamicSharedMemorySize, LDS_BYTES) != hipSuccess) { fprintf(stderr, "kernel_launch: hipFuncSetAttribute failed\n"); grid = -1; return; }
        if (hipOccupancyMaxActiveBlocksPerMultiprocessor(&per_cu, (const void*)mega_fwd, NWAVES * 64, LDS_BYTES) != hipSuccess || per_cu < 1) { fprintf(stderr, "kernel_launch: occupancy query says %d\n", per_cu); (void)hipGetLastError(); grid = -1; return; }
        grid = cus;
    }
    if (grid < 0) return;
    (void)hipMemsetAsync((char*)d_ws + WS_CTL, 0, CTL_ZERO_BYTES, stream);
    Args a{};
    for (int i = 0; i < 27; ++i) a.in[i] = (const float*)d_in[i];
    a.out = (float*)d_out; a.ws = (unsigned char*)d_ws;
#if MK_SPLIT
    for (int p = 0; p < PH_TOTAL; ++p) { a.ph_lo = p; a.ph_hi = p + 1; hipLaunchKernelGGL(mega_fwd, dim3(grid), dim3(NWAVES * 64), LDS_BYTES, stream, a); }
#else
    a.ph_lo = 0; a.ph_hi = PH_TOTAL;
    hipLaunchKernelGGL(mega_fwd, dim3(grid), dim3(NWAVES * 64), LDS_BYTES, stream, a);
#endif
}
```

```cpp
#include <hip/hip_runtime.h>
#include <hip/hip_bf16.h>
#include <cstdio>
#include <cstdint>
#include <cmath>
namespace pg8 {
#define PG8_LAS __attribute__((address_space(3)))
typedef unsigned short bf16_t;
typedef short bf16x8 __attribute__((ext_vector_type(8)));
typedef float f32x4 __attribute__((ext_vector_type(4)));
typedef unsigned u32x4 __attribute__((ext_vector_type(4)));
constexpr int BM = 256, BK = 64, HALF = 128, HTB = HALF * BK * 2  , STAGE_BYTES = 8 * HTB, NXCD = 8, WGM = 8;

__host__ __device__ __forceinline__ int lds_byte(int r, int c) { const int st = (r >> 4) * 2 + (c >> 5), rr = r & 15, cc = c & 31, ob = rr * 64 + cc * 2; return st * 1024 + (ob ^ (((ob >> 9) & 1) << 5)); }
__host__ __device__ __forceinline__ void stage_rc(int b, int& R, int& C) { const int st = b / 1024, sb = b % 1024, swz = sb ^ (((sb >> 9) & 1) << 5); R = (st >> 1) * 16 + swz / 64; C = (st & 1) * 32 + (swz % 64) / 2; }
__host__ __device__ __forceinline__ int perm32(int rho) { const int n = rho >> 4, i = rho & 15; return 8 * (i >> 2) + 4 * n + (i & 3); }

struct Unit { int pm, pn; };
struct Gemm { const bf16_t* A; const bf16_t* Bt; int M, N, K; };

struct StaticOrder {
    int nM, nN, nwg, G, c;
    __host__ __device__ void init(int M, int N, int G_, int c_) { nM = M / BM; nN = N / BM; nwg = nM * nN; G = G_; c = c_; }
    __host__ __device__ bool next(int i, Unit& u) const {
        const long L = (long)i * G + c; if (L >= nwg) return false;
        int wgid = (int)L; { const int q = nwg / NXCD, r = nwg % NXCD, xcd = wgid % NXCD, off = wgid / NXCD; wgid = (xcd < r ? xcd * (q + 1) : r * (q + 1) + (xcd - r) * q) + off; }
        const int nig = WGM * nN, gid = wgid / nig, fm = gid * WGM, gsz = (nM - fm) < WGM ? (nM - fm) : WGM;
        u.pm = fm + ((wgid % nig) % gsz); u.pn = (wgid % nig) / gsz; return true;
    }
    __device__ __forceinline__ void a_ready(const Unit&) const {}
    __device__ __forceinline__ void done(const Unit&) const {}
};

__device__ __forceinline__ unsigned cvt_pk_bf16(float lo, float hi) { unsigned r; asm volatile("v_cvt_pk_bf16_f32 %0, %1, %2" : "=v"(r) : "v"(lo), "v"(hi)); return r; }
typedef float f32x2 __attribute__((ext_vector_type(2)));
template <class Epi, class Sched, bool ALIGN_EPI = false, bool SP2 = false, bool GATHER = false>
__device__ __forceinline__ void gemm_phase(PG8_LAS unsigned char* lds, const Gemm g, const Sched& S, const Epi& E, const PG8_LAS int* rt = nullptr) {
    int tid_ = threadIdx.x; asm volatile("" : "+v"(tid_));
    const int tid = tid_, wid = __builtin_amdgcn_readfirstlane(tid >> 6), lane = tid & 63, wr = wid >> 2, wc = wid & 3, fr = lane & 15, fq = lane >> 4;
    const int K = g.K, nt = K / BK;
    unsigned voffA[2], voffB[2];
#pragma unroll
    for (int i = 0; i < 2; ++i) { int R, C; stage_rc(tid * 16 + i * 8192, R, C); const int Rb = Epi::PERM ? ((R & ~31) + perm32(R & 31)) : R;
        voffA[i] = (unsigned)(R * K + C) * 2u; voffB[i] = (unsigned)(Rb * K + C) * 2u; }
    const size_t kstep = (size_t)(BK * 2);
    static_assert(!GATHER || SP2, "gather needs the SP2 loop");
#define PG8_GROWS(d0, d1, ui_) do { _Pragma("unroll") for (int _i = 0; _i < 2; ++_i) { int R_, C_; stage_rc(tid * 16 + _i * 8192, R_, C_); \
        d0[_i] = (unsigned)(rt[(ui_) * 256 + R_] * K + C_) * 2u; d1[_i] = (unsigned)(rt[(ui_) * 256 + 128 + R_] * K + C_) * 2u; } } while (0)
    const size_t hstep = (size_t)HALF * K * 2;
    const size_t tstep = 2 * hstep;
    const unsigned ldsw = (unsigned)wid * 1024u;
    const int aoff = lds_byte(wr * 64 + fr, fq * 8), boff = lds_byte(wc * 32 + fr, fq * 8);
#define PG8_SA(b, h) (((b) * 2 + (h)) * HTB)
#define PG8_SB(b, h) ((4 + (b) * 2 + (h)) * HTB)
#define PG8_STAGE(bufoff, gbase, voff) do { _Pragma("unroll") for (int _i = 0; _i < 2; ++_i) \
        __builtin_amdgcn_global_load_lds((const unsigned*)((const char*)(gbase) + (voff)[_i]), (PG8_LAS unsigned*)(lds + (bufoff) + ldsw + _i * 8192), 16, 0, 0); } while (0)
#define PG8_LDA(dst, b, h) do { _Pragma("unroll") for (int m = 0; m < 4; ++m) _Pragma("unroll") for (int k = 0; k < 2; ++k) dst[m][k] = *(const PG8_LAS bf16x8*)(lds + PG8_SA(b, h) + aoff + m * 2048 + k * 1024); } while (0)
#define PG8_LDB(dst, b, h) do { _Pragma("unroll") for (int n = 0; n < 2; ++n) _Pragma("unroll") for (int k = 0; k < 2; ++k) dst[n][k] = *(const PG8_LAS bf16x8*)(lds + PG8_SB(b, h) + boff + n * 2048 + k * 1024); } while (0)
#define PG8_MMA(ai, bj, At, Bt) do { __builtin_amdgcn_s_setprio(1); _Pragma("unroll") for (int m = 0; m < 4; ++m) _Pragma("unroll") for (int n = 0; n < 2; ++n) _Pragma("unroll") for (int k = 0; k < 2; ++k) \
        acc[ai][bj][m][n] = __builtin_amdgcn_mfma_f32_16x16x32_bf16(Bt[n][k], At[m][k], acc[ai][bj][m][n], 0, 0, 0); __builtin_amdgcn_s_setprio(0); } while (0)
#define PG8_WAIT_V(n) asm volatile("s_waitcnt vmcnt(" #n ")" ::: "memory")
#define PG8_WAIT_L(n) asm volatile("s_waitcnt lgkmcnt(" #n ")" ::: "memory")
#define PG8_BAR __builtin_amdgcn_s_barrier()
#define PG8_SCHED __builtin_amdgcn_sched_barrier(0)
    Unit cur, nxt;
    if (!S.next(0, cur)) return;
    f32x4 acc[2][2][4][2];
#pragma unroll
    for (int a = 0; a < 2; ++a)
#pragma unroll
        for (int b = 0; b < 2; ++b)
#pragma unroll
            for (int m = 0; m < 4; ++m)
#pragma unroll
                for (int n = 0; n < 2; ++n) acc[a][b][m][n] = (f32x4){0.f, 0.f, 0.f, 0.f};
    bf16x8 At[4][2], B0[2][2], B1[2][2];
    const char* cA = (const char*)g.A + (GATHER ? (size_t)0 : (size_t)cur.pm * tstep); const char* cB = (const char*)g.Bt + (size_t)cur.pn * tstep;
#define PG8_STAGE_A(bufoff, kbase, half, nextsel) do { if constexpr (GATHER) { unsigned o_[2]; const int un_ = ((nextsel) && has_next_) ? ui + 1 : ui; \
            _Pragma("unroll") for (int _j = 0; _j < 2; ++_j) { int R_, C_; stage_rc(tid * 16 + _j * 8192, R_, C_); o_[_j] = (unsigned)(rt[un_ * 256 + (half) * 128 + R_] * K + C_) * 2u; } \
            PG8_STAGE(bufoff, kbase, o_); } \
        else PG8_STAGE(bufoff, (kbase) + ((half) ? hstep : 0), voffA); } while (0)
    bool has_next_ = false; int ui = 0;
    S.a_ready(cur);
    if constexpr (SP2) {
        PG8_STAGE(PG8_SB(0, 0), cB, voffB); PG8_STAGE(PG8_SB(0, 1), cB + hstep, voffB); PG8_STAGE_A(PG8_SA(0, 0), cA, 0, false); PG8_STAGE_A(PG8_SA(0, 1), cA, 1, false);
        if (wr == 1) PG8_BAR;
        PG8_WAIT_V(2); PG8_BAR;
        PG8_STAGE(PG8_SB(1, 0), cB + kstep, voffB); PG8_STAGE_A(PG8_SA(1, 0), cA + kstep, 0, false); PG8_STAGE(PG8_SB(1, 1), cB + hstep + kstep, voffB);
        PG8_WAIT_V(6); PG8_BAR;
    } else {
        PG8_STAGE(PG8_SB(0, 0), cB, voffB); PG8_STAGE(PG8_SA(0, 0), cA, voffA); PG8_STAGE(PG8_SB(0, 1), cB + hstep, voffB); PG8_STAGE(PG8_SA(0, 1), cA + hstep, voffA);
        if (wr == 1) PG8_BAR;
        PG8_WAIT_V(4); PG8_BAR;
        PG8_STAGE(PG8_SB(1, 0), cB + kstep, voffB); PG8_STAGE(PG8_SA(1, 0), cA + kstep, voffA); PG8_STAGE(PG8_SB(1, 1), cB + hstep + kstep, voffB);
        PG8_WAIT_V(6); PG8_BAR;
    }
    for (;;) {
        const bool has_next = S.next(ui + 1, nxt);
        const char* nA = (has_next && !GATHER) ? (const char*)g.A + (size_t)nxt.pm * tstep : cA;
        has_next_ = has_next; const char* nB = has_next ? (const char*)g.Bt + (size_t)nxt.pn * tstep : cB;
        for (int t = 0; t < nt; t += 2) {
            const bool last = (t == nt - 2);
            const char* a1 = cA + (size_t)(t + 1) * kstep;
            const char* a2 = last ? nA : cA + (size_t)(t + 2) * kstep; const char* b2 = last ? nB : cB + (size_t)(t + 2) * kstep;
            const char* a3 = a2 + kstep; const char* b3 = b2 + kstep;
            if (last && has_next) S.a_ready(nxt);
            if constexpr (SP2) {
            PG8_LDB(B0, 0, 0); PG8_LDB(B1, 0, 1); PG8_SCHED; PG8_LDA(At, 0, 0); PG8_STAGE_A(PG8_SA(1, 1), a1, 1, false);
            PG8_WAIT_V(8); PG8_WAIT_L(0); PG8_BAR; PG8_MMA(0, 0, At, B0); PG8_MMA(0, 1, At, B1); PG8_BAR; PG8_SCHED;
            PG8_LDA(At, 0, 1); PG8_STAGE(PG8_SB(0, 0), b2, voffB); PG8_STAGE(PG8_SB(0, 1), b2 + hstep, voffB); PG8_STAGE_A(PG8_SA(0, 0), a2, 0, last);
            PG8_WAIT_V(8); PG8_WAIT_L(0); PG8_BAR; PG8_MMA(1, 0, At, B0); PG8_MMA(1, 1, At, B1); PG8_BAR; PG8_SCHED;
            PG8_LDB(B0, 1, 0); PG8_LDB(B1, 1, 1); PG8_SCHED; PG8_LDA(At, 1, 0); PG8_STAGE_A(PG8_SA(0, 1), a2, 1, last);
            PG8_WAIT_V(8); PG8_WAIT_L(0); PG8_BAR; PG8_MMA(0, 0, At, B0); PG8_MMA(0, 1, At, B1); PG8_BAR; PG8_SCHED;
            PG8_LDA(At, 1, 1); PG8_STAGE(PG8_SB(1, 0), b3, voffB); PG8_STAGE(PG8_SB(1, 1), b3 + hstep, voffB); PG8_STAGE_A(PG8_SA(1, 0), a3, 0, last);
            PG8_WAIT_V(8); PG8_WAIT_L(0); PG8_BAR; PG8_MMA(1, 0, At, B0); PG8_MMA(1, 1, At, B1); PG8_BAR; PG8_SCHED;
            } else {
            PG8_LDB(B0, 0, 0); PG8_SCHED; PG8_LDA(At, 0, 0); PG8_STAGE(PG8_SA(1, 1), a1 + hstep, voffA);
            PG8_WAIT_L(8); PG8_BAR; PG8_WAIT_L(0); PG8_MMA(0, 0, At, B0); PG8_BAR; PG8_SCHED;
            PG8_LDB(B1, 0, 1); PG8_STAGE(PG8_SB(0, 0), b2, voffB);
            PG8_BAR; PG8_WAIT_L(0); PG8_MMA(0, 1, At, B1); PG8_BAR;
            PG8_LDA(At, 0, 1); PG8_STAGE(PG8_SA(0, 0), a2, voffA);
            PG8_BAR; PG8_WAIT_L(0); PG8_MMA(1, 0, At, B0); PG8_BAR; PG8_SCHED;
            PG8_STAGE(PG8_SB(0, 1), b2 + hstep, voffB);
            PG8_WAIT_V(6); PG8_BAR; PG8_MMA(1, 1, At, B1); PG8_BAR;
            PG8_LDB(B0, 1, 0); PG8_SCHED; PG8_LDA(At, 1, 0); PG8_STAGE(PG8_SA(0, 1), a2 + hstep, voffA);
            PG8_WAIT_L(8); PG8_BAR; PG8_WAIT_L(0); PG8_MMA(0, 0, At, B0); PG8_BAR; PG8_SCHED;
            PG8_LDB(B1, 1, 1); PG8_STAGE(PG8_SB(1, 0), b3, voffB);
            PG8_BAR; PG8_WAIT_L(0); PG8_MMA(0, 1, At, B1); PG8_BAR;
            PG8_LDA(At, 1, 1); PG8_STAGE(PG8_SA(1, 0), a3, voffA);
            PG8_BAR; PG8_WAIT_L(0); PG8_MMA(1, 0, At, B0); PG8_BAR; PG8_SCHED;
            PG8_STAGE(PG8_SB(1, 1), b3 + hstep, voffB);
            PG8_WAIT_V(6); PG8_BAR; PG8_MMA(1, 1, At, B1); PG8_BAR;
            }
        }
        if constexpr (ALIGN_EPI) { if (wr == 0) PG8_BAR; }
        if constexpr (!Epi::AFTER_DRAIN) { E(acc, cur, wr, wc, fr, fq); S.done(cur); }
        if (!has_next) break;
#pragma unroll
        for (int a = 0; a < 2; ++a)
#pragma unroll
            for (int b = 0; b < 2; ++b)
#pragma unroll
                for (int m = 0; m < 4; ++m)
#pragma unroll
                    for (int n = 0; n < 2; ++n) acc[a][b][m][n] = (f32x4){0.f, 0.f, 0.f, 0.f};
        cur = nxt; cA = nA; cB = nB; ++ui;

        if constexpr (ALIGN_EPI) { if (wr == 1) PG8_BAR; }
    }
    PG8_WAIT_V(0);
    if constexpr (!ALIGN_EPI) { if (wr == 0) PG8_BAR; }
    PG8_BAR;
    if constexpr (Epi::AFTER_DRAIN) { E.fused(acc, cur, wr, wc, fr, fq, lds, wid, lane); S.done(cur); }
#undef PG8_SA
#undef PG8_STAGE_A
#undef PG8_GROWS
#undef PG8_SB
#undef PG8_STAGE
#undef PG8_LDA
#undef PG8_LDB
#undef PG8_MMA
#undef PG8_WAIT_V
#undef PG8_WAIT_L
#undef PG8_BAR
#undef PG8_SCHED
}
}

#ifndef PG8_SP2
#define PG8_SP2 true
#endif
#ifndef PG8_ALIGN
#define PG8_ALIGN true
#endif
#include <hip/hip_bf16.h>
#include <cmath>
namespace attn_body {
using bf16=__hip_bfloat16;
using bf16x8=__attribute__((ext_vector_type(8)))short;
using s16x4=__attribute__((ext_vector_type(4)))short;
using f32x16=__attribute__((ext_vector_type(16)))float;
using u32x4=__attribute__((ext_vector_type(4)))unsigned;
typedef float f32x4_t __attribute__((ext_vector_type(4)));
constexpr int BATCH=4,NHEAD=4,SEQ=8192,D=64,DM=3328,DO=1024;
constexpr int NW=8,QBLK=32,QB=QBLK*NW,KVBLK=64,NQB=SEQ/QB;
constexpr int ATTN_UNIT_ROWS=QB;
__device__ __forceinline__ int crow(int r,int hi){return (r&3)+8*(r>>2)+4*hi;}
#define SBAR() __builtin_amdgcn_sched_barrier(0)
__device__ __forceinline__ void cmask(f32x16&p0,f32x16&p1,int jb,int qrel,int hi){
  const float NEG=-INFINITY; int kb=64*jb+4*hi;
  #pragma unroll
  for(int r=0;r<16;++r){int kv=kb+(r&3)+8*(r>>2); if(kv>qrel)p0[r]=NEG; if(kv+32>qrel)p1[r]=NEG;}
}

constexpr int NSLOT=3, SLOTB=8192;
constexpr int LDS_K=0, LDS_V=NSLOT*SLOTB, LDS_WS=2*NSLOT*SLOTB, LDS_OST=LDS_WS+NW*64*4, LDS_F2=LDS_OST+NW*4096, LDS_BYTES=LDS_F2+SEQ*4;
constexpr float C2=0.125f*1.4426950408889634f;
__device__ __forceinline__ void glds16(const void*gsrc,unsigned lds_dst){unsigned keep;
  asm volatile("s_mov_b32 %0, m0\n\ts_mov_b32 m0, %2\n\ts_nop 0\n\tglobal_load_lds_dwordx4 %1, off\n\ts_mov_b32 m0, %0":"=&s"(keep):"v"(gsrc),"s"(lds_dst):"memory");}
__device__ __forceinline__ float max3f(float a,float b,float c){float r;asm("v_max3_f32 %0, %1, %2, %3":"=v"(r):"v"(a),"v"(b),"v"(c));return r;}
__device__ __forceinline__ float max2f(float a,float b){float r;asm("v_max_f32_e32 %0, %1, %2":"=v"(r):"v"(a),"v"(b));return r;}
__device__ __forceinline__ float fadd_s(float a,float b){float r;asm("v_add_f32_e32 %0, %1, %2":"=v"(r):"v"(a),"v"(b));return r;}
__device__ __forceinline__ float fsub_s(float a,float b){float r;asm("v_sub_f32_e32 %0, %1, %2":"=v"(r):"v"(a),"v"(b));return r;}
typedef float f32x2_t __attribute__((ext_vector_type(2))); typedef __bf16 bf16x2_t __attribute__((ext_vector_type(2)));
__device__ __forceinline__ unsigned cvtpk_s(float lo,float hi){f32x2_t v={lo,hi};bf16x2_t b=__builtin_convertvector(v,bf16x2_t);return __builtin_bit_cast(unsigned,b);}
#define WAIT_BAR(N) asm volatile("s_waitcnt vmcnt(" #N ") lgkmcnt(0)\n\ts_barrier":::"memory")

__device__ __forceinline__ void qkt(f32x16&p0,f32x16&p1,const char*Kslot,const bf16x8*qr,const f32x16&negm,int r32,int hi){
  const char*kb=Kslot+hi*1024+r32*16;
  #pragma unroll
  for(int d0=0;d0<4;++d0){
    const bf16x8 b0=*reinterpret_cast<const bf16x8*>(kb+d0*2048);
    const bf16x8 b1=*reinterpret_cast<const bf16x8*>(kb+d0*2048+512);
    if(d0==0){p0=__builtin_amdgcn_mfma_f32_32x32x16_bf16(b0,qr[0],negm,0,0,0);p1=__builtin_amdgcn_mfma_f32_32x32x16_bf16(b1,qr[0],negm,0,0,0);}
    else{p0=__builtin_amdgcn_mfma_f32_32x32x16_bf16(b0,qr[d0],p0,0,0,0);p1=__builtin_amdgcn_mfma_f32_32x32x16_bf16(b1,qr[d0],p1,0,0,0);}}
}
typedef __attribute__((address_space(3))) const char* lds_cptr;
typedef short v4i16_t __attribute__((ext_vector_type(4)));
__device__ __forceinline__ void kload8(bf16x8*kf,lds_cptr kp){
  kf[0]=*(const __attribute__((address_space(3))) bf16x8*)(kp);      kf[1]=*(const __attribute__((address_space(3))) bf16x8*)(kp+512);
  kf[2]=*(const __attribute__((address_space(3))) bf16x8*)(kp+2048); kf[3]=*(const __attribute__((address_space(3))) bf16x8*)(kp+2560);
  kf[4]=*(const __attribute__((address_space(3))) bf16x8*)(kp+4096); kf[5]=*(const __attribute__((address_space(3))) bf16x8*)(kp+4608);
  kf[6]=*(const __attribute__((address_space(3))) bf16x8*)(kp+6144); kf[7]=*(const __attribute__((address_space(3))) bf16x8*)(kp+6656);
}
__device__ __forceinline__ void kload2(bf16x8*kf,lds_cptr kp,int j){ kf[2*j]=*(const __attribute__((address_space(3))) bf16x8*)(kp+j*2048); kf[2*j+1]=*(const __attribute__((address_space(3))) bf16x8*)(kp+j*2048+512); }
__device__ __forceinline__ s16x4 vtr(lds_cptr p){ return __builtin_bit_cast(s16x4,__builtin_amdgcn_ds_read_tr16_b64_v4i16((__attribute__((address_space(3))) v4i16_t*)p)); }
__device__ __forceinline__ float rowmax(const f32x16&p0,const f32x16&p1){
  float a=max3f(p0[0],p0[1],p1[0]),b=max3f(p0[2],p0[3],p1[1]);a=max3f(a,p1[2],p1[3]);
  #pragma unroll
  for(int r=4;r<16;r+=4){a=max3f(a,p0[r],p0[r+1]);b=max3f(b,p0[r+2],p0[r+3]);a=max3f(a,p1[r],p1[r+1]);b=max3f(b,p1[r+2],p1[r+3]);}
  const float m=max2f(a,b);
  auto rr=__builtin_amdgcn_permlane32_swap(__float_as_uint(m),__float_as_uint(m),false,false);
  return max2f(__uint_as_float(rr[0]),__uint_as_float(rr[1]));
}
__device__ __forceinline__ void pv(f32x16*o,int vb,bf16x8 pa0,bf16x8 pa1,bf16x8 pa2,bf16x8 pa3){
  #pragma unroll
  for(int d0=0;d0<2;++d0){s16x4 lo[4],hi[4];
    #pragma unroll
    for(int ks=0;ks<4;++ks){
      asm volatile("ds_read_b64_tr_b16 %0,%1 offset:%c2":"=&v"(lo[ks]):"v"(vb),"i"(d0*4096+ks*1024):"memory");
      asm volatile("ds_read_b64_tr_b16 %0,%1 offset:%c2":"=&v"(hi[ks]):"v"(vb),"i"(d0*4096+ks*1024+512):"memory");}
    asm volatile("s_waitcnt lgkmcnt(0)":::"memory");SBAR();
    #define PK(k) (bf16x8){lo[k][0],lo[k][1],lo[k][2],lo[k][3],hi[k][0],hi[k][1],hi[k][2],hi[k][3]}
    o[d0]=__builtin_amdgcn_mfma_f32_32x32x16_bf16(pa0,PK(0),o[d0],0,0,0);
    o[d0]=__builtin_amdgcn_mfma_f32_32x32x16_bf16(pa1,PK(1),o[d0],0,0,0);
    o[d0]=__builtin_amdgcn_mfma_f32_32x32x16_bf16(pa2,PK(2),o[d0],0,0,0);
    o[d0]=__builtin_amdgcn_mfma_f32_32x32x16_bf16(pa3,PK(3),o[d0],0,0,0);
    #undef PK
  }
}

#ifndef ATTN_STORE16
#define ATTN_STORE16(p,v) (*(u32x4*)(p)=(v))
#endif
template<int THRL> __device__ __forceinline__ void attn_unit(int b,int h,int qb,const bf16*Q,const bf16*__restrict__ K,const bf16*__restrict__ V,bf16*O,const float*__restrict__ F2g,const float*__restrict__ gain,float qkb,char*shm){
  int tid_=threadIdx.x; asm volatile("":"+v"(tid_)); const int tid=tid_,lane=tid&63,r32=lane&31,hi=lane>>5; const int wid=__builtin_amdgcn_readfirstlane(tid>>6);
  const long rowbase=(long)b*SEQ; const int q0=qb*QB;
  const bf16*Qw=Q+(rowbase+q0+wid*QBLK)*DM+h*D;
  const float*f2row=F2g+((long)b*NHEAD+h)*SEQ;
  int t0;
  { const int NTf=(q0+QB)/KVBLK; const float thr=f2row[q0]+qkb+40.0f; const int ta=lane,tb=lane+64;
    const bool va=(ta<NTf-4)&&(f2row[64*ta+63]>thr), vb=(tb<NTf-4)&&(f2row[64*tb+63]>thr);
    t0=(__builtin_popcountll(__ballot(va))+__builtin_popcountll(__ballot(vb)))&~1; t0=__builtin_amdgcn_readfirstlane(t0); }
  const bf16*Kh=K+(rowbase+(long)t0*KVBLK)*DM+h*D,*Vh=V+(rowbase+(long)t0*KVBLK)*DM+h*D;
  const lds_cptr shm3=(lds_cptr)shm;
  const unsigned lds0=(unsigned)(uintptr_t)shm;
  float*wsf=(float*)(shm+LDS_WS)+wid*64;
  const bf16*ksrc=Kh+(long)lane*DM+wid*8;
  const bf16*vsrc=Vh+(long)(16*(wid&3)+(lane>>2))*DM+(wid>>2)*32+(lane&3)*8;
  const unsigned kdst=lds0+LDS_K+wid*1024, vdst=lds0+LDS_V+wid*1024;
  #define DMA_K(t,slot) glds16(ksrc+(long)(t)*KVBLK*DM,(unsigned)__builtin_amdgcn_readfirstlane(kdst+(slot)))
  #define DMA_V(t,slot) glds16(vsrc+(long)(t)*KVBLK*DM,(unsigned)__builtin_amdgcn_readfirstlane(vdst+(slot)))
  const int vb0=(int)(lds0+LDS_V)+((lane>>4)&1)*32+(lane&3)*8+(4*hi+((lane&15)>>2))*64;
  const char*Kbase=shm+LDS_K; bf16x8 kf[8];
  const lds_cptr kp0=shm3+LDS_K+hi*1024+r32*16; const lds_cptr vp0=shm3+LDS_V+((lane>>4)&1)*32+(lane&3)*8+(4*hi+((lane&15)>>2))*64;
  const int NT=(q0+QB)/KVBLK-t0;
  { const float*f2src=f2row+(long)t0*KVBLK; __attribute__((address_space(3))) float*f2l=(__attribute__((address_space(3))) float*)(shm3+LDS_F2);
    for(int i=tid;i<NT*KVBLK/4;i+=NW*64){ const f32x4_t v=*(const f32x4_t*)(f2src+4*i); *(__attribute__((address_space(3))) f32x4_t*)(f2l+4*i)=v; } }
  const __attribute__((address_space(3))) float*F2L=(const __attribute__((address_space(3))) float*)(shm3+LDS_F2)+4*hi;
  DMA_K(0,0);DMA_V(0,0);DMA_K(1,SLOTB);
  bf16x8 qr[4];
  #pragma unroll
  for(int d0=0;d0<4;++d0)qr[d0]=*reinterpret_cast<const bf16x8*>(&Qw[(long)r32*DM+d0*16+hi*8]);
  float mhat=0.f,l_reg=0.f;f32x16 o[2];o[0]=f32x16{};o[1]=f32x16{};f32x16 negm=f32x16{};asm volatile("":"+v"(negm));
  const int qrel=wid*QBLK+r32;
  #define CMASK(P0,P1,t) do{int jb_=(t)-(NT-4); if(jb_>=0)cmask(P0,P1,jb_,qrel,hi);}while(0)
  #define BIAS(P0,P1,t) do{ const __attribute__((address_space(3))) float*fb_=F2L+(t)*64; \
    const f32x4_t b00_=*(const __attribute__((address_space(3))) f32x4_t*)(fb_),    b01_=*(const __attribute__((address_space(3))) f32x4_t*)(fb_+8),  b02_=*(const __attribute__((address_space(3))) f32x4_t*)(fb_+16), b03_=*(const __attribute__((address_space(3))) f32x4_t*)(fb_+24); \
    const f32x4_t b10_=*(const __attribute__((address_space(3))) f32x4_t*)(fb_+32), b11_=*(const __attribute__((address_space(3))) f32x4_t*)(fb_+40), b12_=*(const __attribute__((address_space(3))) f32x4_t*)(fb_+48), b13_=*(const __attribute__((address_space(3))) f32x4_t*)(fb_+56); \
    _Pragma("unroll") for(int e_=0;e_<4;++e_){ P0[e_]-=b00_[e_]; P0[4+e_]-=b01_[e_]; P0[8+e_]-=b02_[e_]; P0[12+e_]-=b03_[e_]; P1[e_]-=b10_[e_]; P1[4+e_]-=b11_[e_]; P1[8+e_]-=b12_[e_]; P1[12+e_]-=b13_[e_]; } }while(0)
  bool resc=false;
  #define START(P0,P1) do{ const float rm=rowmax(P0,P1); resc=false; \
    { const float dl=rm; mhat=fadd_s(mhat,dl); \
      _Pragma("unroll") for(int r=0;r<16;++r){P0[r]=fsub_s(P0[r],dl);P1[r]=fsub_s(P1[r],dl);} \
      _Pragma("unroll") for(int r=0;r<16;++r)negm[r]=-mhat; asm volatile("":"+v"(negm)); } \
    _Pragma("unroll") for(int r=0;r<16;++r)P0[r]=__builtin_amdgcn_exp2f(P0[r]); }while(0)
  #define RESC() do{ if(resc){ asm volatile("s_waitcnt lgkmcnt(0)":::"memory"); \
      _Pragma("unroll") for(int d_=0;d_<2;++d_) _Pragma("unroll") for(int r=0;r<16;++r)o[d_][r]*=wsf[crow(r,hi)]; } }while(0)
  f32x16 pA0,pA1,pB0,pB1;
  int sl_prev=0,sl_cur=0,sl_next=SLOTB;
  #define ROT() do{sl_prev=sl_cur;sl_cur=sl_next;sl_next=(sl_next==(NSLOT-1)*SLOTB)?0:sl_next+SLOTB;}while(0)
  DMA_K(2,2*SLOTB);
  WAIT_BAR(3);
  qkt(pA0,pA1,Kbase,qr,negm,r32,hi);asm volatile("s_nop 15\n\ts_nop 7":"+v"(pA0),"+v"(pA1));BIAS(pA0,pA1,0);CMASK(pA0,pA1,0);
  START(pA0,pA1);
  _Pragma("unroll") for(int r=0;r<16;++r)pA1[r]=__builtin_amdgcn_exp2f(pA1[r]);
  WAIT_BAR(0);
  DMA_K(3,0);DMA_V(1,SLOTB);
  ROT();
  kload8(kf,kp0+sl_cur);
  WAIT_BAR(2);
  s16x4 vlo[8],vhi[8]; u32x4 pw0,pw1,pw2,pw3;
  #define PKW(P,B) cvtpk_s(P[B],P[B+1])
  #define PAF(k) __builtin_bit_cast(bf16x8,pw##k)
  #define VFR(i) (bf16x8){vlo[i][0],vlo[i][1],vlo[i][2],vlo[i][3],vhi[i][0],vhi[i][1],vhi[i][2],vhi[i][3]}
  #define PIN(x) asm volatile("":"+v"(x))
  #define MX3(a,b,c) __builtin_fmaxf(__builtin_fmaxf((a),(b)),(c))
  #define GAPA(MF,A0,A1,A2,A3,W0,W1,PW) do{ MF; sacc+=A0; sacc+=A1; sacc+=A2; sacc+=A3; PIN(sacc); W0; W1; PIN(PW); SBAR(); }while(0)
  #define EX(v) __builtin_amdgcn_exp2f(v)
  #define GAPB(MF,X,B) do{ MF; X[B]=EX(X[B]); X[B+1]=EX(X[B+1]); X[B+2]=EX(X[B+2]); X[B+3]=EX(X[B+3]); PIN(X); SBAR(); }while(0)
  #define VRD(i) do{ vlo[i]=vtr(vp_+(((i)>>2)*4096+((i)&3)*1024)); vhi[i]=vtr(vp_+(((i)>>2)*4096+((i)&3)*1024+512)); }while(0)
  #define KRD(G,j) do{ if(G){ kload2(kf,kp0+sl_next,j); SBAR(); } }while(0)
  #define STEP(C0,C1,P0,P1,t,GK,GV,GL) do{ SBAR(); \
    const lds_cptr vp_=vp0+sl_prev; \
    VRD(0); SBAR(); float sacc=(P0[0]+P0[1]); \
    GAPA(C0=__builtin_amdgcn_mfma_f32_32x32x16_bf16(kf[0],qr[0],negm,0,0,0), P0[2],P0[3],P0[4],P0[5],     pw0[0]=PKW(P0,0), pw0[1]=PKW(P0,2), pw0); \
    VRD(4); SBAR(); GAPA(C1=__builtin_amdgcn_mfma_f32_32x32x16_bf16(kf[1],qr[0],negm,0,0,0), P0[6],P0[7],P0[8],P0[9],     pw0[2]=PKW(P0,4), pw0[3]=PKW(P0,6), pw0); \
    VRD(1); SBAR(); GAPA(C0=__builtin_amdgcn_mfma_f32_32x32x16_bf16(kf[2],qr[1],C0,0,0,0),   P0[10],P0[11],P0[12],P0[13], pw1[0]=PKW(P0,8), pw1[1]=PKW(P0,10), pw1); \
    VRD(5); SBAR(); GAPA(C1=__builtin_amdgcn_mfma_f32_32x32x16_bf16(kf[3],qr[1],C1,0,0,0),   P0[14],P0[15],P1[0],P1[1],   pw1[2]=PKW(P0,12),pw1[3]=PKW(P0,14), pw1); \
    VRD(2); SBAR(); GAPA(C0=__builtin_amdgcn_mfma_f32_32x32x16_bf16(kf[4],qr[2],C0,0,0,0),   P1[2],P1[3],P1[4],P1[5],     pw2[0]=PKW(P1,0), pw2[1]=PKW(P1,2), pw2); \
    VRD(6); SBAR(); GAPA(C1=__builtin_amdgcn_mfma_f32_32x32x16_bf16(kf[5],qr[2],C1,0,0,0),   P1[6],P1[7],P1[8],P1[9],     pw2[2]=PKW(P1,4), pw2[3]=PKW(P1,6), pw2); \
    VRD(3); SBAR(); GAPA(C0=__builtin_amdgcn_mfma_f32_32x32x16_bf16(kf[6],qr[3],C0,0,0,0),   P1[10],P1[11],P1[12],P1[13], pw3[0]=PKW(P1,8), pw3[1]=PKW(P1,10), pw3); \
    VRD(7); SBAR(); GAPA(C1=__builtin_amdgcn_mfma_f32_32x32x16_bf16(kf[7],qr[3],C1,0,0,0),   P1[14],P1[15],0.f,0.f,       pw3[2]=PKW(P1,12),pw3[3]=PKW(P1,14), pw3); \
    l_reg+=sacc; \
    if(GK){DMA_K((t)+3,sl_cur);} if(GV){DMA_V((t)+1,sl_next);} \
    BIAS(C0,C1,t); CMASK(C0,C1,t); \
    { float a=MX3(C0[0],C0[1],C1[0]),b=MX3(C0[2],C0[3],C1[1]); a=MX3(a,C1[2],C1[3]); \
      _Pragma("unroll") for(int r=4;r<16;r+=4){a=MX3(a,C0[r],C0[r+1]);b=MX3(b,C0[r+2],C0[r+3]);a=MX3(a,C1[r],C1[r+1]);b=MX3(b,C1[r+2],C1[r+3]);} \
      float rm=__builtin_fmaxf(a,b); { auto rr=__builtin_amdgcn_permlane32_swap(__float_as_uint(rm),__float_as_uint(rm),false,false); rm=__builtin_fmaxf(__uint_as_float(rr[0]),__uint_as_float(rr[1])); } \
      resc=false; \
      if(__builtin_expect(__any(rm>(float)THRL),0)){ const float dl=__builtin_fmaxf(rm,0.f); mhat+=dl; \
        _Pragma("unroll") for(int r=0;r<16;++r){C0[r]-=dl;C1[r]-=dl;} \
        _Pragma("unroll") for(int r=0;r<16;++r)negm[r]=-mhat; asm volatile("":"+v"(negm)); \
        const float f=__builtin_amdgcn_exp2f(-dl); l_reg*=f; if(hi==0)wsf[r32]=f; resc=true; } } \
    SBAR(); \
    GAPB(o[0]=__builtin_amdgcn_mfma_f32_32x32x16_bf16(PAF(0),VFR(0),o[0],0,0,0), C0,0); \
    GAPB(o[1]=__builtin_amdgcn_mfma_f32_32x32x16_bf16(PAF(0),VFR(4),o[1],0,0,0), C0,4); \
    KRD(GL,0); GAPB(o[0]=__builtin_amdgcn_mfma_f32_32x32x16_bf16(PAF(1),VFR(1),o[0],0,0,0), C0,8); \
    KRD(GL,1); GAPB(o[1]=__builtin_amdgcn_mfma_f32_32x32x16_bf16(PAF(1),VFR(5),o[1],0,0,0), C0,12); \
    KRD(GL,2); GAPB(o[0]=__builtin_amdgcn_mfma_f32_32x32x16_bf16(PAF(2),VFR(2),o[0],0,0,0), C1,0); \
    KRD(GL,3); GAPB(o[1]=__builtin_amdgcn_mfma_f32_32x32x16_bf16(PAF(2),VFR(6),o[1],0,0,0), C1,4); \
    GAPB(o[0]=__builtin_amdgcn_mfma_f32_32x32x16_bf16(PAF(3),VFR(3),o[0],0,0,0), C1,8); \
    GAPB(o[1]=__builtin_amdgcn_mfma_f32_32x32x16_bf16(PAF(3),VFR(7),o[1],0,0,0), C1,12); \
    }while(0)
  int t=1;
  #undef CMASK
  #define CMASK(P0,P1,t) do{}while(0)
  for(;t+5<NT;t+=2){
    STEP(pB0,pB1,pA0,pA1,t,true,true,true);     WAIT_BAR(2); RESC(); ROT();
    STEP(pA0,pA1,pB0,pB1,t+1,true,true,true);   WAIT_BAR(2); RESC(); ROT();
  }
  #undef CMASK
  #define CMASK(P0,P1,t) do{int jb_=(t)-(NT-4); if(jb_>=0)cmask(P0,P1,jb_,qrel,hi);}while(0)
  #define ENDW(tt) do{ if((tt)+3<NT){WAIT_BAR(2);} else if((tt)+2<NT){WAIT_BAR(1);} else {WAIT_BAR(0);} }while(0)
  for(;t+1<NT;t+=2){
    STEP(pB0,pB1,pA0,pA1,t,(t+3<NT),(t+1<NT),(t+1<NT));       ENDW(t);   RESC(); ROT();
    STEP(pA0,pA1,pB0,pB1,t+1,(t+4<NT),(t+2<NT),(t+2<NT));     ENDW(t+1); RESC(); ROT();
  }
  STEP(pB0,pB1,pA0,pA1,NT-1,false,false,false); RESC();
  { float sacc=pB0[0]+pB0[1]; _Pragma("unroll") for(int r=2;r<16;++r)sacc+=pB0[r]; _Pragma("unroll") for(int r=0;r<16;++r)sacc+=pB1[r]; l_reg+=sacc;
    pw0=(u32x4){PKW(pB0,0),PKW(pB0,2),PKW(pB0,4),PKW(pB0,6)};pw1=(u32x4){PKW(pB0,8),PKW(pB0,10),PKW(pB0,12),PKW(pB0,14)};pw2=(u32x4){PKW(pB1,0),PKW(pB1,2),PKW(pB1,4),PKW(pB1,6)};pw3=(u32x4){PKW(pB1,8),PKW(pB1,10),PKW(pB1,12),PKW(pB1,14)};
    SBAR(); pv(o,vb0+sl_cur,PAF(0),PAF(1),PAF(2),PAF(3)); }
  #undef PKW
  #undef PAF
  #undef VFR
  #undef PIN
  #undef MX3
  #undef GAPA
  #undef GAPB
  #undef EX
  #undef VRD
  #undef KRD
  #undef STEP
  #undef ENDW
  {auto rr=__builtin_amdgcn_permlane32_swap(__float_as_uint(l_reg),__float_as_uint(l_reg),false,false);l_reg=__uint_as_float(rr[0])+__uint_as_float(rr[1]);}
  if(hi==0)wsf[32+r32]=l_reg;asm volatile("s_waitcnt lgkmcnt(0)":::"memory");
  float rli[16];
  #pragma unroll
  for(int r=0;r<16;++r)rli[r]=__builtin_amdgcn_rcpf(wsf[32+crow(r,hi)]);
  bf16*Ow=O+(rowbase+q0+wid*QBLK)*DO+h*D;
  { bf16*stg=(bf16*)(shm+LDS_OST)+wid*2048;
    #pragma unroll
    for(int r=0;r<16;++r){const int orow=crow(r,hi);
      #pragma unroll
      for(int d0=0;d0<2;++d0)stg[orow*64+d0*32+r32]=__float2bfloat16(o[d0][r]*rli[r]);}
    asm volatile("s_waitcnt lgkmcnt(0)":::"memory");
    const f32x4_t g0=*(const f32x4_t*)(gain+h*D+(lane&7)*8), g1=*(const f32x4_t*)(gain+h*D+(lane&7)*8+4);
    #pragma unroll
    for(int i=0;i<4;++i){const int row=i*8+(lane>>3),ch=lane&7; const u32x4 v=*(const u32x4*)(stg+row*64+ch*8);
      float x[8];
      #pragma unroll
      for(int e=0;e<4;++e){ x[2*e]=__uint_as_float(v[e]<<16); x[2*e+1]=__uint_as_float(v[e]&0xffff0000u); }
      float ss=0.f;
      #pragma unroll
      for(int e=0;e<8;++e)ss+=x[e]*x[e];
      ss+=__int_as_float(__builtin_amdgcn_ds_bpermute((lane^1)<<2,__float_as_int(ss))); ss+=__int_as_float(__builtin_amdgcn_ds_bpermute((lane^2)<<2,__float_as_int(ss))); ss+=__int_as_float(__builtin_amdgcn_ds_bpermute((lane^4)<<2,__float_as_int(ss)));
      const float rs=rsqrtf(ss*(1.0f/64.0f)+1e-6f);
      u32x4 w; w[0]=cvtpk_s(x[0]*rs*g0[0],x[1]*rs*g0[1]); w[1]=cvtpk_s(x[2]*rs*g0[2],x[3]*rs*g0[3]); w[2]=cvtpk_s(x[4]*rs*g1[0],x[5]*rs*g1[1]); w[3]=cvtpk_s(x[6]*rs*g1[2],x[7]*rs*g1[3]);
      ATTN_STORE16(Ow+(long)row*DO+ch*8,w);} }
  asm volatile("s_waitcnt lgkmcnt(0)\n\ts_barrier":::"memory");
  #undef DMA_K
  #undef DMA_V
  #undef CMASK
  #undef START
  #undef RESC
  #undef ROT
}
constexpr int ATTN_LDS_BYTES=LDS_BYTES;
struct AttnTensors { const bf16* Q; const bf16* K; const bf16* V; bf16* O; const float* F2; const float* gain; const unsigned* qkn; };
struct AttnUnit { int bh; int qb; };
struct StaticOrder {
  int vcu, G;
  __device__ __forceinline__ explicit StaticOrder(int grid,int block):vcu((grid%8==0)?(block%8)*(grid/8)+block/8:block),G(grid){}
  __device__ __forceinline__ bool next(int i,AttnUnit&u)const{ const int pair=vcu+(i>>1)*G; if(pair>=256)return false; const int s=pair&15; u.bh=pair>>4; u.qb=(i&1)?31-s:s; return true; }
  __device__ __forceinline__ void a_ready(const AttnUnit&)const{}
  __device__ __forceinline__ void done(const AttnUnit&)const{}
};
template<class Sched,int THRL=8> __device__ __forceinline__ void attn_phase(char*lds,const AttnTensors&T,const Sched&S){
  AttnUnit u;
  for(int i=0;S.next(i,u);++i){ S.a_ready(u); attn_unit<THRL>(u.bh/NHEAD,u.bh%NHEAD,u.qb,T.Q,T.K,T.V,T.O,T.F2,T.gain,2.0f*sqrtf(__uint_as_float(T.qkn[2*u.bh])*__uint_as_float(T.qkn[2*u.bh+1])),lds); S.done(u); }
}
#undef SBAR
#undef WAIT_BAR
}
#define GAS __attribute__((address_space(1)))
#define LAS __attribute__((address_space(3)))
typedef unsigned short bf16;
typedef unsigned v4u __attribute__((ext_vector_type(4)));
typedef float f32x4 __attribute__((ext_vector_type(4)));
typedef short bf16x8 __attribute__((ext_vector_type(8)));
typedef GAS unsigned gu32;
typedef GAS unsigned long long gu64;
#define RLX_AGENT __ATOMIC_RELAXED, __HIP_MEMORY_SCOPE_AGENT
#define LDS_WAIT() asm volatile("s_waitcnt lgkmcnt(0)" ::: "memory")
#define VM_WAIT() asm volatile("s_waitcnt vmcnt(0)" ::: "memory")
__device__ __forceinline__ unsigned long long rt() { return __builtin_amdgcn_s_memrealtime(); }
__device__ __forceinline__ unsigned f2bf(float f) { unsigned u = __builtin_bit_cast(unsigned, f); return (u + 0x7fffu + ((u >> 16) & 1u)) >> 16; }
__device__ __forceinline__ unsigned pk2(float lo, float hi) { return f2bf(lo) | (f2bf(hi) << 16); }

#define XB_TMO      128
#define XB_XCNT(j)  (256  + 64 * (j))
#define XB_XSUB(j)  (1280 + 64 * (j))
#define XB_XGEN(j)  (2304 + 64 * (j))
#define XB_TOP      3328
#define XB_TOPGEN   3392
#define XCD_BAR_WORDS 3456
#define XB_SPIN_CAP (1u << 18)
#ifndef XB_SCOPE
#define XB_SCOPE ""
#endif

__device__ __forceinline__ unsigned xb_ld(unsigned* p)              { return __hip_atomic_load(p, __ATOMIC_RELAXED, __HIP_MEMORY_SCOPE_AGENT); }
__device__ __forceinline__ unsigned xb_add(unsigned* p, unsigned v) { return __hip_atomic_fetch_add(p, v, __ATOMIC_RELAXED, __HIP_MEMORY_SCOPE_AGENT); }
__device__ __forceinline__ unsigned xb_xcc_id() { return (unsigned)__builtin_amdgcn_s_getreg((3 << 11) | 20) & 0xFu; }
#define XB_SPIN(cond, bar) do { unsigned _sp = 0; while (cond) { __builtin_amdgcn_s_sleep(1); \
    if ((++_sp & 255u) == 0u) { if (xb_ld(&(bar)[XB_TMO])) break; if (_sp > XB_SPIN_CAP) { atomicAdd(&(bar)[XB_TMO], 1u); break; } } } } while (0)

struct XcdBarrier {
    unsigned* bar; unsigned x;
    volatile LAS unsigned* st;
};

__device__ __forceinline__ XcdBarrier xcd_barrier_post(unsigned* bar, volatile LAS unsigned* st) {
    XcdBarrier b; b.bar = bar; b.x = xb_xcc_id(); b.st = st;
    if (threadIdx.x == 0) (void)xb_add(&bar[XB_XCNT(b.x)], 1u);
    return b;
}
__device__ __forceinline__ void xcd_barrier_complete(unsigned* bar, unsigned x, unsigned& nloc, unsigned& nx) {
    const unsigned G = gridDim.x * gridDim.y * gridDim.z;
    unsigned sum, cnt, mine, sp = 0u;
    for (;;) {
        sum = 0u; cnt = 0u; mine = 0u;
#pragma unroll
        for (unsigned j = 0; j < 16; ++j) { const unsigned c = xb_ld(&bar[XB_XCNT(j)]); sum += c; cnt += (c > 0u) ? 1u : 0u; mine = (j == x) ? c : mine; }
        if (sum == G) break;
        __builtin_amdgcn_s_sleep(1);
        if ((++sp & 255u) == 0u) { if (xb_ld(&bar[XB_TMO])) break; if (sp > XB_SPIN_CAP) { atomicAdd(&bar[XB_TMO], 1u); break; } }
    }
    nloc = mine > 0u ? mine : 1u; nx = cnt > 0u ? cnt : 1u;
}

__device__ __forceinline__ void xcd_barrier(const XcdBarrier& b) {
    asm volatile("s_waitcnt vmcnt(0)" ::: "memory");
    __syncthreads();
    if (threadIdx.x == 0) {
        unsigned* bar = b.bar;
        __builtin_amdgcn_s_waitcnt(0);
        unsigned nloc = b.st[0], nx = b.st[1];
        if (nloc == 0u) { xcd_barrier_complete(bar, b.x, nloc, nx); b.st[0] = nloc; b.st[1] = nx; }
        const unsigned old = xb_add(&bar[XB_XSUB(b.x)], 1u);
        const unsigned gen = old / nloc;
        if (old + 1u == (gen + 1u) * nloc) {
            __builtin_amdgcn_fence(__ATOMIC_RELEASE, XB_SCOPE);
            asm volatile("s_waitcnt vmcnt(0)" ::: "memory");
            const unsigned og = xb_add(&bar[XB_TOP], 1u);
            const unsigned tg = og / nx;
            if (og + 1u == (tg + 1u) * nx) xb_add(&bar[XB_TOPGEN], 1u);
            else XB_SPIN(xb_ld(&bar[XB_TOPGEN]) == tg, bar);
            __builtin_amdgcn_fence(__ATOMIC_ACQUIRE, XB_SCOPE);
            xb_add(&bar[XB_XGEN(b.x)], 1u);
            asm volatile("s_waitcnt vmcnt(0)" ::: "memory");
        } else {
            XB_SPIN(xb_ld(&bar[XB_XGEN(b.x)]) == gen, bar);
            __builtin_amdgcn_fence(__ATOMIC_ACQUIRE, XB_SCOPE);
            asm volatile("s_waitcnt vmcnt(0)" ::: "memory");
        }
    }
    __syncthreads();
}

constexpr int NWAVES = 8;
constexpr int T = 32768, D = 1024, SEQ = 8192, NBATCH = 4, NLAYER = 4, CHUNK = 128, NCHUNK = T / CHUNK, CPB = SEQ / CHUNK;
constexpr int DINP = 3344, PP = 3328, NPROJ_T = 3584;
constexpr int O_AQ = 0, O_AK = 256, O_AV = 512, O_SU = 768, O_SV = 1024, O_MZ = 1280, O_LQ = 2304, O_LK = 2560, O_LV = 2816, O_LO = 3072;
constexpr int O_XBC = 1536;
constexpr int XC = 768;
constexpr int NEXP = 32, DEXP = 512, MOE_TILES = 288, MOE_ROWS = MOE_TILES * 256;
constexpr float NORM_EPS = 1e-6f;
constexpr float ATT_C2 = 0.125f * 1.4426950408889634f;
constexpr float LOG2E = 1.4426950408889634f;

constexpr size_t MiB = 1u << 20;
constexpr size_t WS_CTL = 0, CTL_ZERO_BYTES = 256 * 1024;
constexpr size_t WS_MOD = 1 * MiB;
constexpr size_t WS_F2 = 2 * MiB;
constexpr size_t WS_SMALL = 3 * MiB;
constexpr size_t WS_TOK = 4 * MiB;
constexpr size_t WS_GATES = 5 * MiB;
constexpr size_t WS_WR = 7 * MiB;
constexpr size_t WS_WIN = 8 * MiB;
constexpr size_t WS_WOUT = 15 * MiB;
constexpr size_t WS_WGU = 17 * MiB;
constexpr size_t WS_WDN = 81 * MiB;
constexpr size_t WS_H = 113 * MiB;
constexpr size_t WS_PROJ = 177 * MiB;
constexpr size_t WS_Y = 385 * MiB;
constexpr size_t WS_XBCC = 449 * MiB;
constexpr size_t WS_SST = 497 * MiB;
constexpr size_t WS_SHIN = 529 * MiB;
constexpr size_t WS_MLS = 545 * MiB;
constexpr size_t WS_MLC = 565 * MiB;
constexpr size_t WS_XB = 575 * MiB;
constexpr size_t WS_ACT = 719 * MiB;
constexpr size_t WS_YB = 791 * MiB;
constexpr size_t WS_XDT = 935 * MiB;
constexpr size_t WS_SLOT = 951 * MiB;
constexpr size_t WS_XRES = 985 * MiB;
constexpr size_t WS_END = 1049 * MiB;
constexpr int CW_TMO = 0, CW_BAR = 4096, CW_QKN = 8192  , CW_Q = 8192 + 1024  , CW_QX = 8192 + 4096  , CW_PAN = 16384  , CW_CVQ = 8192 + 2048  ;
constexpr size_t EXP_ALT = 558 * MiB;
constexpr int RING_BYTES = 131072, MISC_OFF = RING_BYTES + 320, LDS_BYTES = 147456;

#define DI __device__ __forceinline__
typedef unsigned v2u __attribute__((ext_vector_type(2)));
namespace pg8 {
struct EpiProj { static constexpr bool PERM = true, AFTER_DRAIN = false;
    bf16_t* P; float* G;
    __device__ __forceinline__ void operator()(const f32x4 (&acc)[2][2][4][2], const Unit& u, int wr, int wc, int fr, int fq) const {
        const int row0 = u.pm * BM + wr * 64 + fr;
        if (u.pn < 13) {
            const int col0 = u.pn * BM + wc * 32 + 8 * fq;
#pragma unroll
            for (int ai = 0; ai < 2; ++ai)
#pragma unroll
                for (int m = 0; m < 4; ++m) { bf16_t* rowp = P + (size_t)(row0 + ai * HALF + m * 16) * 3328 + col0;
#pragma unroll
                    for (int bj = 0; bj < 2; ++bj) { const f32x4 v0 = acc[ai][bj][m][0], v1 = acc[ai][bj][m][1];
                        u32x4 w; w.x = cvt_pk_bf16(v0[0], v0[1]); w.y = cvt_pk_bf16(v0[2], v0[3]); w.z = cvt_pk_bf16(v1[0], v1[1]); w.w = cvt_pk_bf16(v1[2], v1[3]);
                        *(u32x4*)(rowp + bj * HALF) = w; } }
        } else if (wc == 0 && fq < 2) {
#pragma unroll
            for (int ai = 0; ai < 2; ++ai)
#pragma unroll
                for (int m = 0; m < 4; ++m) { float* gp = G + (size_t)(row0 + ai * HALF + m * 16) * 16 + 8 * fq;
                    *(f32x4*)(gp) = acc[ai][0][m][0]; *(f32x4*)(gp + 4) = acc[ai][0][m][1]; }
        }
    }
};
struct EpiOut { static constexpr bool PERM = true, AFTER_DRAIN = false;
    bf16_t* X; const float* gate;
    __device__ __forceinline__ void operator()(const f32x4 (&acc)[2][2][4][2], const Unit& u, int wr, int wc, int fr, int fq) const {
        const int row0 = u.pm * BM + wr * 64 + fr, col0 = u.pn * BM + wc * 32 + 8 * fq;
        const float* gb = gate + (size_t)((u.pm * BM) >> 13) * 6144 + col0;
        f32x4 gv[2][2];
#pragma unroll
        for (int bj = 0; bj < 2; ++bj)
#pragma unroll
            for (int n = 0; n < 2; ++n) gv[bj][n] = *(const f32x4*)(gb + bj * HALF + n * 4);
#pragma unroll
        for (int ai = 0; ai < 2; ++ai)
#pragma unroll
            for (int m = 0; m < 4; ++m) { bf16_t* rowp = X + (size_t)(row0 + ai * HALF + m * 16) * 1024 + col0;
#pragma unroll
                for (int bj = 0; bj < 2; ++bj) { const u32x4 xr = *(const u32x4*)(rowp + bj * HALF);
                    f32x4 x0, x1; x0[0] = __uint_as_float(xr.x << 16); x0[1] = __uint_as_float(xr.x & 0xffff0000u); x0[2] = __uint_as_float(xr.y << 16); x0[3] = __uint_as_float(xr.y & 0xffff0000u);
                    x1[0] = __uint_as_float(xr.z << 16); x1[1] = __uint_as_float(xr.z & 0xffff0000u); x1[2] = __uint_as_float(xr.w << 16); x1[3] = __uint_as_float(xr.w & 0xffff0000u);
                    x0 = x0 + gv[bj][0] * acc[ai][bj][m][0]; x1 = x1 + gv[bj][1] * acc[ai][bj][m][1];
                    u32x4 w; w.x = cvt_pk_bf16(x0[0], x0[1]); w.y = cvt_pk_bf16(x0[2], x0[3]); w.z = cvt_pk_bf16(x1[0], x1[1]); w.w = cvt_pk_bf16(x1[2], x1[3]);
                    *(u32x4*)(rowp + bj * HALF) = w; } }
    }
};
struct EpiOutNorm { static constexpr bool PERM = false, AFTER_DRAIN = true;
    float* X; const float* gate; const float* w2; const float* shift2; const float* scale2; bf16_t* Hout; float* slots; unsigned* cnt; unsigned* tmo;
    __device__ __forceinline__ void fused(f32x4 (&acc)[2][2][4][2], const Unit& u, int wr, int wc, int fr, int fq, PG8_LAS unsigned char* lds, int wid, int lane) const {
        PG8_LAS float* P = (PG8_LAS float*)lds;
        PG8_LAS float* S = (PG8_LAS float*)(lds + 4096);
        const int row0 = u.pm * BM + wr * 64 + fr, col0 = u.pn * BM + wc * 32 + 4 * fq; const size_t bo = (size_t)((u.pm * BM) >> 13) * 6144;
#pragma unroll
        for (int ai = 0; ai < 2; ++ai)
#pragma unroll
            for (int m = 0; m < 4; ++m) { float* rowp = X + (size_t)(row0 + ai * HALF + m * 16) * 1024 + col0; float ss = 0.f;
#pragma unroll
                for (int bj = 0; bj < 2; ++bj)
#pragma unroll
                    for (int n = 0; n < 2; ++n) { const f32x4 x = *(const f32x4*)(rowp + bj * HALF + n * 16), g = *(const f32x4*)(gate + bo + col0 + bj * HALF + n * 16);
                        const f32x4 v = x + g * acc[ai][bj][m][n]; acc[ai][bj][m][n] = v; *(f32x4*)(rowp + bj * HALF + n * 16) = v; ss += (v[0] * v[0] + v[1] * v[1]) + (v[2] * v[2] + v[3] * v[3]); }
                ss += __int_as_float(__builtin_amdgcn_ds_bpermute((lane ^ 16) << 2, __float_as_int(ss))); ss += __int_as_float(__builtin_amdgcn_ds_bpermute((lane ^ 32) << 2, __float_as_int(ss)));
                if (fq == 0) P[(ai * HALF + wr * 64 + m * 16 + fr) * 4 + wc] = ss; }
        asm volatile("s_waitcnt lgkmcnt(0)" ::: "memory"); __builtin_amdgcn_s_barrier(); asm volatile("" ::: "memory");
        const int row = wid * 32 + (lane & 31);
        if (lane < 32) { const float t = (P[row * 4 + 0] + P[row * 4 + 1]) + (P[row * 4 + 2] + P[row * 4 + 3]);
            __hip_atomic_store((unsigned*)slots + ((size_t)(u.pm * BM + row) * 4 + u.pn), __float_as_uint(t), __ATOMIC_RELAXED, __HIP_MEMORY_SCOPE_AGENT); }
        asm volatile("s_waitcnt vmcnt(0)" ::: "memory");
        if (lane == 0) __hip_atomic_fetch_add(cnt + 64 * u.pm, 1u, __ATOMIC_RELAXED, __HIP_MEMORY_SCOPE_AGENT);
        if (wid == 0) { const unsigned long long t0 = __builtin_amdgcn_s_memrealtime();
            for (;;) { if ((unsigned)__builtin_amdgcn_readfirstlane(__hip_atomic_load(cnt + 64 * u.pm, __ATOMIC_RELAXED, __HIP_MEMORY_SCOPE_AGENT)) >= 32u) break;
                if (__builtin_amdgcn_s_memrealtime() - t0 > 2000000ull) { if (lane == 0) __hip_atomic_store(tmo, 1u, __ATOMIC_RELAXED, __HIP_MEMORY_SCOPE_AGENT); break; }
                __builtin_amdgcn_s_sleep(2); }
            __builtin_amdgcn_fence(__ATOMIC_ACQUIRE, "agent"); }
        asm volatile("s_waitcnt vmcnt(0) lgkmcnt(0)" ::: "memory"); __builtin_amdgcn_s_barrier(); asm volatile("" ::: "memory");
        if (lane < 32) { const unsigned* sl = (const unsigned*)slots + (size_t)(u.pm * BM + row) * 4; float t4[4];
#pragma unroll
            for (int t = 0; t < 4; ++t) t4[t] = __uint_as_float(__hip_atomic_load(sl + t, __ATOMIC_RELAXED, __HIP_MEMORY_SCOPE_AGENT));
            S[row] = rsqrtf(((t4[0] + t4[1]) + (t4[2] + t4[3])) * (1.0f / 1024.0f) + 1e-6f); }
        asm volatile("s_waitcnt lgkmcnt(0)" ::: "memory"); __builtin_amdgcn_s_barrier(); asm volatile("" ::: "memory");
        f32x4 wv[2][2], sc[2][2], sh[2][2];
#pragma unroll
        for (int bj = 0; bj < 2; ++bj)
#pragma unroll
            for (int n = 0; n < 2; ++n) { const int c = col0 + bj * HALF + n * 16; wv[bj][n] = *(const f32x4*)(w2 + c); sc[bj][n] = *(const f32x4*)(scale2 + bo + c) + 1.f; sh[bj][n] = *(const f32x4*)(shift2 + bo + c); wv[bj][n] = wv[bj][n] * sc[bj][n]; }
#pragma unroll
        for (int ai = 0; ai < 2; ++ai)
#pragma unroll
            for (int m = 0; m < 4; ++m) { const int r = ai * HALF + wr * 64 + m * 16 + fr; const float rs = S[r]; bf16_t* hp = Hout + (size_t)(u.pm * BM + r) * 1024 + col0;
#pragma unroll
                for (int bj = 0; bj < 2; ++bj)
#pragma unroll
                    for (int n = 0; n < 2; ++n) { const f32x4 h = acc[ai][bj][m][n] * rs * wv[bj][n] + sh[bj][n];
                        typedef unsigned u32x2 __attribute__((ext_vector_type(2))); u32x2 w; w.x = cvt_pk_bf16(h[0], h[1]); w.y = cvt_pk_bf16(h[2], h[3]);
                        *(u32x2*)(hp + bj * HALF + n * 16) = w; } }
    }
};
struct OneRound { StaticOrder so; int round;
    __device__ __forceinline__ bool next(int i, Unit& u) const { return i == 0 && so.next(round, u); }
    __device__ __forceinline__ void a_ready(const Unit&) const {}
    __device__ __forceinline__ void done(const Unit&) const {}
};
struct EpiGU { static constexpr bool PERM = true, AFTER_DRAIN = false;
    bf16_t* A;
    __device__ __forceinline__ void operator()(const f32x4 (&acc)[2][2][4][2], const Unit& u, int wr, int wc, int fr, int fq) const {
        const int row0 = u.pm * BM + wr * 64 + fr, col0 = (u.pn & 3) * 128 + wc * 16 + 4 * fq;
#pragma unroll
        for (int ai = 0; ai < 2; ++ai)
#pragma unroll
            for (int m = 0; m < 4; ++m) { bf16_t* rowp = A + (size_t)(row0 + ai * HALF + m * 16) * 512 + col0;
#pragma unroll
                for (int bj = 0; bj < 2; ++bj) { const f32x4 g = acc[ai][bj][m][0], up = acc[ai][bj][m][1]; f32x4 a;
#pragma unroll
                    for (int e = 0; e < 4; ++e) a[e] = g[e] * __builtin_amdgcn_rcpf(1.f + __expf(-g[e])) * up[e];
                    typedef unsigned u32x2 __attribute__((ext_vector_type(2)));
                    u32x2 w; w.x = cvt_pk_bf16(a[0], a[1]); w.y = cvt_pk_bf16(a[2], a[3]);
                    *(u32x2*)(rowp + bj * 64) = w; } }
    }
};
struct EpiDown { static constexpr bool PERM = true, AFTER_DRAIN = false;
    bf16_t* Yb;
    __device__ __forceinline__ void operator()(const f32x4 (&acc)[2][2][4][2], const Unit& u, int wr, int wc, int fr, int fq) const {
        const int row0 = u.pm * BM + wr * 64 + fr, col0 = (u.pn & 3) * BM + wc * 32 + 8 * fq;
#pragma unroll
        for (int ai = 0; ai < 2; ++ai)
#pragma unroll
            for (int m = 0; m < 4; ++m) { bf16_t* rowp = Yb + (size_t)(row0 + ai * HALF + m * 16) * 1024 + col0;
#pragma unroll
                for (int bj = 0; bj < 2; ++bj) { const f32x4 v0 = acc[ai][bj][m][0], v1 = acc[ai][bj][m][1];
                    u32x4 w; w.x = cvt_pk_bf16(v0[0], v0[1]); w.y = cvt_pk_bf16(v0[2], v0[3]); w.z = cvt_pk_bf16(v1[0], v1[1]); w.w = cvt_pk_bf16(v1[2], v1[3]);
                    *(u32x4*)(rowp + bj * HALF) = w; } }
    }
};
struct MoeOrder {
    int G, c; const PG8_LAS int* xt;
    __device__ __forceinline__ bool next(int i, Unit& u) const {
        int ul = i * (G >> 3) + (c >> 3);
        if (ul >= xt[4]) return false;
        const int s = (ul >= xt[1] ? 1 : 0) + (ul >= xt[2] ? 1 : 0) + (ul >= xt[3] ? 1 : 0);
        ul -= xt[s];
        u.pm = xt[8 + s] + (ul >> 2); u.pn = 4 * ((c & 7) + 8 * s) + (ul & 3); return true;
    }
    __device__ __forceinline__ void a_ready(const Unit&) const {}
    __device__ __forceinline__ void done(const Unit&) const {}
};
}

DI float bf2f(unsigned b) { return __uint_as_float(b << 16); }
typedef float f32x2h_t __attribute__((ext_vector_type(2))); typedef __bf16 bf16x2h_t __attribute__((ext_vector_type(2)));
DI unsigned pk2h(float lo, float hi) { const f32x2h_t v = {lo, hi}; return __builtin_bit_cast(unsigned, __builtin_convertvector(v, bf16x2h_t)); }
DI float silu_f(float x) { return x * __builtin_amdgcn_rcpf(1.f + __expf(-x)); }
DI float sigmoid_f(float x) { return __builtin_amdgcn_rcpf(1.f + __expf(-x)); }
DI float gelu_tanh_f(float x) { const float z = 0.7978845608028654f * (x + 0.044715f * x * x * x); return x * __builtin_amdgcn_rcpf(1.f + __expf(-2.f * z)); }
DI float log_sigmoid_f(float x) { return fminf(x, 0.f) - log1pf(__expf(-fabsf(x))); }
DI float softplus_f(float x) { return fmaxf(x, 0.f) + log1pf(__expf(-fabsf(x))); }
DI float shx(float v, int o, int lane) { return __int_as_float(__builtin_amdgcn_ds_bpermute((lane ^ o) << 2, __float_as_int(v))); }
DI float shup(float v, int o, int lane) { return __int_as_float(__builtin_amdgcn_ds_bpermute(((lane - o) & 63) << 2, __float_as_int(v))); }
DI float shidx(float v, int src) { return __int_as_float(__builtin_amdgcn_ds_bpermute(src << 2, __float_as_int(v))); }
DI float wave_sum(float v, int lane) {
#pragma unroll
    for (int o = 1; o < 64; o <<= 1) v += shx(v, o, lane);
    return v;
}
DI f32x4 mfma16(bf16x8 a, bf16x8 b, f32x4 c) { asm volatile("s_nop 3" : "+v"(a), "+v"(b)); return __builtin_amdgcn_mfma_f32_16x16x32_bf16(a, b, c, 0, 0, 0); }
#define GL_PIN(x) asm volatile("s_nop 4" : "+v"(x))
#define GL_PIN4(a, b, c, d) asm volatile("s_nop 4" : "+v"(a), "+v"(b), "+v"(c), "+v"(d))
DI void unpack8(const v4u w, float (&x)[8]) {
#pragma unroll
    for (int e = 0; e < 4; ++e) { x[2 * e] = __uint_as_float(w[e] << 16); x[2 * e + 1] = __uint_as_float(w[e] & 0xffff0000u); }
}

struct Frame {
    LAS unsigned char* lds;
    volatile LAS unsigned* MISC;
    gu32* ctl;
    int tid, lane, wave, vcu, G, bx, l; size_t z;
    float* out; unsigned char* ws;
};
constexpr int PTRTAB_OFF = 131072 + 2048;
DI const float* inp(const Frame& F, int i) {
    const LAS unsigned* t = (const LAS unsigned*)(F.lds + PTRTAB_OFF) + 2 * i;
    const unsigned lo = __builtin_amdgcn_readfirstlane(t[0]), hi = __builtin_amdgcn_readfirstlane(t[1]);
    return (const float*)(const GAS float*)(((unsigned long long)hi << 32) | lo);
}
enum { I_X = 0, I_C, I_WIN, I_WOUT, I_MIXG, I_AFB, I_SGW, I_SGB, I_CONVW, I_CONVB, I_DTB, I_ALOG, I_DSKIP, I_IB, I_FB, I_WADA, I_BADA, I_WN1, I_WN2, I_WRG, I_BRG, I_WRE, I_BRE, I_WEG, I_WEU, I_WED, I_WNF };

DI void refresh(Frame& F) { int t_ = F.tid; asm volatile("" : "+v"(t_)); F.tid = t_; F.lane = t_ & 63; F.wave = __builtin_amdgcn_readfirstlane(t_ >> 6); size_t z_ = 0; unsigned zl_ = 0; asm volatile("" : "+s"(z_), "+s"(zl_)); F.ws = F.ws + z_; F.lds = F.lds + zl_; }
DI void tile_g2l(LAS bf16* dst, int lp, const bf16* src, size_t gp, int rows, int cols, int tid) {
    const int cpr = cols >> 3, n = rows * cpr;
    if (n % (4 * NWAVES * 64) == 0) {
        for (int i0 = tid; i0 < n; i0 += 4 * NWAVES * 64) { v4u t[4];
#pragma unroll
            for (int j = 0; j < 4; ++j) { const int i = i0 + j * NWAVES * 64, r = i / cpr, c = (i % cpr) * 8; t[j] = *(const v4u*)(src + (size_t)r * gp + c); }
#pragma unroll
            for (int j = 0; j < 4; ++j) { const int i = i0 + j * NWAVES * 64, r = i / cpr, c = (i % cpr) * 8; *(LAS v4u*)(dst + r * lp + c) = t[j]; } }
        return; }
    for (int i = tid; i < n; i += NWAVES * 64) { const int r = i / cpr, c = (i % cpr) * 8; *(LAS v4u*)(dst + r * lp + c) = *(const v4u*)(src + (size_t)r * gp + c); }
}
DI void tile_l2g(bf16* dst, size_t gp, const LAS bf16* src, int lp, int rows, int cols, int tid) {
    const int cpr = cols >> 3, n = rows * cpr;
    for (int i = tid; i < n; i += NWAVES * 64) { const int r = i / cpr, c = (i % cpr) * 8; *(v4u*)(dst + (size_t)r * gp + c) = *(const LAS v4u*)(src + r * lp + c); }
}
template <bool IS_MAX> DI float scan128(float x, int tid, LAS float* red) {
    const int lane = tid & 63;
#pragma unroll
    for (int o = 1; o < 64; o <<= 1) { const float y = shup(x, o, lane); if (lane >= o) x = IS_MAX ? fmaxf(x, y) : x + y; }
    if (tid == 63) red[0] = x;
    __syncthreads();
    if (tid >= 64 && tid < 128) { const float p = red[0]; x = IS_MAX ? fmaxf(x, p) : x + p; }
    __syncthreads();
    return x;
}

DI void p_mod(Frame& F) {
    LAS float* SC = (LAS float*)F.lds;
    LAS float* RED = SC + 4096;
    const float* c = inp(F, I_C);
    for (int i = F.tid; i < 4096; i += 512) SC[i] = silu_f(c[i]);
    __syncthreads();
    float* mod = (float*)(F.ws + WS_MOD);
    const int jj = F.tid & 63, kg = F.tid >> 6;
    for (int u = F.bx; u < NLAYER * 96; u += F.G) {
        const int l = u / 96, j0 = (u % 96) * 64;
        const float* w = inp(F, I_WADA) + ((size_t)l * 1024 + kg * 128) * 6144 + j0 + jj;
        float a0 = 0.f, a1 = 0.f, a2 = 0.f, a3 = 0.f;
#pragma unroll 16
        for (int k = 0; k < 128; ++k) { const float wv = __builtin_nontemporal_load(w + (size_t)k * 6144); const int kk = kg * 128 + k; a0 += SC[kk] * wv; a1 += SC[1024 + kk] * wv; a2 += SC[2048 + kk] * wv; a3 += SC[3072 + kk] * wv; }
        RED[(kg * 4 + 0) * 64 + jj] = a0; RED[(kg * 4 + 1) * 64 + jj] = a1; RED[(kg * 4 + 2) * 64 + jj] = a2; RED[(kg * 4 + 3) * 64 + jj] = a3;
        __syncthreads();
        if (F.tid < 256) { const int b = F.tid >> 6; float s = inp(F, I_BADA)[(size_t)l * 6144 + j0 + jj];
#pragma unroll
            for (int g = 0; g < 8; ++g) s += RED[(g * 4 + b) * 64 + jj];
            mod[((size_t)l * 4 + b) * 6144 + j0 + jj] = s; }
        __syncthreads();
    }
}

struct CvItem { const float* gp; size_t N; bf16* WT; int d0, K, k0; float sc; };
DI void cv_load(const CvItem& d, int lane, f32x4 (&v)[16]) {
    const int kp = lane >> 4;
#pragma unroll
    for (int i = 0; i < 8; ++i) { const int p = 4 * i + kp; v[2 * i] = (f32x4){0.f, 0.f, 0.f, 0.f}; v[2 * i + 1] = v[2 * i];
        if (d.gp) { v[2 * i] = __builtin_nontemporal_load((const f32x4*)(d.gp + (size_t)(d.k0 + 2 * p) * d.N)); v[2 * i + 1] = __builtin_nontemporal_load((const f32x4*)(d.gp + (size_t)(d.k0 + 2 * p + 1) * d.N)); } }
}
DI void cv_finish(const CvItem& d, const f32x4 (&v)[16], LAS unsigned* scr, int lane) {
    const int kp = lane >> 4, gi = lane & 15;
#pragma unroll
    for (int i = 0; i < 8; ++i) { const int p = 4 * i + kp;
#pragma unroll
        for (int e = 0; e < 4; ++e) scr[(4 * gi + e) * 33 + p] = pk2h(v[2 * i][e] * d.sc, v[2 * i + 1][e] * d.sc); }
    LDS_WAIT(); asm volatile("" ::: "memory");
    const int c = lane & 7;
#pragma unroll
    for (int j = 0; j < 8; ++j) { const int n = (lane >> 3) + 8 * j; const LAS unsigned* s = scr + n * 33 + 4 * c;
        v4u o; o.x = s[0]; o.y = s[1]; o.z = s[2]; o.w = s[3];
        __builtin_nontemporal_store(o, (GAS v4u*)(d.WT + (size_t)(d.d0 + n) * d.K + d.k0 + 8 * c)); }
    LDS_WAIT(); asm volatile("" ::: "memory");
}
constexpr int CV_IN = 13 * 4 * 16, CV_INS = 16, CV_OUT = 256, CV_R = 16, CV_DENSE = CV_IN + CV_INS + CV_OUT + CV_R, CV_GU = 32 * 256, CV_DN = 32 * 128, CV_EXP = CV_GU + CV_DN, CV_WIN = CV_IN + CV_INS, CV_ALL = CV_DENSE + CV_EXP;
DI CvItem cv_decode(Frame& F, int l, int it, int gi) {
    int r = it;
    if (r < CV_IN) { const int tile = r >> 6, blk = (r >> 4) & 3, kb = r & 15;
        const int so = tile == 0 ? 0 : tile == 1 ? 256 : tile == 2 ? 512 : tile == 3 ? 772 : tile == 4 ? 1028 : tile == 5 ? 1284 : tile == 6 ? 1540 : tile == 7 ? 1796 : tile == 8 ? 2052 : tile == 9 ? 2312 : tile == 10 ? 2568 : tile == 11 ? 2824 : 3080;
        return CvItem{inp(F, I_WIN) + (size_t)l * 1024 * DINP + so + blk * 64 + 4 * gi, DINP, (bf16*)(F.ws + WS_WIN), tile * 256 + blk * 64, 1024, kb * 64, tile == 0 ? ATT_C2 : 1.f}; }
    r -= CV_IN;
    if (r < CV_INS) { const int col = gi == 0 ? 768 : gi == 1 ? 2308 : gi == 2 ? 3336 : gi == 3 ? 3340 : -1;
        return CvItem{col >= 0 ? inp(F, I_WIN) + (size_t)l * 1024 * DINP + col : nullptr, DINP, (bf16*)(F.ws + WS_WIN), 3328, 1024, r * 64, 1.f}; }
    r -= CV_INS;
    if (r < CV_OUT) { const int blk = r >> 4, kb = r & 15;
        return CvItem{inp(F, I_WOUT) + (size_t)l * 1024 * 1024 + blk * 64 + 4 * gi, 1024, (bf16*)(F.ws + WS_WOUT), blk * 64, 1024, kb * 64, 1.f}; }
    r -= CV_OUT;
    if (r < CV_R) { const float* cp = gi == 0 ? inp(F, I_WRG) + (size_t)l * 1024 * 4 : gi <= 8 ? inp(F, I_WRE) + (size_t)l * 1024 * 32 + 4 * (gi - 1) : nullptr;
        return CvItem{cp, (size_t)(gi == 0 ? 4 : 32), (bf16*)(F.ws + WS_WR), 0, 1024, r * 64, 1.f}; }
    r -= CV_R;
    if (r < CV_GU) { const int e = r >> 8, blk = (r >> 4) & 15, kb = r & 15, rr = blk * 64 + 4 * gi, j = rr >> 8, cc = rr & 255;
        const int which = (cc >> 2) & 1, uu = 128 * j + 64 * (cc >> 7) + ((cc & 127) >> 3) * 4;
        return CvItem{(which ? inp(F, I_WEU) : inp(F, I_WEG)) + ((size_t)(l * 32 + e) * 1024) * 512 + uu, 512, (bf16*)(F.ws + WS_WGU + (size_t)(l & 1) * EXP_ALT) + (size_t)e * 1024 * 1024, blk * 64, 1024, kb * 64, 1.f}; }
    r -= CV_GU;
    { const int e = r >> 7, blk = (r >> 3) & 15, kb = r & 7;
        return CvItem{inp(F, I_WED) + ((size_t)(l * 32 + e) * 512) * 1024 + blk * 64 + 4 * gi, 1024, (bf16*)(F.ws + WS_WDN + (size_t)(l & 1) * EXP_ALT) + (size_t)e * 1024 * 512, blk * 64, 512, kb * 64, 1.f}; }
}
DI void p_convert(Frame& F, int l, int n0, int n1, int gw = -1, int NGW = 0) {
    LAS unsigned* scr = (LAS unsigned*)(F.lds + F.wave * 16384);
    if (gw < 0) { gw = F.vcu * NWAVES + F.wave; NGW = F.G * NWAVES; }
    const int gi = F.lane & 15;
    int it = n0 + gw; if (it >= n1) return;
    CvItem da = cv_decode(F, l, it, gi), db = da; f32x4 va[16], vb[16]; cv_load(da, F.lane, va);
    _Pragma("unroll 1") for (;;) {
        { const int nx = it + NGW; const bool more = nx < n1;
          if (more) { db = cv_decode(F, l, nx, gi); cv_load(db, F.lane, vb); }
          cv_finish(da, va, scr, F.lane);
          if (!more) break;
          it = nx; }
        { const int nx = it + NGW; const bool more = nx < n1;
          if (more) { da = cv_decode(F, l, nx, gi); cv_load(da, F.lane, va); }
          cv_finish(db, vb, scr, F.lane);
          if (!more) break;
          it = nx; }
    }
}

DI void p_convert_np(Frame& F, int l, int n0, int n1, int gw, int NGW) {
    LAS unsigned* scr = (LAS unsigned*)(F.lds + F.wave * 16384);
    const int gi = F.lane & 15;
    _Pragma("unroll 1") for (int it = n0 + gw; it < n1; it += NGW) { CvItem da = cv_decode(F, l, it, gi); f32x4 va[16]; cv_load(da, F.lane, va); cv_finish(da, va, scr, F.lane); }
}

DI int cvq_grab(gu32* ctr, int lane) { unsigned v = 0u; if (lane == 0) v = __hip_atomic_fetch_add(ctr, 1u, __ATOMIC_RELAXED, __HIP_MEMORY_SCOPE_AGENT); return (int)__builtin_amdgcn_readfirstlane(v); }
DI void p_convert_q(Frame& F, int lconv, gu32* ctr, int cap) {
    LAS unsigned* scr = (LAS unsigned*)(F.lds + F.wave * 16384);
    const int gi = F.lane & 15;
    int it = cvq_grab(ctr, F.lane); if (it >= CV_EXP) return;
    CvItem da = cv_decode(F, lconv, CV_DENSE + it, gi); f32x4 va[16]; cv_load(da, F.lane, va);
    int ndone = 1;
    for (;;) {
        const int nx = (cap < 0 || ndone < cap) ? cvq_grab(ctr, F.lane) : CV_EXP; const bool more = nx < CV_EXP;
        CvItem db = da; f32x4 vb[16];
#pragma unroll
        for (int i = 0; i < 16; ++i) vb[i] = va[i];
        if (more) { db = cv_decode(F, lconv, CV_DENSE + nx, gi); cv_load(db, F.lane, vb); }
        cv_finish(da, va, scr, F.lane);
        if (!more) break;
        da = db; ++ndone;
#pragma unroll
        for (int i = 0; i < 16; ++i) va[i] = vb[i];
    }
}

template <int MODE> DI void p_norm(Frame& F, const void* xin, const bool xbf, int comb_l, bf16* xout, const float* wn, const float* shift, const float* scale, bf16* hout, float* fout, const int blk = -1) {
    const int gw0 = F.vcu * NWAVES + F.wave; const int gw = blk < 0 ? gw0 : blk * 128 + F.wave * 16, NGW = blk < 0 ? F.G * NWAVES : 1, TE = blk < 0 ? T : blk * 128 + F.wave * 16 + 16;
    const float* mod = (const float*)(F.ws + WS_MOD);
    const int* tokd = (const int*)(F.ws + WS_TOK + 768 * 1024); const float* tokw = (const float*)(F.ws + WS_TOK + 512 * 1024);
#ifdef DIAG_COMB_XB
    const bf16* yb = (const bf16*)(F.ws + WS_XB);
#else
    const bf16* yb = (const bf16*)(F.ws + WS_YB);
#endif
    const bool comb = comb_l >= 0;
    f32x4 wv[4];
#pragma unroll
    for (int j = 0; j < 4; ++j) wv[j] = *((const f32x4*)wn + F.lane + 64 * j);
    struct Tok { v2u d, w; };
    struct Row { v2u xb[4]; f32x4 xf[4]; v2u ya[4], yc[4]; };
    auto ld_tok = [&](const int m, Tok& t) { t.d = *(const v2u*)(tokd + 2 * m); t.w = *(const v2u*)((const unsigned*)tokw + 2 * m); };
    auto ld_row = [&](const int m, const Tok& t, Row& R) {
        if (xbf) { const GAS v2u* xr = (const GAS v2u*)((const bf16*)xin + (size_t)m * D) + F.lane;
#pragma unroll
            for (int j = 0; j < 4; ++j) R.xb[j] = __builtin_nontemporal_load(xr + 64 * j);
        } else { const GAS f32x4* xr = (const GAS f32x4*)((const float*)xin + (size_t)m * D) + F.lane;
#pragma unroll
            for (int j = 0; j < 4; ++j) R.xf[j] = __builtin_nontemporal_load(xr + 64 * j); }
        if (comb) {
#pragma unroll
            for (int j = 0; j < 4; ++j) { R.ya[j] = __builtin_nontemporal_load((const v2u*)(yb + (size_t)t.d[0] * 1024) + F.lane + 64 * j); R.yc[j] = __builtin_nontemporal_load((const v2u*)(yb + (size_t)t.d[1] * 1024) + F.lane + 64 * j); } } };
    Tok tA, tB; Row RA;
    tA.d = (v2u){0u, 0u}; tA.w = tA.d; tB = tA;
    if (gw < TE) { if (comb) { ld_tok(gw, tA); if (gw + NGW < TE) ld_tok(gw + NGW, tB); } ld_row(gw, tA, RA); }
    for (int m = gw; m < TE; m += NGW) {
        Row RN; Tok tN; tN.d = (v2u){0u, 0u}; tN.w = tN.d;
        if (m + NGW < TE) { ld_row(m + NGW, tB, RN); if (comb && m + 2 * NGW < TE) ld_tok(m + 2 * NGW, tN); }
        const int b = m >> 13;
        f32x4 v[4];
        if (xbf) {
#pragma unroll
            for (int j = 0; j < 4; ++j) { const v2u a = RA.xb[j];
                v[j][0] = __uint_as_float(a[0] << 16); v[j][1] = __uint_as_float(a[0] & 0xffff0000u); v[j][2] = __uint_as_float(a[1] << 16); v[j][3] = __uint_as_float(a[1] & 0xffff0000u); }
        } else {
#pragma unroll
            for (int j = 0; j < 4; ++j) v[j] = RA.xf[j];
        }
        if (comb) {
            const float w0 = __uint_as_float(tA.w[0]), w1 = __uint_as_float(tA.w[1]);
            const float* g2 = mod + ((size_t)comb_l * 4 + b) * 6144 + 5 * 1024;
#pragma unroll
            for (int j = 0; j < 4; ++j) { const v2u a = RA.ya[j], c = RA.yc[j];
                const f32x4 g = *((const f32x4*)g2 + F.lane + 64 * j);
                f32x4 y; y[0] = w0 * bf2f(a[0] & 0xffffu) + w1 * bf2f(c[0] & 0xffffu); y[1] = w0 * bf2f(a[0] >> 16) + w1 * bf2f(c[0] >> 16); y[2] = w0 * bf2f(a[1] & 0xffffu) + w1 * bf2f(c[1] & 0xffffu); y[3] = w0 * bf2f(a[1] >> 16) + w1 * bf2f(c[1] >> 16);
                v[j] = v[j] + g * y; }
        }
        if (xout) { GAS v2u* xo = (GAS v2u*)(xout + (size_t)m * D) + F.lane;
#pragma unroll
            for (int j = 0; j < 4; ++j) { v2u o; o[0] = pk2h(v[j][0], v[j][1]); o[1] = pk2h(v[j][2], v[j][3]); __builtin_nontemporal_store(o, xo + 64 * j); } }
        float s = 0.f;
#pragma unroll
        for (int j = 0; j < 4; ++j) s += (v[j][0] * v[j][0] + v[j][1] * v[j][1]) + (v[j][2] * v[j][2] + v[j][3] * v[j][3]);
        const float rstd = rsqrtf(wave_sum(s, F.lane) * (1.f / D) + NORM_EPS);
        if (MODE == 0) {
            const float* sh = shift + (size_t)b * 6144; const float* sc = scale + (size_t)b * 6144;
            GAS v2u* o8 = (GAS v2u*)(hout + (size_t)m * D) + F.lane;
#pragma unroll
            for (int j = 0; j < 4; ++j) { const f32x4 a = *((const f32x4*)sc + F.lane + 64 * j), c = *((const f32x4*)sh + F.lane + 64 * j);
                const f32x4 h = v[j] * rstd * wv[j] * (a + 1.f) + c; v2u o; o[0] = pk2h(h[0], h[1]); o[1] = pk2h(h[2], h[3]); o8[64 * j] = o; }
        } else {
            GAS f32x4* o = (GAS f32x4*)(fout + (size_t)m * D) + F.lane;
#pragma unroll
            for (int j = 0; j < 4; ++j) o[64 * j] = v[j] * rstd * wv[j];
        }
        RA = RN; tA = tB; tB = tN;
    }
}

template <bool IS_MAX> DI float scan128x2(float x, int tid, LAS float* red) {
    const int lane = tid & 63, wave = tid >> 6;
#pragma unroll
    for (int o = 1; o < 64; o <<= 1) { const float y = shup(x, o, lane); if (lane >= o) x = IS_MAX ? fmaxf(x, y) : x + y; }
    if (lane == 63 && wave < 4 && (wave & 1) == 0) red[wave >> 1] = x;
    __syncthreads();
    if (wave < 4 && (wave & 1)) { const float p = red[wave >> 1]; x = IS_MAX ? fmaxf(x, p) : x + p; }
    __syncthreads();
    return x;
}
constexpr int LP = 136;
constexpr int LP64 = 72;
constexpr int TILE128 = 128 * LP * 2;

DI void fscan_unit(Frame& F, int l, int bh) {
    refresh(F);
    LAS float* WT = (LAS float*)F.lds;
    const int b = bh >> 2, h = bh & 3; const float bias = inp(F, I_AFB)[l * 4 + h];
    const float* g = (const float*)(F.ws + WS_GATES) + ((size_t)b * SEQ + 16 * F.tid) * 16 + h;
    float v[16]; float run = 0.f;
#pragma unroll
    for (int i = 0; i < 16; ++i) { run += log_sigmoid_f(g[i * 16] + bias); v[i] = run; }
    float x = run;
#pragma unroll
    for (int o = 1; o < 64; o <<= 1) { const float y = shup(x, o, F.lane); if (F.lane >= o) x += y; }
    if (F.lane == 63) WT[F.wave] = x;
    __syncthreads();
    float pre = 0.f;
    for (int w = 0; w < F.wave; ++w) pre += WT[w];
    const float excl = x - run + pre;
    float* o = (float*)(F.ws + WS_F2) + (size_t)bh * SEQ + 16 * F.tid;
#pragma unroll
    for (int i = 0; i < 16; ++i) o[i] = (v[i] + excl) * LOG2E;
    __syncthreads();
}

DI void qknorm_unit(Frame& F, int u, gu32* qkn) {
    refresh(F);
    const int bh = u >> 4, seg = u & 15, b = bh >> 2, h = bh & 3;
    const bf16* proj = (const bf16*)(F.ws + WS_PROJ);
    float qm = 0.f, km = 0.f;
#pragma unroll
    for (int i = 0; i < 1; ++i) { const size_t row = (size_t)b * SEQ + seg * 512 + F.tid + i; float qs = 0.f, ks = 0.f;
#pragma unroll
        for (int c = 0; c < 8; ++c) { float x[8];
            unpack8(*(const v4u*)(proj + row * PP + O_AQ + h * 64 + 8 * c), x);
#pragma unroll
            for (int e = 0; e < 8; ++e) qs += x[e] * x[e];
            unpack8(*(const v4u*)(proj + row * PP + O_AK + h * 64 + 8 * c), x);
#pragma unroll
            for (int e = 0; e < 8; ++e) ks += x[e] * x[e]; }
        qm = fmaxf(qm, qs); km = fmaxf(km, ks); }
#pragma unroll
    for (int o = 1; o < 64; o <<= 1) { qm = fmaxf(qm, shx(qm, o, F.lane)); km = fmaxf(km, shx(km, o, F.lane)); }
    if (F.lane == 0) { __hip_atomic_fetch_max(qkn + 2 * bh, __float_as_uint(qm), __ATOMIC_RELAXED, __HIP_MEMORY_SCOPE_AGENT); __hip_atomic_fetch_max(qkn + 2 * bh + 1, __float_as_uint(km), __ATOMIC_RELAXED, __HIP_MEMORY_SCOPE_AGENT); }
}

template <bool IS_MAX> DI void wscan2(float& x0, float& x1, int lane) {
    x1 = IS_MAX ? fmaxf(x0, x1) : x0 + x1;
    float s = x1;
#pragma unroll
    for (int o = 1; o < 64; o <<= 1) { const float y = shup(s, o, lane); if (lane >= o) s = IS_MAX ? fmaxf(s, y) : s + y; }
    const float ex = shup(s, 1, lane);
    if (lane > 0) { x0 = IS_MAX ? fmaxf(x0, ex) : x0 + ex; x1 = IS_MAX ? fmaxf(x1, ex) : x1 + ex; }
}
DI void ssd_vectors(Frame& F, int l, int t0, int g, LAS float* DT, LAS float* AC, LAS float* RED) {
    (void)RED;
    if (F.wave < 2) {
        const int r2 = F.wave, head = 2 * g + r2, s0 = 2 * F.lane; const float* gp = (const float*)(F.ws + WS_GATES) + (size_t)(t0 + s0) * 16 + 4 + head;
        const float db = inp(F, I_DTB)[l * 4 + head], na = -__expf(inp(F, I_ALOG)[l * 4 + head]);
        const float d0 = softplus_f(gp[0] + db), d1 = softplus_f(gp[16] + db); float a0 = na * d0, a1 = na * d1;
        wscan2<false>(a0, a1, F.lane);
        DT[r2 * 128 + s0] = d0; DT[r2 * 128 + s0 + 1] = d1; AC[r2 * 128 + s0] = a0; AC[r2 * 128 + s0 + 1] = a1; }
    __syncthreads();
}
DI void ssd_local_unit(Frame& F, int l, int ch, int g) {
    refresh(F);
    LAS bf16* XWT = (LAS bf16*)F.lds; LAS bf16* BT = XWT + 128 * LP; LAS bf16* XD = BT + 128 * LP;
    LAS float* DT = (LAS float*)(F.lds + 3 * TILE128); LAS float* AC = DT + 256; LAS float* RED = AC + 256;
    const int t0 = ch * CHUNK, cpos = ch & (CPB - 1);
    const bf16* proj = (const bf16*)(F.ws + WS_PROJ); bf16* xbcc = (bf16*)(F.ws + WS_XBCC);
    const float* cw = inp(F, I_CONVW) + (size_t)l * 4 * XC; const float* cb = inp(F, I_CONVB) + (size_t)l * XC;
    const int s = F.tid >> 2, cg = F.tid & 3;
    float okm[4]; int spc[4];
#pragma unroll
    for (int j = 0; j < 4; ++j) { const int sp = s - 3 + j; const bool ok = cpos * CHUNK + sp >= 0; okm[j] = ok ? 1.f : 0.f; spc[j] = ok ? sp : s; }
    auto load_part = [&](const int part, v4u (&raw)[4][4]) {
#pragma unroll
        for (int cc = 0; cc < 4; ++cc)
#pragma unroll
            for (int j = 0; j < 4; ++j) raw[cc][j] = *(const v4u*)(proj + (size_t)(t0 + spc[j]) * PP + O_XBC + part * 256 + g * 128 + cg * 32 + cc * 8); };
    auto do_part = [&](const int part, const v4u (&raw)[4][4]) {
#pragma unroll
        for (int cc = 0; cc < 4; ++cc) {
            const int lc = cg * 32 + cc * 8, c0 = part * 256 + g * 128 + lc;
            float acc[8];
            { const f32x4 b0 = *(const f32x4*)(cb + c0), b1 = *(const f32x4*)(cb + c0 + 4);
#pragma unroll
              for (int e = 0; e < 4; ++e) { acc[e] = b0[e]; acc[4 + e] = b1[e]; } }
#pragma unroll
            for (int j = 0; j < 4; ++j) { float x[8]; unpack8(raw[cc][j], x);
                const f32x4 w0 = *(const f32x4*)(cw + j * XC + c0), w1 = *(const f32x4*)(cw + j * XC + c0 + 4);
#pragma unroll
                for (int e = 0; e < 4; ++e) { acc[e] += w0[e] * okm[j] * x[e]; acc[4 + e] += w1[e] * okm[j] * x[4 + e]; } }
#pragma unroll
            for (int e = 0; e < 8; ++e) acc[e] = silu_f(acc[e]);
            v4u o; o.x = pk2h(acc[0], acc[1]); o.y = pk2h(acc[2], acc[3]); o.z = pk2h(acc[4], acc[5]); o.w = pk2h(acc[6], acc[7]);
            *(v4u*)(xbcc + (size_t)(t0 + s) * XC + c0) = o;
            if (part == 0) { const int r2 = lc >> 6; const float dtv = DT[r2 * 128 + s], sc = dtv * __expf(AC[r2 * 128 + 127] - AC[r2 * 128 + s]);
#pragma unroll
                for (int e = 0; e < 8; ++e) { XWT[(lc + e) * LP + s] = (bf16)f2bf(acc[e] * sc); XD[(lc + e) * LP + s] = (bf16)f2bf(acc[e] * dtv); } }
            else if (part == 1) {
#pragma unroll
                for (int e = 0; e < 8; ++e) BT[(lc + e) * LP + s] = (bf16)f2bf(acc[e]); }
        } };
    v4u ra[4][4], rb[4][4];
    load_part(1, ra);
    ssd_vectors(F, l, t0, g, DT, AC, RED);
    load_part(2, rb);
    do_part(1, ra);
    load_part(0, ra);
    do_part(2, rb);
    do_part(0, ra);
    __syncthreads();
    const int w = F.wave, r = F.lane & 15, q = F.lane >> 4;
    f32x4 acc[8];
#pragma unroll
    for (int nt = 0; nt < 8; ++nt) acc[nt] = (f32x4){0.f, 0.f, 0.f, 0.f};
#pragma unroll
    for (int ks = 0; ks < 4; ++ks) { const bf16x8 a = *(const LAS bf16x8*)(XWT + (16 * w + r) * LP + 32 * ks + 8 * q);
#pragma unroll
        for (int nt = 0; nt < 8; ++nt) { const bf16x8 b = *(const LAS bf16x8*)(BT + (16 * nt + r) * LP + 32 * ks + 8 * q); acc[nt] = mfma16(a, b, acc[nt]); } }
    float* sst = (float*)(F.ws + WS_SST);
#pragma unroll
    for (int jj = 0; jj < 4; ++jj) { const int row = 16 * w + 4 * q + jj, head = 2 * g + (row >> 6), p = row & 63;
        float* o = sst + ((size_t)(ch * 4 + head) * 64 + p) * 128 + r;
#pragma unroll
        for (int nt = 0; nt < 8; ++nt) o[16 * nt] = acc[nt][jj]; }
    if (F.tid < 2) ((float*)(F.ws + WS_SMALL))[ch * 4 + 2 * g + F.tid] = __expf(AC[F.tid * 128 + 127]);
    tile_l2g((bf16*)(F.ws + WS_XDT) + (size_t)(ch * 2 + g) * 128 * 128, 128, XD, LP, 128, 128, F.tid);
    __syncthreads();
}
DI void ssd_out_unit(Frame& F, int l, int ch, int g) {
    refresh(F);
    LAS bf16* CL = (LAS bf16*)F.lds; LAS bf16* BL = CL + 128 * LP; LAS bf16* GL = BL + 128 * LP;
    LAS float* DT = (LAS float*)(F.lds + 3 * TILE128); LAS float* AC = DT + 256; LAS float* RED = AC + 256;
    const int t0 = ch * CHUNK;
    const bf16* xbcc = (const bf16*)(F.ws + WS_XBCC); const bf16* proj = (const bf16*)(F.ws + WS_PROJ);
    tile_g2l(CL, LP, xbcc + (size_t)t0 * XC + 512 + g * 128, XC, 128, 128, F.tid);
    tile_g2l(BL, LP, xbcc + (size_t)t0 * XC + 256 + g * 128, XC, 128, 128, F.tid);
    ssd_vectors(F, l, t0, g, DT, AC, RED);
    __syncthreads();
    const int w = F.wave, r = F.lane & 15, q = F.lane >> 4, wlim = w | 1, t_own = 16 * w + r;
    const float* gain = inp(F, I_MIXG) + (size_t)l * 1024 + 512;
    const bf16* hin = (const bf16*)(F.ws + WS_SHIN); const bf16* xdt = (const bf16*)(F.ws + WS_XDT) + (size_t)(ch * 2 + g) * 128 * 128;
    v2u po[2][4][2];
#pragma unroll
    for (int r2 = 0; r2 < 2; ++r2) {
        const int head = 2 * g + r2; const LAS float* ac = AC + r2 * 128;
        bf16x8 hb[4][4];
#pragma unroll
        for (int ks = 0; ks < 4; ++ks)
#pragma unroll
            for (int pt = 0; pt < 4; ++pt) hb[ks][pt] = *(const bf16x8*)(hin + ((size_t)(ch * 4 + head) * 64 + 16 * pt + r) * 128 + 32 * ks + 8 * q);
        { const float at = ac[t_own];
          for (int st = 0; st <= wlim; ++st) { f32x4 c = (f32x4){0.f, 0.f, 0.f, 0.f};
#pragma unroll
              for (int ks = 0; ks < 4; ++ks) { const bf16x8 a = *(const LAS bf16x8*)(BL + (16 * st + r) * LP + 32 * ks + 8 * q), b = *(const LAS bf16x8*)(CL + (16 * w + r) * LP + 32 * ks + 8 * q); c = mfma16(a, b, c); }
              float gv[4];
#pragma unroll
              for (int jj = 0; jj < 4; ++jj) { const int s = 16 * st + 4 * q + jj; gv[jj] = (s <= t_own) ? c[jj] * __expf(at - ac[s]) : 0.f; }
              v2u o; o[0] = pk2h(gv[0], gv[1]); o[1] = pk2h(gv[2], gv[3]);
              *(LAS v2u*)(GL + t_own * LP + 16 * st + 4 * q) = o; } }
        f32x4 acc[4], accb[4];
#pragma unroll
        for (int pt = 0; pt < 4; ++pt) { acc[pt] = (f32x4){0.f, 0.f, 0.f, 0.f}; accb[pt] = (f32x4){0.f, 0.f, 0.f, 0.f}; }
        for (int ks = 0; ks <= (w >> 1); ++ks) { const bf16x8 a = *(const LAS bf16x8*)(GL + (16 * w + r) * LP + 32 * ks + 8 * q);
            bf16x8 xb[4];
#pragma unroll
            for (int pt = 0; pt < 4; ++pt) xb[pt] = *(const bf16x8*)(xdt + (size_t)(64 * r2 + 16 * pt + r) * 128 + 32 * ks + 8 * q);
            GL_PIN4(xb[0], xb[1], xb[2], xb[3]);
#pragma unroll
            for (int pt = 0; pt < 4; ++pt) acc[pt] = mfma16(a, xb[pt], acc[pt]); }
#pragma unroll
        for (int ks = 0; ks < 4; ++ks) GL_PIN4(hb[ks][0], hb[ks][1], hb[ks][2], hb[ks][3]);
#pragma unroll
        for (int ks = 0; ks < 4; ++ks) { const bf16x8 a = *(const LAS bf16x8*)(CL + (16 * w + r) * LP + 32 * ks + 8 * q);
#pragma unroll
            for (int pt = 0; pt < 4; ++pt) accb[pt] = mfma16(a, hb[ks][pt], accb[pt]); }
        const float dsk = inp(F, I_DSKIP)[l * 4 + head];
        float ss[4] = {0.f, 0.f, 0.f, 0.f};
#pragma unroll
        for (int pt = 0; pt < 4; ++pt)
#pragma unroll
            for (int jj = 0; jj < 4; ++jj) { const int t = 16 * w + 4 * q + jj, p = 16 * pt + r;
                const float xs = bf2f(xbcc[(size_t)(t0 + t) * XC + g * 128 + r2 * 64 + p]), z = bf2f(proj[(size_t)(t0 + t) * PP + O_MZ + head * 64 + p]);
                float y = acc[pt][jj] + __expf(ac[t]) * accb[pt][jj] + dsk * xs; y *= silu_f(z); acc[pt][jj] = y; ss[jj] += y * y; }
#pragma unroll
        for (int jj = 0; jj < 4; ++jj) { float v = ss[jj]; v += shx(v, 1, F.lane); v += shx(v, 2, F.lane); v += shx(v, 4, F.lane); v += shx(v, 8, F.lane); ss[jj] = rsqrtf(v * (1.f / 64.f) + NORM_EPS); }
#pragma unroll
        for (int pt = 0; pt < 4; ++pt) { const float gn = gain[head * 64 + 16 * pt + r];
            po[r2][pt][0][0] = pk2h(acc[pt][0] * ss[0] * gn, acc[pt][1] * ss[1] * gn); po[r2][pt][0][1] = 0u;
            po[r2][pt][1][0] = pk2h(acc[pt][2] * ss[2] * gn, acc[pt][3] * ss[3] * gn); po[r2][pt][1][1] = 0u; }
    }
    LAS bf16* OUT = CL;
#pragma unroll
    for (int r2 = 0; r2 < 2; ++r2)
#pragma unroll
        for (int pt = 0; pt < 4; ++pt)
#pragma unroll
            for (int jp = 0; jp < 2; ++jp) { const unsigned pr = po[r2][pt][jp][0]; const int t = 16 * w + 4 * q + 2 * jp, c = r2 * 64 + 16 * pt + r;
                OUT[t * LP + c] = (bf16)(pr & 0xffffu); OUT[(t + 1) * LP + c] = (bf16)(pr >> 16); }
    __syncthreads();
    tile_l2g((bf16*)(F.ws + WS_Y) + (size_t)t0 * 1024 + 512 + g * 128, 1024, OUT, LP, 128, 128, F.tid);
    __syncthreads();
}
#ifdef DIAG_ML_ALT
#define ML_ALT(l) ((size_t)((l) & 1))
#else
#define ML_ALT(l) ((size_t)0)
#endif

DI void p_scans(Frame& F) {
    const int gid = F.bx * (NWAVES * 64) + F.tid, NT_ = F.G * NWAVES * 64;
    const float* sst = (const float*)(F.ws + WS_SST); bf16* hin = (bf16*)(F.ws + WS_SHIN); const float* dec = (const float*)(F.ws + WS_SMALL);
    for (int e = gid; e < 16 * 8192; e += NT_) {
        const int bh = e >> 13, idx = e & 8191, b = bh >> 2, head = bh & 3;
        float hst = 0.f;
        for (int cb = 0; cb < CPB; cb += 32) { float xs[32], ds[32];
#pragma unroll
            for (int i = 0; i < 32; ++i) { const size_t u = (size_t)((b * CPB + cb + i) * 4 + head); xs[i] = __builtin_nontemporal_load(sst + u * 8192 + idx); ds[i] = dec[u]; }
#pragma unroll
            for (int i = 0; i < 32; ++i) { const size_t u = (size_t)((b * CPB + cb + i) * 4 + head); hin[u * 8192 + idx] = (bf16)f2bf(hst); hst = ds[i] * hst + xs[i]; } }
    }
    const float* mls = (const float*)(F.ws + WS_MLS + ML_ALT(F.l) * (406 * MiB)); bf16* mlc = (bf16*)(F.ws + WS_MLC + ML_ALT(F.l) * (406 * MiB));
    const float* mlm = (const float*)(F.ws + WS_SMALL + 64 * 1024 + ML_ALT(F.l) * 16384); float* mlmin = (float*)(F.ws + WS_SMALL + 128 * 1024 + ML_ALT(F.l) * 16384);
    const int slot = (F.wave == 0) ? 0 : (F.wave == 4) ? 1 : (F.wave == 1) ? 2 : (F.wave == 5) ? 3 : -1;
    if (slot >= 0)
    for (int wt = slot * F.G + F.bx; wt < 520; wt += 4 * F.G) {
        const int e = wt * 64 + F.lane;
        const int bh = e / 2080, idx = 2 * (e % 2080), b = bh >> 2, head = bh & 3;
        float c0 = 0.f, c1 = 0.f, m = -1e30f;
        typedef float f32x2n __attribute__((ext_vector_type(2)));
        for (int cb = 0; cb < CPB; cb += 16) { f32x2n sv[16]; float ml[16], ae[16];
#pragma unroll
            for (int i = 0; i < 16; ++i) { const size_t u = (size_t)((b * CPB + cb + i) * 4 + head); ml[i] = mlm[2 * u]; ae[i] = mlm[2 * u + 1]; sv[i] = __builtin_nontemporal_load((const f32x2n*)(mls + u * 5120 + idx)); }
#pragma unroll
            for (int i = 0; i < 16; ++i) { const size_t u = (size_t)((b * CPB + cb + i) * 4 + head);
                __hip_atomic_store((unsigned*)(mlc + u * 5120 + idx), pk2h(c0, c1), __ATOMIC_RELAXED, __HIP_MEMORY_SCOPE_AGENT); if (idx == 0) mlmin[u] = m;
                const float mnew = fmaxf(ae[i] + m, ml[i]); const float fa = __expf(ae[i] + m - mnew), fb = __expf(ml[i] - mnew);
                c0 = fa * c0 + fb * sv[i].x; c1 = fa * c1 + fb * sv[i].y; m = mnew; } }
    }
}

struct SgPre { v4u u[2], v0, v1; };
DI void sg_load(Frame& F, int ch, int h, SgPre& P) {
    const bf16* proj = (const bf16*)(F.ws + WS_PROJ); const size_t t0 = (size_t)ch * CHUNK;
#pragma unroll
    for (int j = 0; j < 2; ++j) { const int i = F.tid + 512 * j, r = i >> 3, c = (i & 7) * 8; P.u[j] = *(const v4u*)(proj + (t0 + r) * PP + O_SU + h * 64 + c); }
    { const int s = F.tid >> 2, cg = F.tid & 3; const bf16* vp = proj + (t0 + s) * PP + O_SV + h * 64 + cg * 16; P.v0 = *(const v4u*)vp; P.v1 = *(const v4u*)(vp + 8); }
}
DI void sg_unit(Frame& F, int l, int ch, int h, const SgPre& P) {
    refresh(F);
    LAS bf16* WL = (LAS bf16*)F.lds;
    LAS bf16* VT = WL + 128 * LP;
    LAS bf16* UL = VT + 64 * LP;
    const int t0 = ch * CHUNK; const bf16* proj = (const bf16*)(F.ws + WS_PROJ);
#pragma unroll
    for (int j = 0; j < 2; ++j) { const int i = F.tid + 512 * j, r = i >> 3, c = (i & 7) * 8; *(LAS v4u*)(UL + r * LP64 + c) = P.u[j]; }
    { const int s = F.tid >> 2, cg = F.tid & 3; (void)proj;
      const v4u r0 = P.v0, r1 = P.v1; float x[16];
      { float a[8]; unpack8(r0, a);
#pragma unroll
        for (int e = 0; e < 8; ++e) x[e] = gelu_tanh_f(a[e]); unpack8(r1, a);
#pragma unroll
        for (int e = 0; e < 8; ++e) x[8 + e] = gelu_tanh_f(a[e]); }
      float ss = 0.f;
#pragma unroll
      for (int e = 0; e < 16; ++e) ss += x[e] * x[e];
      ss += shx(ss, 1, F.lane); ss += shx(ss, 2, F.lane);
      const float rs = rsqrtf(ss * (1.f / 64.f) + NORM_EPS); const float* gn = inp(F, I_MIXG) + (size_t)l * 1024 + 256 + h * 64 + cg * 16;
#pragma unroll
      for (int e = 0; e < 16; ++e) VT[(cg * 16 + e) * LP + s] = (bf16)f2bf(x[e] * rs * gn[e]); }
    { const float* wsrc = inp(F, I_SGW) + ((size_t)(l * 4 + h)) * 128 * 128;
#pragma unroll
      for (int i = 0; i < 8; ++i) { const int idx = F.tid + 512 * i, t = idx >> 5, s4 = (idx & 31) * 4; const f32x4 wv = *(const f32x4*)(wsrc + t * 128 + s4);
          v2u o; o[0] = pk2h(s4 <= t ? wv[0] : 0.f, s4 + 1 <= t ? wv[1] : 0.f); o[1] = pk2h(s4 + 2 <= t ? wv[2] : 0.f, s4 + 3 <= t ? wv[3] : 0.f);
          *(LAS v2u*)(WL + t * LP + s4) = o; } }
    __syncthreads();
    const int w = F.wave, r = F.lane & 15, q = F.lane >> 4;
    f32x4 acc[4];
#pragma unroll
    for (int dt = 0; dt < 4; ++dt) acc[dt] = (f32x4){0.f, 0.f, 0.f, 0.f};
    for (int ks = 0; ks <= (w >> 1); ++ks) { const bf16x8 a = *(const LAS bf16x8*)(WL + (16 * w + r) * LP + 32 * ks + 8 * q);
#pragma unroll
        for (int dt = 0; dt < 4; ++dt) { const bf16x8 b = *(const LAS bf16x8*)(VT + (16 * dt + r) * LP + 32 * ks + 8 * q); acc[dt] = mfma16(a, b, acc[dt]); } }
    const float* bs = inp(F, I_SGB) + (size_t)(l * 4 + h) * 128;
#pragma unroll
    for (int jj = 0; jj < 4; ++jj) { const int t = 16 * w + 4 * q + jj; const float bt = bs[t];
#pragma unroll
        for (int dt = 0; dt < 4; ++dt) { LAS bf16* p = UL + t * LP64 + 16 * dt + r; const float u = gelu_tanh_f(bf2f(*p)); *p = (bf16)f2bf(u * (acc[dt][jj] + bt)); } }
    __syncthreads();
    tile_l2g((bf16*)(F.ws + WS_Y) + (size_t)t0 * 1024 + 256 + h * 64, 1024, UL, LP64, 128, 64, F.tid);
    __syncthreads();
}

DI void ml_vectors(Frame& F, int l, int t0, int h, LAS float* A, LAS float* IG, LAS float* RED) {
    (void)RED;
    if (F.wave == 0) {
        const int s0 = 2 * F.lane; const float* gp = (const float*)(F.ws + WS_GATES) + (size_t)(t0 + s0) * 16; const float fb = inp(F, I_FB)[l * 4 + h], ib = inp(F, I_IB)[l * 4 + h];
        float a0 = log_sigmoid_f(gp[12 + h] + fb), a1 = log_sigmoid_f(gp[16 + 12 + h] + fb);
        IG[s0] = gp[8 + h] + ib; IG[s0 + 1] = gp[16 + 8 + h] + ib;
        wscan2<false>(a0, a1, F.lane);
        A[s0] = a0; A[s0 + 1] = a1; }
    __syncthreads();
}
struct MlLPre { v4u v0, v1, k0, k1; };
DI void ml_local_load(Frame& F, int ch, int h, MlLPre& P) {
    const bf16* proj = (const bf16*)(F.ws + WS_PROJ); const int s2 = (F.tid >> 3) * 2, c0 = (F.tid & 7) * 8;
    const bf16* vp = proj + ((size_t)ch * CHUNK + s2) * PP + O_LV + h * 64 + c0; const bf16* kp = proj + ((size_t)ch * CHUNK + s2) * PP + O_LK + h * 64 + c0;
    P.v0 = *(const v4u*)vp; P.v1 = *(const v4u*)(vp + PP); P.k0 = *(const v4u*)kp; P.k1 = *(const v4u*)(kp + PP);
}
DI void ml_local_unit(Frame& F, int l, int ch, int h, const MlLPre& P) {
    refresh(F);
    LAS bf16* VWT = (LAS bf16*)F.lds;
    LAS bf16* KT = VWT + 80 * LP;
    LAS float* A = (LAS float*)(F.lds + (80 + 64) * LP * 2); LAS float* IG = A + 128; LAS float* WG = IG + 128; LAS float* RED = WG + 128;
    const int t0 = ch * CHUNK; const bf16* proj = (const bf16*)(F.ws + WS_PROJ);
    const int s2 = (F.tid >> 3) * 2, c0 = (F.tid & 7) * 8; (void)proj;
    const v4u rv0 = P.v0, rv1 = P.v1, rk0 = P.k0, rk1 = P.k1;
    ml_vectors(F, l, t0, h, A, IG, RED);
    const float aend = A[127];
    float gval = -INFINITY;
    if (F.tid < 128) gval = aend - A[F.tid] + IG[F.tid];
    float mx = gval;
#pragma unroll
    for (int o = 1; o < 64; o <<= 1) mx = fmaxf(mx, shx(mx, o, F.lane));
    if (F.lane == 0 && F.wave < 2) RED[2 + F.wave] = mx;
    __syncthreads();
    const float mloc = fmaxf(RED[2], RED[3]);
    if (F.tid < 128) WG[F.tid] = __expf(gval - mloc);
    for (int i = F.tid; i < 15 * 64; i += 512) *(LAS unsigned*)(VWT + (65 + (i >> 6)) * LP + 2 * (i & 63)) = 0u;
    __syncthreads();
    if (F.tid < 64) *(LAS unsigned*)(VWT + 64 * LP + 2 * F.tid) = pk2h(WG[2 * F.tid], WG[2 * F.tid + 1]);
    {
      const float wg0 = WG[s2], wg1 = WG[s2 + 1];
      float x0[8], x1[8];
      unpack8(rv0, x0); unpack8(rv1, x1);
#pragma unroll
      for (int e = 0; e < 8; ++e) *(LAS unsigned*)(VWT + (c0 + e) * LP + s2) = pk2h(x0[e] * wg0, x1[e] * wg1);
      unpack8(rk0, x0); unpack8(rk1, x1);
#pragma unroll
      for (int e = 0; e < 8; ++e) *(LAS unsigned*)(KT + (c0 + e) * LP + s2) = pk2h(x0[e] * 0.125f, x1[e] * 0.125f); }
    __syncthreads();
    const int w = F.wave, r = F.lane & 15, q = F.lane >> 4;
    float* mls = (float*)(F.ws + WS_MLS + ML_ALT(F.l) * (406 * MiB)) + (size_t)(ch * 4 + h) * 5120;
#pragma unroll
    for (int it = 0; it < 3; ++it) { const int mt = (it < 2) ? (w >> 1) : 4, nt = (it < 2) ? 2 * (w & 1) + it : w;
        if (it == 2 && w >= 4) break;
        f32x4 acc = (f32x4){0.f, 0.f, 0.f, 0.f};
#pragma unroll
        for (int ks = 0; ks < 4; ++ks) { const bf16x8 a = *(const LAS bf16x8*)(VWT + (16 * mt + r) * LP + 32 * ks + 8 * q), b = *(const LAS bf16x8*)(KT + (16 * nt + r) * LP + 32 * ks + 8 * q); acc = mfma16(a, b, acc); }
#pragma unroll
#ifdef DIAG_MLS_CONST
        for (int jj = 0; jj < 4; ++jj) mls[(16 * mt + 4 * q + jj) * 64 + 16 * nt + r] = 0.01f * (float)(((16 * mt + 4 * q + jj) * 5 + (16 * nt + r) * 3 + ch) % 17 - 8);
#elif defined(DIAG_MLS_NOWG)
        for (int jj = 0; jj < 4; ++jj) mls[(16 * mt + 4 * q + jj) * 64 + 16 * nt + r] = acc[jj];
#else
        for (int jj = 0; jj < 4; ++jj) mls[(16 * mt + 4 * q + jj) * 64 + 16 * nt + r] = acc[jj];
#endif
    }
    if (F.tid == 0) { float* mlm = (float*)(F.ws + WS_SMALL + 64 * 1024 + ML_ALT(F.l) * 16384) + (size_t)(ch * 4 + h) * 2; mlm[0] = mloc; mlm[1] = aend; }
    __syncthreads();
}
struct MlPre { v4u q[2], k[2], o[2], v[2]; };
DI void ml_out_load(Frame& F, int ch, int h, MlPre& P) {
    const bf16* proj = (const bf16*)(F.ws + WS_PROJ); const size_t t0 = (size_t)ch * CHUNK;
#pragma unroll
    for (int j = 0; j < 2; ++j) { const int i = F.tid + 512 * j, r = i >> 3, c = (i & 7) * 8; const bf16* p = proj + (t0 + r) * PP + h * 64 + c;
        P.q[j] = *(const v4u*)(p + O_LQ); P.k[j] = *(const v4u*)(p + O_LK); P.o[j] = *(const v4u*)(p + O_LO); }
    { const int s = F.tid >> 2, cg = F.tid & 3; const bf16* vp = proj + (t0 + s) * PP + O_LV + h * 64 + cg * 16; P.v[0] = *(const v4u*)vp; P.v[1] = *(const v4u*)(vp + 8); }
}
struct NoHook { DI void operator()() const {} };
template <class Hook = NoHook> DI void ml_out_unit(Frame& F, int l, int ch, int h, const MlPre& P, Hook mid = Hook()) {
    refresh(F);
    LAS bf16* QL = (LAS bf16*)F.lds;
    LAS bf16* KL = QL + 128 * LP64;
    LAS bf16* OL = KL + 128 * LP64;
    LAS bf16* VT = OL + 128 * LP64;
    LAS bf16* WL = VT + 80 * LP;
    LAS float* A = (LAS float*)(F.lds + 3 * 128 * LP64 * 2 + (80 + 128) * LP * 2); LAS float* IG = A + 128; LAS float* E1 = IG + 128; LAS float* INTER = E1 + 128; LAS float* EMT = INTER + 128; LAS float* RED = EMT + 128;
    const int t0 = ch * CHUNK; const bf16* proj = (const bf16*)(F.ws + WS_PROJ);
#pragma unroll
    for (int j = 0; j < 2; ++j) { const int i = F.tid + 512 * j, r = i >> 3, c = (i & 7) * 8;
        *(LAS v4u*)(QL + r * LP64 + c) = P.q[j]; *(LAS v4u*)(KL + r * LP64 + c) = P.k[j]; *(LAS v4u*)(OL + r * LP64 + c) = P.o[j]; }
    { const int s = F.tid >> 2, cg = F.tid & 3;
      const v4u r0 = P.v[0], r1 = P.v[1];
#pragma unroll
      for (int e = 0; e < 4; ++e) { VT[(cg * 16 + 2 * e) * LP + s] = (bf16)(r0[e] & 0xffffu); VT[(cg * 16 + 2 * e + 1) * LP + s] = (bf16)(r0[e] >> 16);
          VT[(cg * 16 + 8 + 2 * e) * LP + s] = (bf16)(r1[e] & 0xffffu); VT[(cg * 16 + 8 + 2 * e + 1) * LP + s] = (bf16)(r1[e] >> 16); } }
    for (int i = F.tid; i < 16 * 128; i += 512) VT[(64 + (i >> 7)) * LP + (i & 127)] = (i < 128) ? (bf16)0x3f80u : (bf16)0;
    mid();
    const bf16* cin = (const bf16*)(F.ws + WS_MLC + ML_ALT(F.l) * (406 * MiB)) + (size_t)(ch * 4 + h) * 5120;
    bf16x8 cb[2][5];
#pragma unroll
    for (int ks = 0; ks < 2; ++ks)
#pragma unroll
        for (int nt = 0; nt < 5; ++nt) { cb[ks][nt] = *(const bf16x8*)(cin + (16 * nt + (F.lane & 15)) * 64 + 32 * ks + 8 * (F.lane >> 4)); if (nt == 4 && (F.lane & 15) != 0) cb[ks][nt] = (bf16x8){0, 0, 0, 0, 0, 0, 0, 0}; }
    ml_vectors(F, l, t0, h, A, IG, RED);
#ifdef DIAG_ML_NOINTER
    const float m_in = -1e30f;
#else
    const float m_in = ((const float*)(F.ws + WS_SMALL + 128 * 1024 + ML_ALT(F.l) * 16384))[ch * 4 + h];
#endif
    if (F.wave == 0) {
        const int s0 = 2 * F.lane; const float av0 = A[s0], av1 = A[s0 + 1]; const float ig0 = IG[s0] - av0, ig1 = IG[s0 + 1] - av1; float c0 = ig0, c1 = ig1;
        wscan2<true>(c0, c1, F.lane);
        const float m0 = fmaxf(c0, m_in), m1 = fmaxf(c1, m_in);
        IG[s0] = ig0; IG[s0 + 1] = ig1;
        E1[s0] = -m0; E1[s0 + 1] = -m1;
        INTER[s0] = __expf(m_in - m0); INTER[s0 + 1] = __expf(m_in - m1); EMT[s0] = __expf(-(av0 + m0)); EMT[s0 + 1] = __expf(-(av1 + m1)); }
    __syncthreads();
    const int w = F.wave, r = F.lane & 15, q = F.lane >> 4, wlim = w | 1, t_own = 16 * w + r;
    { const float e1 = E1[t_own];
#pragma unroll
      for (int st = 0; st < 8; ++st) if (st <= wlim) { f32x4 c = (f32x4){0.f, 0.f, 0.f, 0.f};
#pragma unroll
          for (int ks = 0; ks < 2; ++ks) { const bf16x8 a = *(const LAS bf16x8*)(KL + (16 * st + r) * LP64 + 32 * ks + 8 * q), b = *(const LAS bf16x8*)(QL + (16 * w + r) * LP64 + 32 * ks + 8 * q); c = mfma16(a, b, c); }
          float gv[4];
#pragma unroll
          for (int jj = 0; jj < 4; ++jj) { const int s = 16 * st + 4 * q + jj; gv[jj] = (s <= t_own) ? 0.125f * c[jj] * __expf(e1 + IG[s]) : 0.f; }
          v2u o; o[0] = pk2h(gv[0], gv[1]); o[1] = pk2h(gv[2], gv[3]);
          *(LAS v2u*)(WL + t_own * LP + 16 * st + 4 * q) = o; } }
    __syncthreads();
    f32x4 acc[5], accb[5];
#pragma unroll
    for (int nt = 0; nt < 5; ++nt) { acc[nt] = (f32x4){0.f, 0.f, 0.f, 0.f}; accb[nt] = (f32x4){0.f, 0.f, 0.f, 0.f}; }
    for (int ks = 0; ks <= (w >> 1); ++ks) { const bf16x8 a = *(const LAS bf16x8*)(WL + (16 * w + r) * LP + 32 * ks + 8 * q);
#pragma unroll
        for (int nt = 0; nt < 5; ++nt) { const bf16x8 b = *(const LAS bf16x8*)(VT + (16 * nt + r) * LP + 32 * ks + 8 * q); acc[nt] = mfma16(a, b, acc[nt]); } }
#pragma unroll
    for (int ks = 0; ks < 2; ++ks) { GL_PIN4(cb[ks][0], cb[ks][1], cb[ks][2], cb[ks][3]); GL_PIN(cb[ks][4]); }
#pragma unroll
    for (int ks = 0; ks < 2; ++ks) { const bf16x8 a = *(const LAS bf16x8*)(QL + (16 * w + r) * LP64 + 32 * ks + 8 * q);
#pragma unroll
        for (int nt = 0; nt < 5; ++nt) accb[nt] = mfma16(a, cb[ks][nt], accb[nt]); }
    const float* gain = inp(F, I_MIXG) + (size_t)l * 1024 + 768 + h * 64;
    float hv[4][4]; float ss[4];
#ifdef DIAG_ML_NOACCB
#pragma unroll
    for (int nt = 0; nt < 5; ++nt) accb[nt] = (f32x4){0.f, 0.f, 0.f, 0.f};
#endif
#pragma unroll
    for (int jj = 0; jj < 4; ++jj) { const int t = 16 * w + 4 * q + jj; const float it = INTER[t];
        const float den_l = acc[4][jj] + it * accb[4][jj]; const float den = shidx(den_l, F.lane & 48);
        const float dd = 1.f / fmaxf(fabsf(den), EMT[t]); float s2 = 0.f;
#pragma unroll
        for (int nt = 0; nt < 4; ++nt) { const float v = (acc[nt][jj] + it * accb[nt][jj]) * dd; hv[nt][jj] = v; s2 += v * v; }
        s2 += shx(s2, 1, F.lane); s2 += shx(s2, 2, F.lane); s2 += shx(s2, 4, F.lane); s2 += shx(s2, 8, F.lane);
        ss[jj] = rsqrtf(s2 * (1.f / 64.f) + NORM_EPS); }
#pragma unroll
    for (int nt = 0; nt < 4; ++nt) { const float gn = gain[16 * nt + r];
#pragma unroll
        for (int jj = 0; jj < 4; ++jj) { const int t = 16 * w + 4 * q + jj; const float og = sigmoid_f(bf2f(OL[t * LP64 + 16 * nt + r]));
            KL[t * LP64 + 16 * nt + r] = (bf16)f2bf(og * hv[nt][jj] * ss[jj] * gn); } }
    __syncthreads();
    tile_l2g((bf16*)(F.ws + WS_Y) + (size_t)t0 * 1024 + 768 + h * 64, 1024, KL, LP64, 128, 64, F.tid);
    __syncthreads();
}

DI void p_gates(Frame& F, int blk) {
    const bf16* H = (const bf16*)(F.ws + WS_H); const bf16* WG = (const bf16*)(F.ws + WS_WIN) + (size_t)PP * 1024; float* G = (float*)(F.ws + WS_GATES);
    const int r = F.lane & 15, q = F.lane >> 4;
    const bf16* bp = WG + (size_t)r * 1024 + 8 * q;
    _Pragma("unroll 1") for (int rt = 0; rt < 2; ++rt) { const int row0 = blk * 256 + F.wave * 32 + rt * 16;
        const bf16* ap = H + (size_t)(row0 + r) * 1024 + 8 * q;
        f32x4 acc = (f32x4){0.f, 0.f, 0.f, 0.f};
#pragma unroll
        for (int kb = 0; kb < 2; ++kb) { bf16x8 av[16], bv[16];
#pragma unroll
            for (int i = 0; i < 16; ++i) { av[i] = *(const bf16x8*)(ap + 32 * (16 * kb + i)); bv[i] = *(const bf16x8*)(bp + 32 * (16 * kb + i)); }
#pragma unroll
            for (int i = 0; i < 16; i += 4) { GL_PIN4(av[i], av[i + 1], av[i + 2], av[i + 3]); GL_PIN4(bv[i], bv[i + 1], bv[i + 2], bv[i + 3]); }
#pragma unroll
            for (int i = 0; i < 16; ++i) acc = mfma16(av[i], bv[i], acc); }
#pragma unroll
        for (int jj = 0; jj < 4; ++jj) G[(size_t)(row0 + 4 * q + jj) * 16 + r] = acc[jj]; }
}
DI void p_router(Frame& F, int l) {
    constexpr int WRP = 1032;
    LAS bf16* WRL = (LAS bf16*)F.lds;
    LAS float* LG = (LAS float*)(F.lds + 48 * WRP * 2);
    LAS int* CNT = (LAS int*)(F.lds + 48 * WRP * 2 + 8 * 16 * 48 * 4);
    const bf16* H = (const bf16*)(F.ws + WS_H); const bf16* WR = (const bf16*)(F.ws + WS_WR);
    int* tok_e = (int*)(F.ws + WS_TOK); int* tok_lp = (int*)(F.ws + WS_TOK + 256 * 1024); float* tok_w = (float*)(F.ws + WS_TOK + 512 * 1024);
    int* hist = (int*)(F.ws + WS_SMALL + 192 * 1024);
    const int r = F.lane & 15, q = F.lane >> 4;
    tile_g2l(WRL, WRP, WR, 1024, 48, 1024, F.tid);
    __syncthreads();
    for (int blk = F.bx; blk < T / 128; blk += F.G) {
        if (F.tid < 256) CNT[F.tid] = 0;
        __syncthreads();
        const int row0 = blk * 128 + F.wave * 16;
        f32x4 acc[3];
#pragma unroll
        for (int nt = 0; nt < 3; ++nt) acc[nt] = (f32x4){0.f, 0.f, 0.f, 0.f};
        const bf16* ap = H + (size_t)(row0 + r) * 1024 + 8 * q;
#pragma unroll
        for (int kb = 0; kb < 2; ++kb) { bf16x8 av[16];
#pragma unroll
            for (int i = 0; i < 16; ++i) av[i] = *(const bf16x8*)(ap + 32 * (16 * kb + i));
#pragma unroll
            for (int i = 0; i < 16; i += 4) GL_PIN4(av[i], av[i + 1], av[i + 2], av[i + 3]);
#pragma unroll
            for (int i = 0; i < 16; ++i) { const int ks = 16 * kb + i;
#pragma unroll
                for (int nt = 0; nt < 3; ++nt) { const bf16x8 b = *(const LAS bf16x8*)(WRL + (16 * nt + r) * WRP + 32 * ks + 8 * q); acc[nt] = mfma16(av[i], b, acc[nt]); } } }
        LAS float* lg = LG + F.wave * 16 * 48;
#pragma unroll
        for (int nt = 0; nt < 3; ++nt)
#pragma unroll
            for (int jj = 0; jj < 4; ++jj) lg[(4 * q + jj) * 48 + 16 * nt + r] = acc[nt][jj];
        LDS_WAIT(); asm volatile("" ::: "memory");
        int ex1 = -1, ex2 = -2; float gw1 = 0.f, gw2 = 0.f;
        if (F.lane < 16) {
            const LAS float* x = lg + F.lane * 48; const float* brg = inp(F, I_BRG) + l * 4; const float* bre = inp(F, I_BRE) + l * 32;
            float g0 = x[0] + brg[0], g1 = x[1] + brg[1], g2 = x[2] + brg[2], g3 = x[3] + brg[3];
            int gs = 0; float gm = g0; if (g1 > gm) { gm = g1; gs = 1; } if (g2 > gm) { gm = g2; gs = 2; } if (g3 > gm) { gm = g3; gs = 3; }
            const float gp = 1.f / (__expf(g0 - gm) + __expf(g1 - gm) + __expf(g2 - gm) + __expf(g3 - gm));
            float t1 = -INFINITY, t2 = -INFINITY; int i1 = 0, i2 = 0;
#pragma unroll
            for (int i = 0; i < 8; ++i) { const float v = x[4 + 8 * gs + i] + bre[8 * gs + i];
                if (v > t1) { t2 = t1; i2 = i1; t1 = v; i1 = i; } else if (v > t2) { t2 = v; i2 = i; } }
            const float e2 = __expf(t2 - t1), p1 = 1.f / (1.f + e2), p2 = e2 * p1;
            ex1 = 8 * gs + i1; ex2 = 8 * gs + i2; gw1 = gp * p1; gw2 = gp * p2;
        }
        int pos1 = 0, pos2 = 0;
#pragma unroll
        for (int j = 0; j < 16; ++j) { const int o1 = __builtin_amdgcn_ds_bpermute(j << 2, ex1), o2 = __builtin_amdgcn_ds_bpermute(j << 2, ex2);
            if (j < F.lane) { pos1 += (o1 == ex1) + (o2 == ex1); pos2 += (o1 == ex2) + (o2 == ex2); } }
        LAS int* wcnt = CNT + F.wave * 32;
        if (F.lane < 16) { __hip_atomic_fetch_add(wcnt + ex1, 1, __ATOMIC_RELAXED, __HIP_MEMORY_SCOPE_WORKGROUP); __hip_atomic_fetch_add(wcnt + ex2, 1, __ATOMIC_RELAXED, __HIP_MEMORY_SCOPE_WORKGROUP); }
        __syncthreads();
        if (F.lane < 16) { int b1 = 0, b2 = 0;
            for (int w2 = 0; w2 < F.wave; ++w2) { b1 += CNT[w2 * 32 + ex1]; b2 += CNT[w2 * 32 + ex2]; }
            const int m = row0 + F.lane;
            tok_e[2 * m] = ex1; tok_e[2 * m + 1] = ex2; tok_lp[2 * m] = b1 + pos1; tok_lp[2 * m + 1] = b2 + pos2; tok_w[2 * m] = gw1; tok_w[2 * m + 1] = gw2; }
        if (F.tid < 32) { int c = 0; for (int w2 = 0; w2 < 8; ++w2) c += CNT[w2 * 32 + F.tid]; hist[blk * 32 + F.tid] = c; }
        __syncthreads();
    }
}
DI void p_dispatch(Frame& F) {
    LAS int* PT = (LAS int*)F.lds;
    LAS int* PB = PT + 512;
    LAS int* TS = PB + 512;
    LAS int* BASE = TS + 64;
    LAS int* TOT = BASE + 32;
    const int* hist = (const int*)(F.ws + WS_SMALL + 192 * 1024); int* tstart = (int*)(F.ws + WS_SMALL + 256 * 1024);
    const int* tok_e = (const int*)(F.ws + WS_TOK); const int* tok_lp = (const int*)(F.ws + WS_TOK + 256 * 1024); int* tok_d = (int*)(F.ws + WS_TOK + 768 * 1024);
    int* rowtok = (int*)(F.ws + WS_SMALL + 512 * 1024);
    for (int blk = F.bx; blk < T / 128; blk += F.G) {
        { const int e = F.tid & 31, part = F.tid >> 5; int tot = 0, bs = 0;
          for (int b2 = part * 16; b2 < part * 16 + 16; ++b2) { const int c = hist[b2 * 32 + e]; tot += c; bs += (b2 < blk) ? c : 0; }
          PT[part * 32 + e] = tot; PB[part * 32 + e] = bs; }
        __syncthreads();
        if (F.tid < 32) { int tot = 0, bs = 0;
            for (int p = 0; p < 16; ++p) { tot += PT[p * 32 + F.tid]; bs += PB[p * 32 + F.tid]; }
            PT[F.tid] = (tot + 255) >> 8; BASE[F.tid] = bs; TOT[F.tid] = tot; }
        __syncthreads();
        if (F.tid == 0) { int run = 0; for (int e = 0; e < 32; ++e) { TS[e] = run; run += PT[e]; } TS[32] = run; }
        __syncthreads();
        if (blk == 0 && F.tid < 33) tstart[F.tid] = TS[F.tid];
        const int row0 = blk * 128 + F.wave * 16;
        if (F.lane < 32) { const int m = row0 + (F.lane >> 1), k = F.lane & 1; const int e = tok_e[2 * m + k]; const int d = 256 * TS[e] + BASE[e] + tok_lp[2 * m + k];
            tok_d[2 * m + k] = d; rowtok[d] = m; }
        __syncthreads();
    }
}

struct Args { const float* in[27]; float* out; unsigned char* ws; int ph_lo, ph_hi; };
#ifndef CV_TAILN
#define CV_TAILN 1536
#endif
constexpr int PH_PER_LAYER = 11, PH_TOTAL = 1 + NLAYER * PH_PER_LAYER + 1;

__global__ void __launch_bounds__(NWAVES * 64, 2) mega_fwd(Args args) {
    extern __shared__ __attribute__((aligned(16))) unsigned char lds[];
    Frame F;
    F.lds = (LAS unsigned char*)lds;
    F.MISC = (volatile LAS unsigned*)(F.lds + MISC_OFF);
    F.tid = threadIdx.x; F.lane = F.tid & 63; F.wave = __builtin_amdgcn_readfirstlane(F.tid >> 6);
    F.G = gridDim.x; F.bx = blockIdx.x; { const int bx = F.bx; F.vcu = (F.G % 8 == 0) ? (bx % 8) * (F.G / 8) + bx / 8 : bx; }
    F.out = args.out; F.ws = args.ws; F.ctl = (gu32*)(args.ws + WS_CTL);
    for (int u = F.tid; u < (LDS_BYTES - RING_BYTES) / 4; u += NWAVES * 64) ((LAS unsigned*)(F.lds + RING_BYTES))[u] = 0u;
    __syncthreads();
    if (F.tid < 27) { const unsigned long long p = (unsigned long long)args.in[F.tid]; LAS unsigned* t = (LAS unsigned*)(F.lds + PTRTAB_OFF) + 2 * F.tid; t[0] = (unsigned)p; t[1] = (unsigned)(p >> 32); }
    __syncthreads();
    XcdBarrier bar = xcd_barrier_post((unsigned*)(F.ctl + CW_BAR), F.MISC + 8);
    const int lo = args.ph_lo, hi = args.ph_hi;
    int ph = 0;
#define IN_RANGE() (lo <= ph && ph < hi)
#define FRESH() do { int t_ = threadIdx.x; asm volatile("" : "+v"(t_)); F.tid = t_; F.lane = t_ & 63; F.wave = __builtin_amdgcn_readfirstlane(t_ >> 6); size_t z_ = 0; unsigned zl_ = 0; int bx_ = blockIdx.x, g_ = gridDim.x; asm volatile("" : "+s"(z_), "+s"(zl_), "+s"(bx_), "+s"(g_)); F.z = z_; F.lds = (LAS unsigned char*)lds + zl_; F.ws = args.ws + z_; F.out = args.out + z_; F.ctl = (gu32*)(F.ws + WS_CTL); int ly_ = l; asm volatile("" : "+s"(ly_)); F.l = ly_; F.bx = bx_; F.G = g_; F.vcu = (g_ % 8 == 0) ? (bx_ % 8) * (g_ / 8) + bx_ / 8 : bx_; } while (0)
#ifndef PHMASK
#define PHMASK 0xffffffffu
#endif
#ifndef LRUN
#define LRUN NLAYER
#endif
#ifndef PCUT
#define PCUT 11
#endif
#ifndef DIAG_COMB_MIN
#define DIAG_COMB_MIN 11
#endif
#ifndef DUPMASK
#define DUPMASK 0u
#endif
#define REPS(k) ((((DUPMASK) >> (k)) & 1u) ? 2 : 1)
#ifndef SKIP_MOE0
#define SKIP_MOE0 0
#endif
#define EN(k) ((((PHMASK) >> (k)) & 1u) && ((k) == 0 || (k) >= 12 || l < LRUN - 1 || (k) <= PCUT) && !(SKIP_MOE0 && l == 0 && (k) >= 8 && (k) <= 11))
#define SEAM() do { if (lo <= ph && ph + 1 < hi) { size_t zb_ = 0; asm volatile("" : "+s"(zb_), "+s"(bar.x)); bar.bar = (unsigned*)(args.ws + WS_CTL + zb_) + CW_BAR; xcd_barrier(bar); } ++ph; } while (0)

#define xrun ((bf16*)(F.ws + WS_XRES))
#define mod ((const float*)(F.ws + WS_MOD))
#define H ((bf16*)(F.ws + WS_H))
#define PROJ ((bf16*)(F.ws + WS_PROJ))
#define Y ((bf16*)(F.ws + WS_Y))

    { const int l = 0; (void)l;
    if (IN_RANGE() && EN(0)) for (int rep_ = 0; rep_ < REPS(0); ++rep_) { FRESH(); p_mod(F); p_convert(F, 0, 0, CV_DENSE); } }
    SEAM();

    for (int l = 0; l < LRUN; ++l) {
#define modl (mod + (size_t)F.l * 4 * 6144)
        if (IN_RANGE() && EN(1)) for (int rep_ = 0; rep_ < REPS(1); ++rep_) { FRESH();
            p_norm<0>(F, F.l == 0 ? (const void*)inp(F, I_X) : (const void*)xrun, F.l != 0, (SKIP_MOE0 && F.l == 1) ? -1 : F.l - 1, xrun, inp(F, I_WN1) + (size_t)F.l * 1024, modl, modl + 1024, H, nullptr);
        }
        SEAM();
        if (IN_RANGE() && EN(2)) for (int rep_ = 0; rep_ < REPS(2); ++rep_) { FRESH();
            const int GG = F.G;
#ifndef STAGGER
#define STAGGER 0
#endif
            if (F.bx < GG) {
                for (int d_ = 0; d_ < STAGGER * (F.bx & 7); ++d_) __builtin_amdgcn_s_sleep(28);
#ifndef GATES_TAIL
#define GATES_TAIL 0
#endif
                if (GATES_TAIL) {
                    pg8::Gemm g{H, (const bf16*)(F.ws + WS_WIN), T, PP, D}; pg8::StaticOrder S; S.init(T, PP, GG, F.bx);
                    pg8::EpiProj E{PROJ, (float*)(F.ws + WS_GATES)};
                    pg8::gemm_phase<pg8::EpiProj, pg8::StaticOrder, PG8_ALIGN, PG8_SP2>(F.lds, g, S, E);
                    const int nun_ = (T / 256) * (PP / 256), rem_ = nun_ % GG;
                    const int ntail_ = rem_ ? GG - rem_ : GG, rank_ = rem_ ? F.bx - rem_ : F.bx;
                    if (rank_ >= 0) { __syncthreads(); refresh(F);
                        for (int blk_ = rank_; blk_ < T / 256; blk_ += ntail_) p_gates(F, blk_);
                        if (rem_) p_convert(F, F.l, CV_DENSE, CV_DENSE + CV_TAILN, rank_ * NWAVES + F.wave, ntail_ * NWAVES); }
                } else {
                pg8::Gemm g{H, (const bf16*)(F.ws + WS_WIN), T, NPROJ_T, D}; pg8::StaticOrder S; S.init(T, NPROJ_T, GG, F.bx);
                pg8::EpiProj E{PROJ, (float*)(F.ws + WS_GATES)};
                pg8::gemm_phase<pg8::EpiProj, pg8::StaticOrder, PG8_ALIGN, PG8_SP2>(F.lds, g, S, E);
                }
            } else p_convert(F, F.l, CV_DENSE, CV_ALL, (F.bx - GG) * NWAVES + F.wave, (F.G - GG) * NWAVES);
        }
        SEAM();
        if (IN_RANGE() && EN(3)) for (int rep_ = 0; rep_ < REPS(3); ++rep_) { FRESH();
            for (int ch = F.bx; ch < NCHUNK; ch += F.G) {
                _Pragma("unroll 1") for (int g = 0; g < 2; ++g) ssd_local_unit(F, F.l, ch, g);
                { MlLPre PA_, PB_; ml_local_load(F, ch, 0, PA_);
                  ml_local_load(F, ch, 1, PB_); ml_local_unit(F, F.l, ch, 0, PA_);
                  ml_local_load(F, ch, 2, PA_); ml_local_unit(F, F.l, ch, 1, PB_);
                  ml_local_load(F, ch, 3, PB_); ml_local_unit(F, F.l, ch, 2, PA_);
                  ml_local_unit(F, F.l, ch, 3, PB_); }
            }
            for (int bh = F.bx; bh < 16; bh += F.G) fscan_unit(F, F.l, bh);
            for (int u = F.bx; u < 256; u += F.G) qknorm_unit(F, u, F.ctl + CW_QKN + F.l * 32);
        }
        SEAM();
        if (IN_RANGE() && EN(4)) for (int rep_ = 0; rep_ < REPS(4); ++rep_) { FRESH();
            const bool exp_here = true;
            gu32* cvq = F.ctl + CW_CVQ + 64 * F.l; (void)exp_here;
            (void)cvq;
#ifndef CV_IN_MIX
#define CV_IN_MIX 0
#endif
#ifndef CV_MIXHEAD
#define CV_MIXHEAD 4
#endif
            const bool mixhead_ = CV_MIXHEAD > 0 && (F.G % (8 * CV_MIXHEAD)) == 0;
            const int cv0_ = mixhead_ ? CV_ALL : CV_DENSE + ((GATES_TAIL && (((T / 256) * (PP / 256)) % F.G) != 0) ? CV_TAILN : 0);
            if (F.wave < 4) { p_scans(F); if (!CV_IN_MIX) p_convert(F, F.l, cv0_, CV_ALL); if (!mixhead_ && F.l + 1 < NLAYER) p_convert(F, F.l + 1, 0, CV_WIN); }
            else { if (!CV_IN_MIX) p_convert(F, F.l, cv0_, CV_ALL); if (!mixhead_ && F.l + 1 < NLAYER) p_convert(F, F.l + 1, 0, CV_WIN); p_scans(F); } }
        SEAM();
        if (IN_RANGE() && EN(5)) for (int rep_ = 0; rep_ < REPS(5); ++rep_) { FRESH();
            const attn_body::AttnTensors AT{(const attn_body::bf16*)(PROJ + O_AQ), (const attn_body::bf16*)(PROJ + O_AK), (const attn_body::bf16*)(PROJ + O_AV), (attn_body::bf16*)Y,
                                            (const float*)(F.ws + WS_F2), inp(F, I_MIXG) + (size_t)F.l * 1024, (const unsigned*)(F.ctl + CW_QKN + F.l * 32)};
            LAS int* QS = (LAS int*)(F.lds + RING_BYTES + 640);
#ifndef MLQ_AHEAD
#define MLQ_AHEAD 0
#endif
#ifndef QMODE
#define QMODE 5
#endif
#ifndef PROBE_ATT2
#define PROBE_ATT2 0
#endif
#ifndef PROBE_ML2
#define PROBE_ML2 0
#endif
            if (CV_MIXHEAD > 0 && (F.G % (8 * CV_MIXHEAD)) == 0 && ((F.bx >> 3) % CV_MIXHEAD) == 0) {
                const int rank_ = (F.bx / (8 * CV_MIXHEAD)) * 8 + (F.bx & 7), nconv_ = F.G / CV_MIXHEAD;
                p_convert(F, F.l, CV_DENSE, CV_ALL, rank_ * NWAVES + F.wave, nconv_ * NWAVES);
                if (F.l + 1 < NLAYER) p_convert(F, F.l + 1, 0, CV_WIN, rank_ * NWAVES + F.wave, nconv_ * NWAVES);
                __syncthreads(); refresh(F); }
            constexpr int CVJ = 6; int cvp = CV_IN_MIX ? 0 : CVJ;
#define CV_PIECE() do { if (cvp < CVJ) { __syncthreads(); refresh(F); p_convert_np(F, F.l, CV_DENSE, CV_ALL, (F.vcu * NWAVES + F.wave) * CVJ + cvp, F.G * NWAVES * CVJ); ++cvp; __syncthreads(); } } while (0)
            for (int pa_ = 0; pa_ <= PROBE_ATT2; ++pa_) for (;;) {
                if (F.tid == 0) QS[0] = (int)__hip_atomic_fetch_add(F.ctl + CW_Q + 64 * F.l + 4 * pa_, 1u, __ATOMIC_RELAXED, __HIP_MEMORY_SCOPE_AGENT);
                __syncthreads();
                const int idx = __builtin_amdgcn_readfirstlane(QS[0]);
                __syncthreads();
                if (idx >= ((QMODE >= 2) ? 512 : 512 + 2560)) break;
                if (idx < 512) { const attn_body::AttnUnit u{(idx & 3) * 4 + 3 - ((idx >> 2) & 3), 31 - (idx >> 4)};
                    attn_body::attn_unit<8>(u.bh / 4, u.bh % 4, u.qb, AT.Q, AT.K, AT.V, AT.O, AT.F2, AT.gain, 2.0f * sqrtf(__uint_as_float(AT.qkn[2 * u.bh]) * __uint_as_float(AT.qkn[2 * u.bh + 1])), (char*)lds); }
                else { const int j = idx - 512;
                    if (j < 1024) { SgPre P_; sg_load(F, j >> 2, j & 3, P_); sg_unit(F, F.l, j >> 2, j & 3, P_); }
                    else if (j < 1536) ssd_out_unit(F, F.l, (j - 1024) >> 1, (j - 1024) & 1);
                    else { MlPre P_; ml_out_load(F, (j - 1536) >> 2, (j - 1536) & 3, P_); ml_out_unit(F, F.l, (j - 1536) >> 2, (j - 1536) & 3, P_); } }
#ifndef CV_NO_ATT_SITE
                CV_PIECE();
#endif
            }
            if (QMODE == 6) {
                _Pragma("unroll 1") for (int ty = 0; ty < 3; ++ty) {
                    for (;;) {
                        if (F.tid == 0) QS[0] = (int)__hip_atomic_fetch_add(F.ctl + CW_Q + 64 * F.l + 8 + 8 * ty, 1u, __ATOMIC_RELAXED, __HIP_MEMORY_SCOPE_AGENT);
                        __syncthreads();
                        const int j = __builtin_amdgcn_readfirstlane(QS[0]);
                        __syncthreads();
                        if (j >= (ty == 1 ? 512 : 1024)) break;
                        if (ty == 0) { SgPre P_; sg_load(F, j >> 2, j & 3, P_); sg_unit(F, F.l, j >> 2, j & 3, P_); } else if (ty == 1) ssd_out_unit(F, F.l, j >> 1, j & 1); else { MlPre P_; ml_out_load(F, j >> 2, j & 3, P_); ml_out_unit(F, F.l, j >> 2, j & 3, P_); }
                    } }
            } else if (QMODE == 7 && (F.G & 7) == 0) {
                for (;;) {
                    if (F.tid == 0) QS[0] = (int)__hip_atomic_fetch_add(F.ctl + CW_Q + 64 * F.l + 32, 1u, __ATOMIC_RELAXED, __HIP_MEMORY_SCOPE_AGENT);
                    __syncthreads();
                    const int j = __builtin_amdgcn_readfirstlane(QS[0]);
                    __syncthreads();
                    if (j >= 1024) break;
                    { MlPre P_; ml_out_load(F, j >> 2, j & 3, P_); ml_out_unit(F, F.l, j >> 2, j & 3, P_); }
                }
                for (;;) {
                    if (F.tid == 0) QS[0] = (int)__hip_atomic_fetch_add(F.ctl + CW_QX + (F.l * 8 + (F.bx & 7)) * 64, 1u, __ATOMIC_RELAXED, __HIP_MEMORY_SCOPE_AGENT);
                    __syncthreads();
                    const int j = __builtin_amdgcn_readfirstlane(QS[0]);
                    __syncthreads();
                    if (j >= 6 * (NCHUNK / 8)) break;
                    const int ch = (F.bx & 7) + 8 * (j / 6), sub = j % 6;
                    if (sub < 4) { SgPre P_; sg_load(F, ch, sub, P_); sg_unit(F, F.l, ch, sub, P_); } else ssd_out_unit(F, F.l, ch, sub - 4);
                }
            } else if (QMODE == 5 && MLQ_AHEAD) {
                gu32* qc_ = F.ctl + CW_Q + 64 * F.l + 32;
                if (F.tid == 0) { QS[0] = (int)__hip_atomic_fetch_add(qc_, 1u, __ATOMIC_RELAXED, __HIP_MEMORY_SCOPE_AGENT); QS[1] = (int)__hip_atomic_fetch_add(qc_, 1u, __ATOMIC_RELAXED, __HIP_MEMORY_SCOPE_AGENT); }
                __syncthreads();
                int j = __builtin_amdgcn_readfirstlane(QS[0]), jn = __builtin_amdgcn_readfirstlane(QS[1]);
                __syncthreads();
                MlPre PA_; if (j < 1024) ml_out_load(F, j >> 2, j & 3, PA_);
                _Pragma("unroll 1") while (j < 1024) {
                    unsigned nx_ = 0u; if (F.tid == 0) nx_ = __hip_atomic_fetch_add(qc_, 1u, __ATOMIC_RELAXED, __HIP_MEMORY_SCOPE_AGENT);
                    MlPre PB_; const int jl = jn < 1024 ? jn : j;
                    ml_out_unit(F, F.l, j >> 2, j & 3, PA_, [&]() { ml_out_load(F, jl >> 2, jl & 3, PB_); });
                    if (F.tid == 0) QS[0] = (int)nx_;
                    __syncthreads();
                    const int jnn = __builtin_amdgcn_readfirstlane(QS[0]);
                    __syncthreads();
                    j = jn; jn = jnn; PA_ = PB_;
                }
                for (int ch = F.bx; ch < NCHUNK; ch += F.G) {
                    { SgPre PA2_, PB2_; sg_load(F, ch, 0, PA2_);
                        sg_load(F, ch, 1, PB2_); sg_unit(F, F.l, ch, 0, PA2_);
                        sg_load(F, ch, 2, PA2_); sg_unit(F, F.l, ch, 1, PB2_);
                        sg_load(F, ch, 3, PB2_); sg_unit(F, F.l, ch, 2, PA2_);
                        sg_unit(F, F.l, ch, 3, PB2_); }
                    _Pragma("unroll 1") for (int g = 0; g < 2; ++g) ssd_out_unit(F, F.l, ch, g); }
            } else if (QMODE >= 3) {
                for (;;) {
                    if (F.tid == 0) QS[0] = (int)__hip_atomic_fetch_add(F.ctl + CW_Q + 64 * F.l + 32, 1u, __ATOMIC_RELAXED, __HIP_MEMORY_SCOPE_AGENT);
                    __syncthreads();
                    const int j = __builtin_amdgcn_readfirstlane(QS[0]);
                    __syncthreads();
                    if (j >= (QMODE == 4 ? 512 : 1024)) break;
                    if (QMODE == 3) { SgPre P_; sg_load(F, j >> 2, j & 3, P_); sg_unit(F, F.l, j >> 2, j & 3, P_); } else if (QMODE == 4) ssd_out_unit(F, F.l, j >> 1, j & 1); else { MlPre P_; ml_out_load(F, j >> 2, j & 3, P_); ml_out_unit(F, F.l, j >> 2, j & 3, P_); }
                    CV_PIECE();
                }
                _Pragma("unroll 1") while (cvp < CVJ) CV_PIECE();
                for (int ch = F.bx; ch < NCHUNK; ch += F.G) {
                    if (QMODE != 3) { SgPre PA_, PB_; sg_load(F, ch, 0, PA_);
                        sg_load(F, ch, 1, PB_); sg_unit(F, F.l, ch, 0, PA_);
                        sg_load(F, ch, 2, PA_); sg_unit(F, F.l, ch, 1, PB_);
                        sg_load(F, ch, 3, PB_); sg_unit(F, F.l, ch, 2, PA_);
                        sg_unit(F, F.l, ch, 3, PB_); }
                    if (QMODE != 4) { _Pragma("unroll 1") for (int g = 0; g < 2; ++g) ssd_out_unit(F, F.l, ch, g); }
                    if (QMODE != 5) { _Pragma("unroll 1") for (int h = 0; h < 4; ++h) { MlPre P_; ml_out_load(F, ch, h, P_); ml_out_unit(F, F.l, ch, h, P_); } } }
            }
            if (QMODE == 2) for (int ch = F.bx; ch < NCHUNK; ch += F.G) {
                _Pragma("unroll 1") for (int h = 0; h < 4; ++h) { SgPre P_; sg_load(F, ch, h, P_); sg_unit(F, F.l, ch, h, P_); }
                _Pragma("unroll 1") for (int g = 0; g < 2; ++g) ssd_out_unit(F, F.l, ch, g);
                _Pragma("unroll 1") for (int h = 0; h < 4; ++h) { MlPre P_; ml_out_load(F, ch, h, P_); ml_out_unit(F, F.l, ch, h, P_); } }
        }
        SEAM();
        if (IN_RANGE() && EN(6)) for (int rep_ = 0; rep_ < REPS(6); ++rep_) { FRESH();
            pg8::Gemm g{Y, (const bf16*)(F.ws + WS_WOUT), T, D, D}; pg8::StaticOrder S; S.init(T, D, F.G, F.bx);
#ifndef FUSE_NORM2
#define FUSE_NORM2 0
#endif
            if (FUSE_NORM2 && F.G == 256) {
                pg8::EpiOutNorm E{(float*)xrun, modl + 2 * 1024, inp(F, I_WN2) + (size_t)F.l * 1024, modl + 3 * 1024, modl + 4 * 1024, H, (float*)(F.ws + WS_SLOT) + (size_t)F.l * T * 4,
                                  (unsigned*)(F.ctl + CW_PAN + F.l * 128 * 64), (unsigned*)(F.ctl + CW_TMO)};
                { pg8::OneRound S0{S, 0}; pg8::gemm_phase<pg8::EpiOutNorm, pg8::OneRound, false, PG8_SP2>(F.lds, g, S0, E); }
                __syncthreads();
                { pg8::OneRound S1{S, 1}; pg8::gemm_phase<pg8::EpiOutNorm, pg8::OneRound, false, PG8_SP2>(F.lds, g, S1, E); }
            } else {
            pg8::EpiOut E{xrun, modl + 2 * 1024};
            pg8::gemm_phase<pg8::EpiOut, pg8::StaticOrder, PG8_ALIGN, PG8_SP2>(F.lds, g, S, E);
            }
        }
        SEAM();
        if (IN_RANGE() && EN(7)) for (int rep_ = 0; rep_ < REPS(7); ++rep_) { FRESH();
            if (!(FUSE_NORM2 && F.G == 256)) p_norm<0>(F, xrun, true, -1, nullptr, inp(F, I_WN2) + (size_t)F.l * 1024, modl + 3 * 1024, modl + 4 * 1024, H, nullptr);
        }
        SEAM();
        if (IN_RANGE() && EN(8)) for (int rep_ = 0; rep_ < REPS(8); ++rep_) { FRESH(); p_router(F, F.l); }
        SEAM();
        if (IN_RANGE() && EN(9)) for (int rep_ = 0; rep_ < REPS(9); ++rep_) { FRESH(); p_dispatch(F); }
        SEAM();
        if (IN_RANGE() && EN(10)) for (int rep_ = 0; rep_ < REPS(10); ++rep_) { FRESH();
            LAS int* TS = (LAS int*)(F.lds + RING_BYTES + 1024);
            if (F.tid < 33) TS[F.tid] = ((const int*)(F.ws + WS_SMALL + 256 * 1024))[F.tid];
            __syncthreads();
            if (F.tid == 0) { int run = 0; for (int s_ = 0; s_ < 4; ++s_) { const int e_ = (F.bx & 7) + 8 * s_; TS[40 + s_] = run; TS[48 + s_] = TS[e_]; run += 4 * (TS[e_ + 1] - TS[e_]); } TS[44] = run;
                int gm_ = 0; for (int x_ = 0; x_ < 8; ++x_) { int u_ = 0; for (int s_ = 0; s_ < 4; ++s_) u_ += 4 * (TS[x_ + 8 * s_ + 1] - TS[x_ + 8 * s_]); const int r_ = (u_ + (F.G >> 3) - 1) / (F.G >> 3); gm_ = r_ > gm_ ? r_ : gm_; } TS[45] = gm_; }
            __syncthreads();
            pg8::Gemm g{H, (const bf16*)(F.ws + WS_WGU + (size_t)(F.l & 1) * EXP_ALT), MOE_ROWS, NEXP * 1024, D};
            pg8::MoeOrder S{F.G, F.bx, TS + 40};
            LAS int* RT = (LAS int*)(F.lds + RING_BYTES + 4096);
            { pg8::Unit u_; const int* rowtok = (const int*)(F.ws + WS_SMALL + 512 * 1024);
              const int nxu_ = __builtin_amdgcn_readfirstlane(TS[44]), lcu_ = F.bx >> 3, peru_ = F.G >> 3; int nu_ = nxu_ > lcu_ ? (nxu_ - lcu_ + peru_ - 1) / peru_ : 0; nu_ = nu_ > 12 ? 12 : nu_;
              _Pragma("unroll 1") for (int i_ = 0; i_ < nu_; ++i_) { (void)S.next(i_, u_); const int pm_ = __builtin_amdgcn_readfirstlane(u_.pm);
                  if (F.tid < 256) { const unsigned tk = (unsigned)rowtok[pm_ * 256 + F.tid]; RT[i_ * 256 + F.tid] = (int)(tk < (unsigned)T ? tk : (unsigned)(T - 1)); } } }
            __syncthreads();
            pg8::EpiGU E{(bf16*)(F.ws + WS_ACT)};
            pg8::gemm_phase<pg8::EpiGU, pg8::MoeOrder, PG8_ALIGN, PG8_SP2, true>(F.lds, g, S, E, RT);
            if (F.l + 1 < NLAYER) { p_convert(F, F.l + 1, CV_WIN, CV_DENSE);
                const int nx_ = __builtin_amdgcn_readfirstlane(TS[44]), lc_ = F.bx >> 3, per_ = F.G >> 3, myunits = nx_ > lc_ ? (nx_ - lc_ + per_ - 1) / per_ : 0;
                const int idle_ = __builtin_amdgcn_readfirstlane(TS[45]) - myunits;
                (void)idle_; }
        }
        SEAM();
        if (IN_RANGE() && EN(11)) for (int rep_ = 0; rep_ < REPS(11); ++rep_) { FRESH();
            LAS int* TS = (LAS int*)(F.lds + RING_BYTES + 1024);
            if (F.tid < 33) TS[F.tid] = ((const int*)(F.ws + WS_SMALL + 256 * 1024))[F.tid];
            __syncthreads();
            if (F.tid == 0) { int run = 0; for (int s_ = 0; s_ < 4; ++s_) { const int e_ = (F.bx & 7) + 8 * s_; TS[40 + s_] = run; TS[48 + s_] = TS[e_]; run += 4 * (TS[e_ + 1] - TS[e_]); } TS[44] = run;
                int gm_ = 0; for (int x_ = 0; x_ < 8; ++x_) { int u_ = 0; for (int s_ = 0; s_ < 4; ++s_) u_ += 4 * (TS[x_ + 8 * s_ + 1] - TS[x_ + 8 * s_]); const int r_ = (u_ + (F.G >> 3) - 1) / (F.G >> 3); gm_ = r_ > gm_ ? r_ : gm_; } TS[45] = gm_; }
            __syncthreads();
            pg8::Gemm g{(const bf16*)(F.ws + WS_ACT), (const bf16*)(F.ws + WS_WDN + (size_t)(F.l & 1) * EXP_ALT), MOE_ROWS, NEXP * 1024, DEXP};
            pg8::MoeOrder S{F.G, F.bx, TS + 40};
            pg8::EpiDown E{(bf16*)(F.ws + WS_YB)};
            pg8::gemm_phase<pg8::EpiDown, pg8::MoeOrder, PG8_ALIGN, PG8_SP2>(F.lds, g, S, E);
            if (F.l + 1 < NLAYER) { const int nx_ = __builtin_amdgcn_readfirstlane(TS[44]), lc_ = F.bx >> 3, per_ = F.G >> 3, myunits = nx_ > lc_ ? (nx_ - lc_ + per_ - 1) / per_ : 0;
                const int idle_ = __builtin_amdgcn_readfirstlane(TS[45]) - myunits;
                (void)idle_; }
        }
        SEAM();
    }
    { const int l = 0; (void)l; if (IN_RANGE() && EN(12)) for (int rep_ = 0; rep_ < REPS(12); ++rep_) { FRESH(); p_norm<1>(F, xrun, true, (PCUT >= DIAG_COMB_MIN) ? LRUN - 1 : -1, nullptr, inp(F, I_WNF), nullptr, nullptr, nullptr, F.out); } }
#undef xrun
#undef mod
#undef H
#undef PROJ
#undef Y
#undef modl
#undef IN_RANGE
#undef SEAM
}

#ifndef MK_SPLIT
#define MK_SPLIT 0
#endif
extern "C" void kernel_launch(void* const* d_in, const int* in_sizes, int n_in, void* d_out, int out_size, void* d_ws, size_t ws_size, hipStream_t stream) {
    static int grid = 0;
    if (grid == 0) {
        if (n_in != 27 || out_size != T * D || ws_size < WS_END) { fprintf(stderr, "kernel_launch: unexpected shapes (n_in %d, out %d, ws %zu)\n", n_in, out_size, ws_size); grid = -1; return; }
        int dev = 0, cus = 0, per_cu = 0;
        if (hipGetDevice(&dev) != hipSuccess || hipDeviceGetAttribute(&cus, hipDeviceAttributeMultiprocessorCount, dev) != hipSuccess) { grid = -1; return; }
        if (hipFuncSetAttribute((const void*)mega_fwd, hipFuncAttributeMaxDynamicSharedMemorySize, LDS_BYTES) != hipSuccess) { fprintf(stderr, "kernel_launch: hipFuncSetAttribute failed\n"); grid = -1; return; }
        if (hipOccupancyMaxActiveBlocksPerMultiprocessor(&per_cu, (const void*)mega_fwd, NWAVES * 64, LDS_BYTES) != hipSuccess || per_cu < 1) { fprintf(stderr, "kernel_launch: occupancy query says %d\n", per_cu); (void)hipGetLastError(); grid = -1; return; }
        grid = cus;
    }
    if (grid < 0) return;
    (void)hipMemsetAsync((char*)d_ws + WS_CTL, 0, CTL_ZERO_BYTES, stream);
    Args a{};
    for (int i = 0; i < 27; ++i) a.in[i] = (const float*)d_in[i];
    a.out = (float*)d_out; a.ws = (unsigned char*)d_ws;
#if MK_SPLIT
    for (int p = 0; p < PH_TOTAL; ++p) { a.ph_lo = p; a.ph_hi = p + 1; hipLaunchKernelGGL(mega_fwd, dim3(grid), dim3(NWAVES * 64), LDS_BYTES, stream, a); }
#else
    a.ph_lo = 0; a.ph_hi = PH_TOTAL;
    hipLaunchKernelGGL(mega_fwd, dim3(grid), dim3(NWAVES * 64), LDS_BYTES, stream, a);
#endif
}
```

```cpp
#include <hip/hip_runtime.h>
#include <hip/hip_bf16.h>
#include <cstdio>
#include <cstdint>
#include <cmath>
namespace pg8 {
#define PG8_LAS __attribute__((address_space(3)))
typedef unsigned short bf16_t;
typedef short bf16x8 __attribute__((ext_vector_type(8)));
typedef float f32x4 __attribute__((ext_vector_type(4)));
typedef unsigned u32x4 __attribute__((ext_vector_type(4)));
constexpr int BM = 256, BK = 64, HALF = 128, HTB = HALF * BK * 2  , STAGE_BYTES = 8 * HTB, NXCD = 8, WGM = 8;

__host__ __device__ __forceinline__ int lds_byte(int r, int c) { const int st = (r >> 4) * 2 + (c >> 5), rr = r & 15, cc = c & 31, ob = rr * 64 + cc * 2; return st * 1024 + (ob ^ (((ob >> 9) & 1) << 5)); }
__host__ __device__ __forceinline__ void stage_rc(int b, int& R, int& C) { const int st = b / 1024, sb = b % 1024, swz = sb ^ (((sb >> 9) & 1) << 5); R = (st >> 1) * 16 + swz / 64; C = (st & 1) * 32 + (swz % 64) / 2; }
__host__ __device__ __forceinline__ int perm32(int rho) { const int n = rho >> 4, i = rho & 15; return 8 * (i >> 2) + 4 * n + (i & 3); }

struct Unit { int pm, pn; };
struct Gemm { const bf16_t* A; const bf16_t* Bt; int M, N, K; };

struct StaticOrder {
    int nM, nN, nwg, G, c;
    __host__ __device__ void init(int M, int N, int G_, int c_) { nM = M / BM; nN = N / BM; nwg = nM * nN; G = G_; c = c_; }
    __host__ __device__ bool next(int i, Unit& u) const {
        const long L = (long)i * G + c; if (L >= nwg) return false;
        int wgid = (int)L; { const int q = nwg / NXCD, r = nwg % NXCD, xcd = wgid % NXCD, off = wgid / NXCD; wgid = (xcd < r ? xcd * (q + 1) : r * (q + 1) + (xcd - r) * q) + off; }
        const int nig = WGM * nN, gid = wgid / nig, fm = gid * WGM, gsz = (nM - fm) < WGM ? (nM - fm) : WGM;
        u.pm = fm + ((wgid % nig) % gsz); u.pn = (wgid % nig) / gsz; return true;
    }
    __device__ __forceinline__ void a_ready(const Unit&) const {}
    __device__ __forceinline__ void done(const Unit&) const {}
};

__device__ __forceinline__ unsigned cvt_pk_bf16(float lo, float hi) { unsigned r; asm volatile("v_cvt_pk_bf16_f32 %0, %1, %2" : "=v"(r) : "v"(lo), "v"(hi)); return r; }
typedef float f32x2 __attribute__((ext_vector_type(2)));
template <class Epi, class Sched, bool ALIGN_EPI = false, bool SP2 = false, bool GATHER = false>
__device__ __forceinline__ void gemm_phase(PG8_LAS unsigned char* lds, const Gemm g, const Sched& S, const Epi& E, const PG8_LAS int* rt = nullptr) {
    int tid_ = threadIdx.x; asm volatile("" : "+v"(tid_));
    const int tid = tid_, wid = __builtin_amdgcn_readfirstlane(tid >> 6), lane = tid & 63, wr = wid >> 2, wc = wid & 3, fr = lane & 15, fq = lane >> 4;
    const int K = g.K, nt = K / BK;
    unsigned voffA[2], voffB[2];
#pragma unroll
    for (int i = 0; i < 2; ++i) { int R, C; stage_rc(tid * 16 + i * 8192, R, C); const int Rb = Epi::PERM ? ((R & ~31) + perm32(R & 31)) : R;
        voffA[i] = (unsigned)(R * K + C) * 2u; voffB[i] = (unsigned)(Rb * K + C) * 2u; }
    const size_t kstep = (size_t)(BK * 2);
    static_assert(!GATHER || SP2, "gather needs the SP2 loop");
#define PG8_GROWS(d0, d1, ui_) do { _Pragma("unroll") for (int _i = 0; _i < 2; ++_i) { int R_, C_; stage_rc(tid * 16 + _i * 8192, R_, C_); \
        d0[_i] = (unsigned)(rt[(ui_) * 256 + R_] * K + C_) * 2u; d1[_i] = (unsigned)(rt[(ui_) * 256 + 128 + R_] * K + C_) * 2u; } } while (0)
    const size_t hstep = (size_t)HALF * K * 2;
    const size_t tstep = 2 * hstep;
    const unsigned ldsw = (unsigned)wid * 1024u;
    const int aoff = lds_byte(wr * 64 + fr, fq * 8), boff = lds_byte(wc * 32 + fr, fq * 8);
#define PG8_SA(b, h) (((b) * 2 + (h)) * HTB)
#define PG8_SB(b, h) ((4 + (b) * 2 + (h)) * HTB)
#define PG8_STAGE(bufoff, gbase, voff) do { _Pragma("unroll") for (int _i = 0; _i < 2; ++_i) \
        __builtin_amdgcn_global_load_lds((const unsigned*)((const char*)(gbase) + (voff)[_i]), (PG8_LAS unsigned*)(lds + (bufoff) + ldsw + _i * 8192), 16, 0, 0); } while (0)
#define PG8_LDA(dst, b, h) do { _Pragma("unroll") for (int m = 0; m < 4; ++m) _Pragma("unroll") for (int k = 0; k < 2; ++k) dst[m][k] = *(const PG8_LAS bf16x8*)(lds + PG8_SA(b, h) + aoff + m * 2048 + k * 1024); } while (0)
#define PG8_LDB(dst, b, h) do { _Pragma("unroll") for (int n = 0; n < 2; ++n) _Pragma("unroll") for (int k = 0; k < 2; ++k) dst[n][k] = *(const PG8_LAS bf16x8*)(lds + PG8_SB(b, h) + boff + n * 2048 + k * 1024); } while (0)
#define PG8_MMA(ai, bj, At, Bt) do { __builtin_amdgcn_s_setprio(1); _Pragma("unroll") for (int m = 0; m < 4; ++m) _Pragma("unroll") for (int n = 0; n < 2; ++n) _Pragma("unroll") for (int k = 0; k < 2; ++k) \
        acc[ai][bj][m][n] = __builtin_amdgcn_mfma_f32_16x16x32_bf16(Bt[n][k], At[m][k], acc[ai][bj][m][n], 0, 0, 0); __builtin_amdgcn_s_setprio(0); } while (0)
#define PG8_WAIT_V(n) asm volatile("s_waitcnt vmcnt(" #n ")" ::: "memory")
#define PG8_WAIT_L(n) asm volatile("s_waitcnt lgkmcnt(" #n ")" ::: "memory")
#define PG8_BAR __builtin_amdgcn_s_barrier()
#define PG8_SCHED __builtin_amdgcn_sched_barrier(0)
    Unit cur, nxt;
    if (!S.next(0, cur)) return;
    f32x4 acc[2][2][4][2];
#pragma unroll
    for (int a = 0; a < 2; ++a)
#pragma unroll
        for (int b = 0; b < 2; ++b)
#pragma unroll
            for (int m = 0; m < 4; ++m)
#pragma unroll
                for (int n = 0; n < 2; ++n) acc[a][b][m][n] = (f32x4){0.f, 0.f, 0.f, 0.f};
    bf16x8 At[4][2], B0[2][2], B1[2][2];
    const char* cA = (const char*)g.A + (GATHER ? (size_t)0 : (size_t)cur.pm * tstep); const char* cB = (const char*)g.Bt + (size_t)cur.pn * tstep;
#define PG8_STAGE_A(bufoff, kbase, half, nextsel) do { if constexpr (GATHER) { unsigned o_[2]; const int un_ = ((nextsel) && has_next_) ? ui + 1 : ui; \
            _Pragma("unroll") for (int _j = 0; _j < 2; ++_j) { int R_, C_; stage_rc(tid * 16 + _j * 8192, R_, C_); o_[_j] = (unsigned)(rt[un_ * 256 + (half) * 128 + R_] * K + C_) * 2u; } \
            PG8_STAGE(bufoff, kbase, o_); } \
        else PG8_STAGE(bufoff, (kbase) + ((half) ? hstep : 0), voffA); } while (0)
    bool has_next_ = false; int ui = 0;
    S.a_ready(cur);
    if constexpr (SP2) {
        PG8_STAGE(PG8_SB(0, 0), cB, voffB); PG8_STAGE(PG8_SB(0, 1), cB + hstep, voffB); PG8_STAGE_A(PG8_SA(0, 0), cA, 0, false); PG8_STAGE_A(PG8_SA(0, 1), cA, 1, false);
        if (wr == 1) PG8_BAR;
        PG8_WAIT_V(2); PG8_BAR;
        PG8_STAGE(PG8_SB(1, 0), cB + kstep, voffB); PG8_STAGE_A(PG8_SA(1, 0), cA + kstep, 0, false); PG8_STAGE(PG8_SB(1, 1), cB + hstep + kstep, voffB);
        PG8_WAIT_V(6); PG8_BAR;
    } else {
        PG8_STAGE(PG8_SB(0, 0), cB, voffB); PG8_STAGE(PG8_SA(0, 0), cA, voffA); PG8_STAGE(PG8_SB(0, 1), cB + hstep, voffB); PG8_STAGE(PG8_SA(0, 1), cA + hstep, voffA);
        if (wr == 1) PG8_BAR;
        PG8_WAIT_V(4); PG8_BAR;
        PG8_STAGE(PG8_SB(1, 0), cB + kstep, voffB); PG8_STAGE(PG8_SA(1, 0), cA + kstep, voffA); PG8_STAGE(PG8_SB(1, 1), cB + hstep + kstep, voffB);
        PG8_WAIT_V(6); PG8_BAR;
    }
    for (;;) {
        const bool has_next = S.next(ui + 1, nxt);
        const char* nA = (has_next && !GATHER) ? (const char*)g.A + (size_t)nxt.pm * tstep : cA;
        has_next_ = has_next; const char* nB = has_next ? (const char*)g.Bt + (size_t)nxt.pn * tstep : cB;
        for (int t = 0; t < nt; t += 2) {
            const bool last = (t == nt - 2);
            const char* a1 = cA + (size_t)(t + 1) * kstep;
            const char* a2 = last ? nA : cA + (size_t)(t + 2) * kstep; const char* b2 = last ? nB : cB + (size_t)(t + 2) * kstep;
            const char* a3 = a2 + kstep; const char* b3 = b2 + kstep;
            if (last && has_next) S.a_ready(nxt);
            if constexpr (SP2) {
            PG8_LDB(B0, 0, 0); PG8_LDB(B1, 0, 1); PG8_SCHED; PG8_LDA(At, 0, 0); PG8_STAGE_A(PG8_SA(1, 1), a1, 1, false);
            PG8_WAIT_V(8); PG8_WAIT_L(0); PG8_BAR; PG8_MMA(0, 0, At, B0); PG8_MMA(0, 1, At, B1); PG8_BAR; PG8_SCHED;
            PG8_LDA(At, 0, 1); PG8_STAGE(PG8_SB(0, 0), b2, voffB); PG8_STAGE(PG8_SB(0, 1), b2 + hstep, voffB); PG8_STAGE_A(PG8_SA(0, 0), a2, 0, last);
            PG8_WAIT_V(8); PG8_WAIT_L(0); PG8_BAR; PG8_MMA(1, 0, At, B0); PG8_MMA(1, 1, At, B1); PG8_BAR; PG8_SCHED;
            PG8_LDB(B0, 1, 0); PG8_LDB(B1, 1, 1); PG8_SCHED; PG8_LDA(At, 1, 0); PG8_STAGE_A(PG8_SA(0, 1), a2, 1, last);
            PG8_WAIT_V(8); PG8_WAIT_L(0); PG8_BAR; PG8_MMA(0, 0, At, B0); PG8_MMA(0, 1, At, B1); PG8_BAR; PG8_SCHED;
            PG8_LDA(At, 1, 1); PG8_STAGE(PG8_SB(1, 0), b3, voffB); PG8_STAGE(PG8_SB(1, 1), b3 + hstep, voffB); PG8_STAGE_A(PG8_SA(1, 0), a3, 0, last);
            PG8_WAIT_V(8); PG8_WAIT_L(0); PG8_BAR; PG8_MMA(1, 0, At, B0); PG8_MMA(1, 1, At, B1); PG8_BAR; PG8_SCHED;
            } else {
            PG8_LDB(B0, 0, 0); PG8_SCHED; PG8_LDA(At, 0, 0); PG8_STAGE(PG8_SA(1, 1), a1 + hstep, voffA);
            PG8_WAIT_L(8); PG8_BAR; PG8_WAIT_L(0); PG8_MMA(0, 0, At, B0); PG8_BAR; PG8_SCHED;
            PG8_LDB(B1, 0, 1); PG8_STAGE(PG8_SB(0, 0), b2, voffB);
            PG8_BAR; PG8_WAIT_L(0); PG8_MMA(0, 1, At, B1); PG8_BAR;
            PG8_LDA(At, 0, 1); PG8_STAGE(PG8_SA(0, 0), a2, voffA);
            PG8_BAR; PG8_WAIT_L(0); PG8_MMA(1, 0, At, B0); PG8_BAR; PG8_SCHED;
            PG8_STAGE(PG8_SB(0, 1), b2 + hstep, voffB);
            PG8_WAIT_V(6); PG8_BAR; PG8_MMA(1, 1, At, B1); PG8_BAR;
            PG8_LDB(B0, 1, 0); PG8_SCHED; PG8_LDA(At, 1, 0); PG8_STAGE(PG8_SA(0, 1), a2 + hstep, voffA);
            PG8_WAIT_L(8); PG8_BAR; PG8_WAIT_L(0); PG8_MMA(0, 0, At, B0); PG8_BAR; PG8_SCHED;
            PG8_LDB(B1, 1, 1); PG8_STAGE(PG8_SB(1, 0), b3, voffB);
            PG8_BAR; PG8_WAIT_L(0); PG8_MMA(0, 1, At, B1); PG8_BAR;
            PG8_LDA(At, 1, 1); PG8_STAGE(PG8_SA(1, 0), a3, voffA);
            PG8_BAR; PG8_WAIT_L(0); PG8_MMA(1, 0, At, B0); PG8_BAR; PG8_SCHED;
            PG8_STAGE(PG8_SB(1, 1), b3 + hstep, voffB);
            PG8_WAIT_V(6); PG8_BAR; PG8_MMA(1, 1, At, B1); PG8_BAR;
            }
        }
        if constexpr (ALIGN_EPI) { if (wr == 0) PG8_BAR; }
        if constexpr (!Epi::AFTER_DRAIN) { E(acc, cur, wr, wc, fr, fq); S.done(cur); }
        if (!has_next) break;
#pragma unroll
        for (int a = 0; a < 2; ++a)
#pragma unroll
            for (int b = 0; b < 2; ++b)
#pragma unroll
                for (int m = 0; m < 4; ++m)
#pragma unroll
                    for (int n = 0; n < 2; ++n) acc[a][b][m][n] = (f32x4){0.f, 0.f, 0.f, 0.f};
        cur = nxt; cA = nA; cB = nB; ++ui;

        if constexpr (ALIGN_EPI) { if (wr == 1) PG8_BAR; }
    }
    PG8_WAIT_V(0);
    if constexpr (!ALIGN_EPI) { if (wr == 0) PG8_BAR; }
    PG8_BAR;
    if constexpr (Epi::AFTER_DRAIN) { E.fused(acc, cur, wr, wc, fr, fq, lds, wid, lane); S.done(cur); }
#undef PG8_SA
#undef PG8_STAGE_A
#undef PG8_GROWS
#undef PG8_SB
#undef PG8_STAGE
#undef PG8_LDA
#undef PG8_LDB
#undef PG8_MMA
#undef PG8_WAIT_V
#undef PG8_WAIT_L
#undef PG8_BAR
#undef PG8_SCHED
}
}

#ifndef PG8_SP2
#define PG8_SP2 true
#endif
#ifndef PG8_ALIGN
#define PG8_ALIGN true
#endif
#include <hip/hip_bf16.h>
#include <cmath>
namespace attn_body {
using bf16=__hip_bfloat16;
using bf16x8=__attribute__((ext_vector_type(8)))short;
using s16x4=__attribute__((ext_vector_type(4)))short;
using f32x16=__attribute__((ext_vector_type(16)))float;
using u32x4=__attribute__((ext_vector_type(4)))unsigned;
typedef float f32x4_t __attribute__((ext_vector_type(4)));
constexpr int BATCH=4,NHEAD=4,SEQ=8192,D=64,DM=3328,DO=1024;
constexpr int NW=8,QBLK=32,QB=QBLK*NW,KVBLK=64,NQB=SEQ/QB;
constexpr int ATTN_UNIT_ROWS=QB;
__device__ __forceinline__ int crow(int r,int hi){return (r&3)+8*(r>>2)+4*hi;}
#define SBAR() __builtin_amdgcn_sched_barrier(0)
__device__ __forceinline__ void cmask(f32x16&p0,f32x16&p1,int jb,int qrel,int hi){
  const float NEG=-INFINITY; int kb=64*jb+4*hi;
  #pragma unroll
  for(int r=0;r<16;++r){int kv=kb+(r&3)+8*(r>>2); if(kv>qrel)p0[r]=NEG; if(kv+32>qrel)p1[r]=NEG;}
}

constexpr int NSLOT=3, SLOTB=8192;
constexpr int LDS_K=0, LDS_V=NSLOT*SLOTB, LDS_WS=2*NSLOT*SLOTB, LDS_OST=LDS_WS+NW*64*4, LDS_F2=LDS_OST+NW*4096, LDS_BYTES=LDS_F2+SEQ*4;
constexpr float C2=0.125f*1.4426950408889634f;
__device__ __forceinline__ void glds16(const void*gsrc,unsigned lds_dst){unsigned keep;
  asm volatile("s_mov_b32 %0, m0\n\ts_mov_b32 m0, %2\n\ts_nop 0\n\tglobal_load_lds_dwordx4 %1, off\n\ts_mov_b32 m0, %0":"=&s"(keep):"v"(gsrc),"s"(lds_dst):"memory");}
__device__ __forceinline__ float max3f(float a,float b,float c){float r;asm("v_max3_f32 %0, %1, %2, %3":"=v"(r):"v"(a),"v"(b),"v"(c));return r;}
__device__ __forceinline__ float max2f(float a,float b){float r;asm("v_max_f32_e32 %0, %1, %2":"=v"(r):"v"(a),"v"(b));return r;}
__device__ __forceinline__ float fadd_s(float a,float b){float r;asm("v_add_f32_e32 %0, %1, %2":"=v"(r):"v"(a),"v"(b));return r;}
__device__ __forceinline__ float fsub_s(float a,float b){float r;asm("v_sub_f32_e32 %0, %1, %2":"=v"(r):"v"(a),"v"(b));return r;}
typedef float f32x2_t __attribute__((ext_vector_type(2))); typedef __bf16 bf16x2_t __attribute__((ext_vector_type(2)));
__device__ __forceinline__ unsigned cvtpk_s(float lo,float hi){f32x2_t v={lo,hi};bf16x2_t b=__builtin_convertvector(v,bf16x2_t);return __builtin_bit_cast(unsigned,b);}
#define WAIT_BAR(N) asm volatile("s_waitcnt vmcnt(" #N ") lgkmcnt(0)\n\ts_barrier":::"memory")

__device__ __forceinline__ void qkt(f32x16&p0,f32x16&p1,const char*Kslot,const bf16x8*qr,const f32x16&negm,int r32,int hi){
  const char*kb=Kslot+hi*1024+r32*16;
  #pragma unroll
  for(int d0=0;d0<4;++d0){
    const bf16x8 b0=*reinterpret_cast<const bf16x8*>(kb+d0*2048);
    const bf16x8 b1=*reinterpret_cast<const bf16x8*>(kb+d0*2048+512);
    if(d0==0){p0=__builtin_amdgcn_mfma_f32_32x32x16_bf16(b0,qr[0],negm,0,0,0);p1=__builtin_amdgcn_mfma_f32_32x32x16_bf16(b1,qr[0],negm,0,0,0);}
    else{p0=__builtin_amdgcn_mfma_f32_32x32x16_bf16(b0,qr[d0],p0,0,0,0);p1=__builtin_amdgcn_mfma_f32_32x32x16_bf16(b1,qr[d0],p1,0,0,0);}}
}
typedef __attribute__((address_space(3))) const char* lds_cptr;
typedef short v4i16_t __attribute__((ext_vector_type(4)));
__device__ __forceinline__ void kload8(bf16x8*kf,lds_cptr kp){
  kf[0]=*(const __attribute__((address_space(3))) bf16x8*)(kp);      kf[1]=*(const __attribute__((address_space(3))) bf16x8*)(kp+512);
  kf[2]=*(const __attribute__((address_space(3))) bf16x8*)(kp+2048); kf[3]=*(const __attribute__((address_space(3))) bf16x8*)(kp+2560);
  kf[4]=*(const __attribute__((address_space(3))) bf16x8*)(kp+4096); kf[5]=*(const __attribute__((address_space(3))) bf16x8*)(kp+4608);
  kf[6]=*(const __attribute__((address_space(3))) bf16x8*)(kp+6144); kf[7]=*(const __attribute__((address_space(3))) bf16x8*)(kp+6656);
}
__device__ __forceinline__ void kload2(bf16x8*kf,lds_cptr kp,int j){ kf[2*j]=*(const __attribute__((address_space(3))) bf16x8*)(kp+j*2048); kf[2*j+1]=*(const __attribute__((address_space(3))) bf16x8*)(kp+j*2048+512); }
__device__ __forceinline__ s16x4 vtr(lds_cptr p){ return __builtin_bit_cast(s16x4,__builtin_amdgcn_ds_read_tr16_b64_v4i16((__attribute__((address_space(3))) v4i16_t*)p)); }
__device__ __forceinline__ float rowmax(const f32x16&p0,const f32x16&p1){
  float a=max3f(p0[0],p0[1],p1[0]),b=max3f(p0[2],p0[3],p1[1]);a=max3f(a,p1[2],p1[3]);
  #pragma unroll
  for(int r=4;r<16;r+=4){a=max3f(a,p0[r],p0[r+1]);b=max3f(b,p0[r+2],p0[r+3]);a=max3f(a,p1[r],p1[r+1]);b=max3f(b,p1[r+2],p1[r+3]);}
  const float m=max2f(a,b);
  auto rr=__builtin_amdgcn_permlane32_swap(__float_as_uint(m),__float_as_uint(m),false,false);
  return max2f(__uint_as_float(rr[0]),__uint_as_float(rr[1]));
}
__device__ __forceinline__ void pv(f32x16*o,int vb,bf16x8 pa0,bf16x8 pa1,bf16x8 pa2,bf16x8 pa3){
  #pragma unroll
  for(int d0=0;d0<2;++d0){s16x4 lo[4],hi[4];
    #pragma unroll
    for(int ks=0;ks<4;++ks){
      asm volatile("ds_read_b64_tr_b16 %0,%1 offset:%c2":"=&v"(lo[ks]):"v"(vb),"i"(d0*4096+ks*1024):"memory");
      asm volatile("ds_read_b64_tr_b16 %0,%1 offset:%c2":"=&v"(hi[ks]):"v"(vb),"i"(d0*4096+ks*1024+512):"memory");}
    asm volatile("s_waitcnt lgkmcnt(0)":::"memory");SBAR();
    #define PK(k) (bf16x8){lo[k][0],lo[k][1],lo[k][2],lo[k][3],hi[k][0],hi[k][1],hi[k][2],hi[k][3]}
    o[d0]=__builtin_amdgcn_mfma_f32_32x32x16_bf16(pa0,PK(0),o[d0],0,0,0);
    o[d0]=__builtin_amdgcn_mfma_f32_32x32x16_bf16(pa1,PK(1),o[d0],0,0,0);
    o[d0]=__builtin_amdgcn_mfma_f32_32x32x16_bf16(pa2,PK(2),o[d0],0,0,0);
    o[d0]=__builtin_amdgcn_mfma_f32_32x32x16_bf16(pa3,PK(3),o[d0],0,0,0);
    #undef PK
  }
}

#ifndef ATTN_STORE16
#define ATTN_STORE16(p,v) (*(u32x4*)(p)=(v))
#endif
template<int THRL> __device__ __forceinline__ void attn_unit(int b,int h,int qb,const bf16*Q,const bf16*__restrict__ K,const bf16*__restrict__ V,bf16*O,const float*__restrict__ F2g,const float*__restrict__ gain,float qkb,char*shm){
  int tid_=threadIdx.x; asm volatile("":"+v"(tid_)); const int tid=tid_,lane=tid&63,r32=lane&31,hi=lane>>5; const int wid=__builtin_amdgcn_readfirstlane(tid>>6);
  const long rowbase=(long)b*SEQ; const int q0=qb*QB;
  const bf16*Qw=Q+(rowbase+q0+wid*QBLK)*DM+h*D;
  const float*f2row=F2g+((long)b*NHEAD+h)*SEQ;
  int t0;
  { const int NTf=(q0+QB)/KVBLK; const float thr=f2row[q0]+qkb+40.0f; const int ta=lane,tb=lane+64;
    const bool va=(ta<NTf-4)&&(f2row[64*ta+63]>thr), vb=(tb<NTf-4)&&(f2row[64*tb+63]>thr);
    t0=(__builtin_popcountll(__ballot(va))+__builtin_popcountll(__ballot(vb)))&~1; t0=__builtin_amdgcn_readfirstlane(t0); }
  const bf16*Kh=K+(rowbase+(long)t0*KVBLK)*DM+h*D,*Vh=V+(rowbase+(long)t0*KVBLK)*DM+h*D;
  const lds_cptr shm3=(lds_cptr)shm;
  const unsigned lds0=(unsigned)(uintptr_t)shm;
  float*wsf=(float*)(shm+LDS_WS)+wid*64;
  const bf16*ksrc=Kh+(long)lane*DM+wid*8;
  const bf16*vsrc=Vh+(long)(16*(wid&3)+(lane>>2))*DM+(wid>>2)*32+(lane&3)*8;
  const unsigned kdst=lds0+LDS_K+wid*1024, vdst=lds0+LDS_V+wid*1024;
  #define DMA_K(t,slot) glds16(ksrc+(long)(t)*KVBLK*DM,(unsigned)__builtin_amdgcn_readfirstlane(kdst+(slot)))
  #define DMA_V(t,slot) glds16(vsrc+(long)(t)*KVBLK*DM,(unsigned)__builtin_amdgcn_readfirstlane(vdst+(slot)))
  const int vb0=(int)(lds0+LDS_V)+((lane>>4)&1)*32+(lane&3)*8+(4*hi+((lane&15)>>2))*64;
  const char*Kbase=shm+LDS_K; bf16x8 kf[8];
  const lds_cptr kp0=shm3+LDS_K+hi*1024+r32*16; const lds_cptr vp0=shm3+LDS_V+((lane>>4)&1)*32+(lane&3)*8+(4*hi+((lane&15)>>2))*64;
  const int NT=(q0+QB)/KVBLK-t0;
  { const float*f2src=f2row+(long)t0*KVBLK; __attribute__((address_space(3))) float*f2l=(__attribute__((address_space(3))) float*)(shm3+LDS_F2);
    for(int i=tid;i<NT*KVBLK/4;i+=NW*64){ const f32x4_t v=*(const f32x4_t*)(f2src+4*i); *(__attribute__((address_space(3))) f32x4_t*)(f2l+4*i)=v; } }
  const __attribute__((address_space(3))) float*F2L=(const __attribute__((address_space(3))) float*)(shm3+LDS_F2)+4*hi;
  DMA_K(0,0);DMA_V(0,0);DMA_K(1,SLOTB);
  bf16x8 qr[4];
  #pragma unroll
  for(int d0=0;d0<4;++d0)qr[d0]=*reinterpret_cast<const bf16x8*>(&Qw[(long)r32*DM+d0*16+hi*8]);
  float mhat=0.f,l_reg=0.f;f32x16 o[2];o[0]=f32x16{};o[1]=f32x16{};f32x16 negm=f32x16{};asm volatile("":"+v"(negm));
  const int qrel=wid*QBLK+r32;
  #define CMASK(P0,P1,t) do{int jb_=(t)-(NT-4); if(jb_>=0)cmask(P0,P1,jb_,qrel,hi);}while(0)
  #define BIAS(P0,P1,t) do{ const __attribute__((address_space(3))) float*fb_=F2L+(t)*64; \
    const f32x4_t b00_=*(const __attribute__((address_space(3))) f32x4_t*)(fb_),    b01_=*(const __attribute__((address_space(3))) f32x4_t*)(fb_+8),  b02_=*(const __attribute__((address_space(3))) f32x4_t*)(fb_+16), b03_=*(const __attribute__((address_space(3))) f32x4_t*)(fb_+24); \
    const f32x4_t b10_=*(const __attribute__((address_space(3))) f32x4_t*)(fb_+32), b11_=*(const __attribute__((address_space(3))) f32x4_t*)(fb_+40), b12_=*(const __attribute__((address_space(3))) f32x4_t*)(fb_+48), b13_=*(const __attribute__((address_space(3))) f32x4_t*)(fb_+56); \
    _Pragma("unroll") for(int e_=0;e_<4;++e_){ P0[e_]-=b00_[e_]; P0[4+e_]-=b01_[e_]; P0[8+e_]-=b02_[e_]; P0[12+e_]-=b03_[e_]; P1[e_]-=b10_[e_]; P1[4+e_]-=b11_[e_]; P1[8+e_]-=b12_[e_]; P1[12+e_]-=b13_[e_]; } }while(0)
  bool resc=false;
  #define START(P0,P1) do{ const float rm=rowmax(P0,P1); resc=false; \
    { const float dl=rm; mhat=fadd_s(mhat,dl); \
      _Pragma("unroll") for(int r=0;r<16;++r){P0[r]=fsub_s(P0[r],dl);P1[r]=fsub_s(P1[r],dl);} \
      _Pragma("unroll") for(int r=0;r<16;++r)negm[r]=-mhat; asm volatile("":"+v"(negm)); } \
    _Pragma("unroll") for(int r=0;r<16;++r)P0[r]=__builtin_amdgcn_exp2f(P0[r]); }while(0)
  #define RESC() do{ if(resc){ asm volatile("s_waitcnt lgkmcnt(0)":::"memory"); \
      _Pragma("unroll") for(int d_=0;d_<2;++d_) _Pragma("unroll") for(int r=0;r<16;++r)o[d_][r]*=wsf[crow(r,hi)]; } }while(0)
  f32x16 pA0,pA1,pB0,pB1;
  int sl_prev=0,sl_cur=0,sl_next=SLOTB;
  #define ROT() do{sl_prev=sl_cur;sl_cur=sl_next;sl_next=(sl_next==(NSLOT-1)*SLOTB)?0:sl_next+SLOTB;}while(0)
  DMA_K(2,2*SLOTB);
  WAIT_BAR(3);
  qkt(pA0,pA1,Kbase,qr,negm,r32,hi);asm volatile("s_nop 15\n\ts_nop 7":"+v"(pA0),"+v"(pA1));BIAS(pA0,pA1,0);CMASK(pA0,pA1,0);
  START(pA0,pA1);
  _Pragma("unroll") for(int r=0;r<16;++r)pA1[r]=__builtin_amdgcn_exp2f(pA1[r]);
  WAIT_BAR(0);
  DMA_K(3,0);DMA_V(1,SLOTB);
  ROT();
  kload8(kf,kp0+sl_cur);
  WAIT_BAR(2);
  s16x4 vlo[8],vhi[8]; u32x4 pw0,pw1,pw2,pw3;
  #define PKW(P,B) cvtpk_s(P[B],P[B+1])
  #define PAF(k) __builtin_bit_cast(bf16x8,pw##k)
  #define VFR(i) (bf16x8){vlo[i][0],vlo[i][1],vlo[i][2],vlo[i][3],vhi[i][0],vhi[i][1],vhi[i][2],vhi[i][3]}
  #define PIN(x) asm volatile("":"+v"(x))
  #define MX3(a,b,c) __builtin_fmaxf(__builtin_fmaxf((a),(b)),(c))
  #define GAPA(MF,A0,A1,A2,A3,W0,W1,PW) do{ MF; sacc+=A0; sacc+=A1; sacc+=A2; sacc+=A3; PIN(sacc); W0; W1; PIN(PW); SBAR(); }while(0)
  #define EX(v) __builtin_amdgcn_exp2f(v)
  #define GAPB(MF,X,B) do{ MF; X[B]=EX(X[B]); X[B+1]=EX(X[B+1]); X[B+2]=EX(X[B+2]); X[B+3]=EX(X[B+3]); PIN(X); SBAR(); }while(0)
  #define VRD(i) do{ vlo[i]=vtr(vp_+(((i)>>2)*4096+((i)&3)*1024)); vhi[i]=vtr(vp_+(((i)>>2)*4096+((i)&3)*1024+512)); }while(0)
  #define KRD(G,j) do{ if(G){ kload2(kf,kp0+sl_next,j); SBAR(); } }while(0)
  #define STEP(C0,C1,P0,P1,t,GK,GV,GL) do{ SBAR(); \
    const lds_cptr vp_=vp0+sl_prev; \
    VRD(0); SBAR(); float sacc=(P0[0]+P0[1]); \
    GAPA(C0=__builtin_amdgcn_mfma_f32_32x32x16_bf16(kf[0],qr[0],negm,0,0,0), P0[2],P0[3],P0[4],P0[5],     pw0[0]=PKW(P0,0), pw0[1]=PKW(P0,2), pw0); \
    VRD(4); SBAR(); GAPA(C1=__builtin_amdgcn_mfma_f32_32x32x16_bf16(kf[1],qr[0],negm,0,0,0), P0[6],P0[7],P0[8],P0[9],     pw0[2]=PKW(P0,4), pw0[3]=PKW(P0,6), pw0); \
    VRD(1); SBAR(); GAPA(C0=__builtin_amdgcn_mfma_f32_32x32x16_bf16(kf[2],qr[1],C0,0,0,0),   P0[10],P0[11],P0[12],P0[13], pw1[0]=PKW(P0,8), pw1[1]=PKW(P0,10), pw1); \
    VRD(5); SBAR(); GAPA(C1=__builtin_amdgcn_mfma_f32_32x32x16_bf16(kf[3],qr[1],C1,0,0,0),   P0[14],P0[15],P1[0],P1[1],   pw1[2]=PKW(P0,12),pw1[3]=PKW(P0,14), pw1); \
    VRD(2); SBAR(); GAPA(C0=__builtin_amdgcn_mfma_f32_32x32x16_bf16(kf[4],qr[2],C0,0,0,0),   P1[2],P1[3],P1[4],P1[5],     pw2[0]=PKW(P1,0), pw2[1]=PKW(P1,2), pw2); \
    VRD(6); SBAR(); GAPA(C1=__builtin_amdgcn_mfma_f32_32x32x16_bf16(kf[5],qr[2],C1,0,0,0),   P1[6],P1[7],P1[8],P1[9],     pw2[2]=PKW(P1,4), pw2[3]=PKW(P1,6), pw2); \
    VRD(3); SBAR(); GAPA(C0=__builtin_amdgcn_mfma_f32_32x32x16_bf16(kf[6],qr[3],C0,0,0,0),   P1[10],P1[11],P1[12],P1[13], pw3[0]=PKW(P1,8), pw3[1]=PKW(P1,10), pw3); \
    VRD(7); SBAR(); GAPA(C1=__builtin_amdgcn_mfma_f32_32x32x16_bf16(kf[7],qr[3],C1,0,0,0),   P1[14],P1[15],0.f,0.f,       pw3[2]=PKW(P1,12),pw3[3]=PKW(P1,14), pw3); \
    l_reg+=sacc; \
    if(GK){DMA_K((t)+3,sl_cur);} if(GV){DMA_V((t)+1,sl_next);} \
    BIAS(C0,C1,t); CMASK(C0,C1,t); \
    { float a=MX3(C0[0],C0[1],C1[0]),b=MX3(C0[2],C0[3],C1[1]); a=MX3(a,C1[2],C1[3]); \
      _Pragma("unroll") for(int r=4;r<16;r+=4){a=MX3(a,C0[r],C0[r+1]);b=MX3(b,C0[r+2],C0[r+3]);a=MX3(a,C1[r],C1[r+1]);b=MX3(b,C1[r+2],C1[r+3]);} \
      float rm=__builtin_fmaxf(a,b); { auto rr=__builtin_amdgcn_permlane32_swap(__float_as_uint(rm),__float_as_uint(rm),false,false); rm=__builtin_fmaxf(__uint_as_float(rr[0]),__uint_as_float(rr[1])); } \
      resc=false; \
      if(__builtin_expect(__any(rm>(float)THRL),0)){ const float dl=__builtin_fmaxf(rm,0.f); mhat+=dl; \
        _Pragma("unroll") for(int r=0;r<16;++r){C0[r]-=dl;C1[r]-=dl;} \
        _Pragma("unroll") for(int r=0;r<16;++r)negm[r]=-mhat; asm volatile("":"+v"(negm)); \
        const float f=__builtin_amdgcn_exp2f(-dl); l_reg*=f; if(hi==0)wsf[r32]=f; resc=true; } } \
    SBAR(); \
    GAPB(o[0]=__builtin_amdgcn_mfma_f32_32x32x16_bf16(PAF(0),VFR(0),o[0],0,0,0), C0,0); \
    GAPB(o[1]=__builtin_amdgcn_mfma_f32_32x32x16_bf16(PAF(0),VFR(4),o[1],0,0,0), C0,4); \
    KRD(GL,0); GAPB(o[0]=__builtin_amdgcn_mfma_f32_32x32x16_bf16(PAF(1),VFR(1),o[0],0,0,0), C0,8); \
    KRD(GL,1); GAPB(o[1]=__builtin_amdgcn_mfma_f32_32x32x16_bf16(PAF(1),VFR(5),o[1],0,0,0), C0,12); \
    KRD(GL,2); GAPB(o[0]=__builtin_amdgcn_mfma_f32_32x32x16_bf16(PAF(2),VFR(2),o[0],0,0,0), C1,0); \
    KRD(GL,3); GAPB(o[1]=__builtin_amdgcn_mfma_f32_32x32x16_bf16(PAF(2),VFR(6),o[1],0,0,0), C1,4); \
    GAPB(o[0]=__builtin_amdgcn_mfma_f32_32x32x16_bf16(PAF(3),VFR(3),o[0],0,0,0), C1,8); \
    GAPB(o[1]=__builtin_amdgcn_mfma_f32_32x32x16_bf16(PAF(3),VFR(7),o[1],0,0,0), C1,12); \
    }while(0)
  int t=1;
  #undef CMASK
  #define CMASK(P0,P1,t) do{}while(0)
  for(;t+5<NT;t+=2){
    STEP(pB0,pB1,pA0,pA1,t,true,true,true);     WAIT_BAR(2); RESC(); ROT();
    STEP(pA0,pA1,pB0,pB1,t+1,true,true,true);   WAIT_BAR(2); RESC(); ROT();
  }
  #undef CMASK
  #define CMASK(P0,P1,t) do{int jb_=(t)-(NT-4); if(jb_>=0)cmask(P0,P1,jb_,qrel,hi);}while(0)
  #define ENDW(tt) do{ if((tt)+3<NT){WAIT_BAR(2);} else if((tt)+2<NT){WAIT_BAR(1);} else {WAIT_BAR(0);} }while(0)
  for(;t+1<NT;t+=2){
    STEP(pB0,pB1,pA0,pA1,t,(t+3<NT),(t+1<NT),(t+1<NT));       ENDW(t);   RESC(); ROT();
    STEP(pA0,pA1,pB0,pB1,t+1,(t+4<NT),(t+2<NT),(t+2<NT));     ENDW(t+1); RESC(); ROT();
  }
  STEP(pB0,pB1,pA0,pA1,NT-1,false,false,false); RESC();
  { float sacc=pB0[0]+pB0[1]; _Pragma("unroll") for(int r=2;r<16;++r)sacc+=pB0[r]; _Pragma("unroll") for(int r=0;r<16;++r)sacc+=pB1[r]; l_reg+=sacc;
    pw0=(u32x4){PKW(pB0,0),PKW(pB0,2),PKW(pB0,4),PKW(pB0,6)};pw1=(u32x4){PKW(pB0,8),PKW(pB0,10),PKW(pB0,12),PKW(pB0,14)};pw2=(u32x4){PKW(pB1,0),PKW(pB1,2),PKW(pB1,4),PKW(pB1,6)};pw3=(u32x4){PKW(pB1,8),PKW(pB1,10),PKW(pB1,12),PKW(pB1,14)};
    SBAR(); pv(o,vb0+sl_cur,PAF(0),PAF(1),PAF(2),PAF(3)); }
  #undef PKW
  #undef PAF
  #undef VFR
  #undef PIN
  #undef MX3
  #undef GAPA
  #undef GAPB
  #undef EX
  #undef VRD
  #undef KRD
  #undef STEP
  #undef ENDW
  {auto rr=__builtin_amdgcn_permlane32_swap(__float_as_uint(l_reg),__float_as_uint(l_reg),false,false);l_reg=__uint_as_float(rr[0])+__uint_as_float(rr[1]);}
  if(hi==0)wsf[32+r32]=l_reg;asm volatile("s_waitcnt lgkmcnt(0)":::"memory");
  float rli[16];
  #pragma unroll
  for(int r=0;r<16;++r)rli[r]=__builtin_amdgcn_rcpf(wsf[32+crow(r,hi)]);
  bf16*Ow=O+(rowbase+q0+wid*QBLK)*DO+h*D;
  { bf16*stg=(bf16*)(shm+LDS_OST)+wid*2048;
    #pragma unroll
    for(int r=0;r<16;++r){const int orow=crow(r,hi);
      #pragma unroll
      for(int d0=0;d0<2;++d0)stg[orow*64+d0*32+r32]=__float2bfloat16(o[d0][r]*rli[r]);}
    asm volatile("s_waitcnt lgkmcnt(0)":::"memory");
    const f32x4_t g0=*(const f32x4_t*)(gain+h*D+(lane&7)*8), g1=*(const f32x4_t*)(gain+h*D+(lane&7)*8+4);
    #pragma unroll
    for(int i=0;i<4;++i){const int row=i*8+(lane>>3),ch=lane&7; const u32x4 v=*(const u32x4*)(stg+row*64+ch*8);
      float x[8];
      #pragma unroll
      for(int e=0;e<4;++e){ x[2*e]=__uint_as_float(v[e]<<16); x[2*e+1]=__uint_as_float(v[e]&0xffff0000u); }
      float ss=0.f;
      #pragma unroll
      for(int e=0;e<8;++e)ss+=x[e]*x[e];
      ss+=__int_as_float(__builtin_amdgcn_ds_bpermute((lane^1)<<2,__float_as_int(ss))); ss+=__int_as_float(__builtin_amdgcn_ds_bpermute((lane^2)<<2,__float_as_int(ss))); ss+=__int_as_float(__builtin_amdgcn_ds_bpermute((lane^4)<<2,__float_as_int(ss)));
      const float rs=rsqrtf(ss*(1.0f/64.0f)+1e-6f);
      u32x4 w; w[0]=cvtpk_s(x[0]*rs*g0[0],x[1]*rs*g0[1]); w[1]=cvtpk_s(x[2]*rs*g0[2],x[3]*rs*g0[3]); w[2]=cvtpk_s(x[4]*rs*g1[0],x[5]*rs*g1[1]); w[3]=cvtpk_s(x[6]*rs*g1[2],x[7]*rs*g1[3]);
      ATTN_STORE16(Ow+(long)row*DO+ch*8,w);} }
  asm volatile("s_waitcnt lgkmcnt(0)\n\ts_barrier":::"memory");
  #undef DMA_K
  #undef DMA_V
  #undef CMASK
  #undef START
  #undef RESC
  #undef ROT
}
constexpr int ATTN_LDS_BYTES=LDS_BYTES;
struct AttnTensors { const bf16* Q; const bf16* K; const bf16* V; bf16* O; const float* F2; const float* gain; const unsigned* qkn; };
struct AttnUnit { int bh; int qb; };
struct StaticOrder {
  int vcu, G;
  __device__ __forceinline__ explicit StaticOrder(int grid,int block):vcu((grid%8==0)?(block%8)*(grid/8)+block/8:block),G(grid){}
  __device__ __forceinline__ bool next(int i,AttnUnit&u)const{ const int pair=vcu+(i>>1)*G; if(pair>=256)return false; const int s=pair&15; u.bh=pair>>4; u.qb=(i&1)?31-s:s; return true; }
  __device__ __forceinline__ void a_ready(const AttnUnit&)const{}
  __device__ __forceinline__ void done(const AttnUnit&)const{}
};
template<class Sched,int THRL=8> __device__ __forceinline__ void attn_phase(char*lds,const AttnTensors&T,const Sched&S){
  AttnUnit u;
  for(int i=0;S.next(i,u);++i){ S.a_ready(u); attn_unit<THRL>(u.bh/NHEAD,u.bh%NHEAD,u.qb,T.Q,T.K,T.V,T.O,T.F2,T.gain,2.0f*sqrtf(__uint_as_float(T.qkn[2*u.bh])*__uint_as_float(T.qkn[2*u.bh+1])),lds); S.done(u); }
}
#undef SBAR
#undef WAIT_BAR
}
#define GAS __attribute__((address_space(1)))
#define LAS __attribute__((address_space(3)))
typedef unsigned short bf16;
typedef unsigned v4u __attribute__((ext_vector_type(4)));
typedef float f32x4 __attribute__((ext_vector_type(4)));
typedef short bf16x8 __attribute__((ext_vector_type(8)));
typedef GAS unsigned gu32;
typedef GAS unsigned long long gu64;
#define RLX_AGENT __ATOMIC_RELAXED, __HIP_MEMORY_SCOPE_AGENT
#define LDS_WAIT() asm volatile("s_waitcnt lgkmcnt(0)" ::: "memory")
#define VM_WAIT() asm volatile("s_waitcnt vmcnt(0)" ::: "memory")
__device__ __forceinline__ unsigned long long rt() { return __builtin_amdgcn_s_memrealtime(); }
__device__ __forceinline__ unsigned f2bf(float f) { unsigned u = __builtin_bit_cast(unsigned, f); return (u + 0x7fffu + ((u >> 16) & 1u)) >> 16; }
__device__ __forceinline__ unsigned pk2(float lo, float hi) { return f2bf(lo) | (f2bf(hi) << 16); }

#define XB_TMO      128
#define XB_XCNT(j)  (256  + 64 * (j))
#define XB_XSUB(j)  (1280 + 64 * (j))
#define XB_XGEN(j)  (2304 + 64 * (j))
#define XB_TOP      3328
#define XB_TOPGEN   3392
#define XCD_BAR_WORDS 3456
#define XB_SPIN_CAP (1u << 18)
#ifndef XB_SCOPE
#define XB_SCOPE ""
#endif

__device__ __forceinline__ unsigned xb_ld(unsigned* p)              { return __hip_atomic_load(p, __ATOMIC_RELAXED, __HIP_MEMORY_SCOPE_AGENT); }
__device__ __forceinline__ unsigned xb_add(unsigned* p, unsigned v) { return __hip_atomic_fetch_add(p, v, __ATOMIC_RELAXED, __HIP_MEMORY_SCOPE_AGENT); }
__device__ __forceinline__ unsigned xb_xcc_id() { return (unsigned)__builtin_amdgcn_s_getreg((3 << 11) | 20) & 0xFu; }
#define XB_SPIN(cond, bar) do { unsigned _sp = 0; while (cond) { __builtin_amdgcn_s_sleep(1); \
    if ((++_sp & 255u) == 0u) { if (xb_ld(&(bar)[XB_TMO])) break; if (_sp > XB_SPIN_CAP) { atomicAdd(&(bar)[XB_TMO], 1u); break; } } } } while (0)

struct XcdBarrier {
    unsigned* bar; unsigned x;
    volatile LAS unsigned* st;
};

__device__ __forceinline__ XcdBarrier xcd_barrier_post(unsigned* bar, volatile LAS unsigned* st) {
    XcdBarrier b; b.bar = bar; b.x = xb_xcc_id(); b.st = st;
    if (threadIdx.x == 0) (void)xb_add(&bar[XB_XCNT(b.x)], 1u);
    return b;
}
__device__ __forceinline__ void xcd_barrier_complete(unsigned* bar, unsigned x, unsigned& nloc, unsigned& nx) {
    const unsigned G = gridDim.x * gridDim.y * gridDim.z;
    unsigned sum, cnt, mine, sp = 0u;
    for (;;) {
        sum = 0u; cnt = 0u; mine = 0u;
#pragma unroll
        for (unsigned j = 0; j < 16; ++j) { const unsigned c = xb_ld(&bar[XB_XCNT(j)]); sum += c; cnt += (c > 0u) ? 1u : 0u; mine = (j == x) ? c : mine; }
        if (sum == G) break;
        __builtin_amdgcn_s_sleep(1);
        if ((++sp & 255u) == 0u) { if (xb_ld(&bar[XB_TMO])) break; if (sp > XB_SPIN_CAP) { atomicAdd(&bar[XB_TMO], 1u); break; } }
    }
    nloc = mine > 0u ? mine : 1u; nx = cnt > 0u ? cnt : 1u;
}

__device__ __forceinline__ void xcd_barrier(const XcdBarrier& b) {
    asm volatile("s_waitcnt vmcnt(0)" ::: "memory");
    __syncthreads();
    if (threadIdx.x == 0) {
        unsigned* bar = b.bar;
        __builtin_amdgcn_s_waitcnt(0);
        unsigned nloc = b.st[0], nx = b.st[1];
        if (nloc == 0u) { xcd_barrier_complete(bar, b.x, nloc, nx); b.st[0] = nloc; b.st[1] = nx; }
        const unsigned old = xb_add(&bar[XB_XSUB(b.x)], 1u);
        const unsigned gen = old / nloc;
        if (old + 1u == (gen + 1u) * nloc) {
            __builtin_amdgcn_fence(__ATOMIC_RELEASE, XB_SCOPE);
            asm volatile("s_waitcnt vmcnt(0)" ::: "memory");
            const unsigned og = xb_add(&bar[XB_TOP], 1u);
            const unsigned tg = og / nx;
            if (og + 1u == (tg + 1u) * nx) xb_add(&bar[XB_TOPGEN], 1u);
            else XB_SPIN(xb_ld(&bar[XB_TOPGEN]) == tg, bar);
            __builtin_amdgcn_fence(__ATOMIC_ACQUIRE, XB_SCOPE);
            xb_add(&bar[XB_XGEN(b.x)], 1u);
            asm volatile("s_waitcnt vmcnt(0)" ::: "memory");
        } else {
            XB_SPIN(xb_ld(&bar[XB_XGEN(b.x)]) == gen, bar);
            __builtin_amdgcn_fence(__ATOMIC_ACQUIRE, XB_SCOPE);
            asm volatile("s_waitcnt vmcnt(0)" ::: "memory");
        }
    }
    __syncthreads();
}

constexpr int NWAVES = 8;
constexpr int T = 32768, D = 1024, SEQ = 8192, NBATCH = 4, NLAYER = 4, CHUNK = 128, NCHUNK = T / CHUNK, CPB = SEQ / CHUNK;
constexpr int DINP = 3344, PP = 3328, NPROJ_T = 3584;
constexpr int O_AQ = 0, O_AK = 256, O_AV = 512, O_SU = 768, O_SV = 1024, O_MZ = 1280, O_LQ = 2304, O_LK = 2560, O_LV = 2816, O_LO = 3072;
constexpr int O_XBC = 1536;
constexpr int XC = 768;
constexpr int NEXP = 32, DEXP = 512, MOE_TILES = 288, MOE_ROWS = MOE_TILES * 256;
constexpr float NORM_EPS = 1e-6f;
constexpr float ATT_C2 = 0.125f * 1.4426950408889634f;
constexpr float LOG2E = 1.4426950408889634f;

constexpr size_t MiB = 1u << 20;
constexpr size_t WS_CTL = 0, CTL_ZERO_BYTES = 256 * 1024;
constexpr size_t WS_MOD = 1 * MiB;
constexpr size_t WS_F2 = 2 * MiB;
constexpr size_t WS_SMALL = 3 * MiB;
constexpr size_t WS_TOK = 4 * MiB;
constexpr size_t WS_GATES = 5 * MiB;
constexpr size_t WS_WR = 7 * MiB;
constexpr size_t WS_WIN = 8 * MiB;
constexpr size_t WS_WOUT = 15 * MiB;
constexpr size_t WS_WGU = 17 * MiB;
constexpr size_t WS_WDN = 81 * MiB;
constexpr size_t WS_H = 113 * MiB;
constexpr size_t WS_PROJ = 177 * MiB;
constexpr size_t WS_Y = 385 * MiB;
constexpr size_t WS_XBCC = 449 * MiB;
constexpr size_t WS_SST = 497 * MiB;
constexpr size_t WS_SHIN = 529 * MiB;
constexpr size_t WS_MLS = 545 * MiB;
constexpr size_t WS_MLC = 565 * MiB;
constexpr size_t WS_XB = 575 * MiB;
constexpr size_t WS_ACT = 719 * MiB;
constexpr size_t WS_YB = 791 * MiB;
constexpr size_t WS_XDT = 935 * MiB;
constexpr size_t WS_SLOT = 951 * MiB;
constexpr size_t WS_XRES = 985 * MiB;
constexpr size_t WS_END = 1049 * MiB;
constexpr int CW_TMO = 0, CW_BAR = 4096, CW_QKN = 8192  , CW_Q = 8192 + 1024  , CW_QX = 8192 + 4096  , CW_PAN = 16384  , CW_CVQ = 8192 + 2048  ;
constexpr size_t EXP_ALT = 558 * MiB;
constexpr int RING_BYTES = 131072, MISC_OFF = RING_BYTES + 320, LDS_BYTES = 147456;

#define DI __device__ __forceinline__
typedef unsigned v2u __attribute__((ext_vector_type(2)));
namespace pg8 {
struct EpiProj { static constexpr bool PERM = true, AFTER_DRAIN = false;
    bf16_t* P; float* G;
    __device__ __forceinline__ void operator()(const f32x4 (&acc)[2][2][4][2], const Unit& u, int wr, int wc, int fr, int fq) const {
        const int row0 = u.pm * BM + wr * 64 + fr;
        if (u.pn < 13) {
            const int col0 = u.pn * BM + wc * 32 + 8 * fq;
#pragma unroll
            for (int ai = 0; ai < 2; ++ai)
#pragma unroll
                for (int m = 0; m < 4; ++m) { bf16_t* rowp = P + (size_t)(row0 + ai * HALF + m * 16) * 3328 + col0;
#pragma unroll
                    for (int bj = 0; bj < 2; ++bj) { const f32x4 v0 = acc[ai][bj][m][0], v1 = acc[ai][bj][m][1];
                        u32x4 w; w.x = cvt_pk_bf16(v0[0], v0[1]); w.y = cvt_pk_bf16(v0[2], v0[3]); w.z = cvt_pk_bf16(v1[0], v1[1]); w.w = cvt_pk_bf16(v1[2], v1[3]);
                        *(u32x4*)(rowp + bj * HALF) = w; } }
        } else if (wc == 0 && fq < 2) {
#pragma unroll
            for (int ai = 0; ai < 2; ++ai)
#pragma unroll
                for (int m = 0; m < 4; ++m) { float* gp = G + (size_t)(row0 + ai * HALF + m * 16) * 16 + 8 * fq;
                    *(f32x4*)(gp) = acc[ai][0][m][0]; *(f32x4*)(gp + 4) = acc[ai][0][m][1]; }
        }
    }
};
struct EpiOut { static constexpr bool PERM = true, AFTER_DRAIN = false;
    bf16_t* X; const float* gate;
    __device__ __forceinline__ void operator()(const f32x4 (&acc)[2][2][4][2], const Unit& u, int wr, int wc, int fr, int fq) const {
        const int row0 = u.pm * BM + wr * 64 + fr, col0 = u.pn * BM + wc * 32 + 8 * fq;
        const float* gb = gate + (size_t)((u.pm * BM) >> 13) * 6144 + col0;
        f32x4 gv[2][2];
#pragma unroll
        for (int bj = 0; bj < 2; ++bj)
#pragma unroll
            for (int n = 0; n < 2; ++n) gv[bj][n] = *(const f32x4*)(gb + bj * HALF + n * 4);
#pragma unroll
        for (int ai = 0; ai < 2; ++ai)
#pragma unroll
            for (int m = 0; m < 4; ++m) { bf16_t* rowp = X + (size_t)(row0 + ai * HALF + m * 16) * 1024 + col0;
#pragma unroll
                for (int bj = 0; bj < 2; ++bj) { const u32x4 xr = *(const u32x4*)(rowp + bj * HALF);
                    f32x4 x0, x1; x0[0] = __uint_as_float(xr.x << 16); x0[1] = __uint_as_float(xr.x & 0xffff0000u); x0[2] = __uint_as_float(xr.y << 16); x0[3] = __uint_as_float(xr.y & 0xffff0000u);
                    x1[0] = __uint_as_float(xr.z << 16); x1[1] = __uint_as_float(xr.z & 0xffff0000u); x1[2] = __uint_as_float(xr.w << 16); x1[3] = __uint_as_float(xr.w & 0xffff0000u);
                    x0 = x0 + gv[bj][0] * acc[ai][bj][m][0]; x1 = x1 + gv[bj][1] * acc[ai][bj][m][1];
                    u32x4 w; w.x = cvt_pk_bf16(x0[0], x0[1]); w.y = cvt_pk_bf16(x0[2], x0[3]); w.z = cvt_pk_bf16(x1[0], x1[1]); w.w = cvt_pk_bf16(x1[2], x1[3]);
                    *(u32x4*)(rowp + bj * HALF) = w; } }
    }
};
struct EpiOutNorm { static constexpr bool PERM = false, AFTER_DRAIN = true;
    float* X; const float* gate; const float* w2; const float* shift2; const float* scale2; bf16_t* Hout; float* slots; unsigned* cnt; unsigned* tmo;
    __device__ __forceinline__ void fused(f32x4 (&acc)[2][2][4][2], const Unit& u, int wr, int wc, int fr, int fq, PG8_LAS unsigned char* lds, int wid, int lane) const {
        PG8_LAS float* P = (PG8_LAS float*)lds;
        PG8_LAS float* S = (PG8_LAS float*)(lds + 4096);
        const int row0 = u.pm * BM + wr * 64 + fr, col0 = u.pn * BM + wc * 32 + 4 * fq; const size_t bo = (size_t)((u.pm * BM) >> 13) * 6144;
#pragma unroll
        for (int ai = 0; ai < 2; ++ai)
#pragma unroll
            for (int m = 0; m < 4; ++m) { float* rowp = X + (size_t)(row0 + ai * HALF + m * 16) * 1024 + col0; float ss = 0.f;
#pragma unroll
                for (int bj = 0; bj < 2; ++bj)
#pragma unroll
                    for (int n = 0; n < 2; ++n) { const f32x4 x = *(const f32x4*)(rowp + bj * HALF + n * 16), g = *(const f32x4*)(gate + bo + col0 + bj * HALF + n * 16);
                        const f32x4 v = x + g * acc[ai][bj][m][n]; acc[ai][bj][m][n] = v; *(f32x4*)(rowp + bj * HALF + n * 16) = v; ss += (v[0] * v[0] + v[1] * v[1]) + (v[2] * v[2] + v[3] * v[3]); }
                ss += __int_as_float(__builtin_amdgcn_ds_bpermute((lane ^ 16) << 2, __float_as_int(ss))); ss += __int_as_float(__builtin_amdgcn_ds_bpermute((lane ^ 32) << 2, __float_as_int(ss)));
                if (fq == 0) P[(ai * HALF + wr * 64 + m * 16 + fr) * 4 + wc] = ss; }
        asm volatile("s_waitcnt lgkmcnt(0)" ::: "memory"); __builtin_amdgcn_s_barrier(); asm volatile("" ::: "memory");
        const int row = wid * 32 + (lane & 31);
        if (lane < 32) { const float t = (P[row * 4 + 0] + P[row * 4 + 1]) + (P[row * 4 + 2] + P[row * 4 + 3]);
            __hip_atomic_store((unsigned*)slots + ((size_t)(u.pm * BM + row) * 4 + u.pn), __float_as_uint(t), __ATOMIC_RELAXED, __HIP_MEMORY_SCOPE_AGENT); }
        asm volatile("s_waitcnt vmcnt(0)" ::: "memory");
        if (lane == 0) __hip_atomic_fetch_add(cnt + 64 * u.pm, 1u, __ATOMIC_RELAXED, __HIP_MEMORY_SCOPE_AGENT);
        if (wid == 0) { const unsigned long long t0 = __builtin_amdgcn_s_memrealtime();
            for (;;) { if ((unsigned)__builtin_amdgcn_readfirstlane(__hip_atomic_load(cnt + 64 * u.pm, __ATOMIC_RELAXED, __HIP_MEMORY_SCOPE_AGENT)) >= 32u) break;
                if (__builtin_amdgcn_s_memrealtime() - t0 > 2000000ull) { if (lane == 0) __hip_atomic_store(tmo, 1u, __ATOMIC_RELAXED, __HIP_MEMORY_SCOPE_AGENT); break; }
                __builtin_amdgcn_s_sleep(2); }
            __builtin_amdgcn_fence(__ATOMIC_ACQUIRE, "agent"); }
        asm volatile("s_waitcnt vmcnt(0) lgkmcnt(0)" ::: "memory"); __builtin_amdgcn_s_barrier(); asm volatile("" ::: "memory");
        if (lane < 32) { const unsigned* sl = (const unsigned*)slots + (size_t)(u.pm * BM + row) * 4; float t4[4];
#pragma unroll
            for (int t = 0; t < 4; ++t) t4[t] = __uint_as_float(__hip_atomic_load(sl + t, __ATOMIC_RELAXED, __HIP_MEMORY_SCOPE_AGENT));
            S[row] = rsqrtf(((t4[0] + t4[1]) + (t4[2] + t4[3])) * (1.0f / 1024.0f) + 1e-6f); }
        asm volatile("s_waitcnt lgkmcnt(0)" ::: "memory"); __builtin_amdgcn_s_barrier(); asm volatile("" ::: "memory");
        f32x4 wv[2][2], sc[2][2], sh[2][2];
#pragma unroll
        for (int bj = 0; bj < 2; ++bj)
#pragma unroll
            for (int n = 0; n < 2; ++n) { const int c = col0 + bj * HALF + n * 16; wv[bj][n] = *(const f32x4*)(w2 + c); sc[bj][n] = *(const f32x4*)(scale2 + bo + c) + 1.f; sh[bj][n] = *(const f32x4*)(shift2 + bo + c); wv[bj][n] = wv[bj][n] * sc[bj][n]; }
#pragma unroll
        for (int ai = 0; ai < 2; ++ai)
#pragma unroll
            for (int m = 0; m < 4; ++m) { const int r = ai * HALF + wr * 64 + m * 16 + fr; const float rs = S[r]; bf16_t* hp = Hout + (size_t)(u.pm * BM + r) * 1024 + col0;
#pragma unroll
                for (int bj = 0; bj < 2; ++bj)
#pragma unroll
                    for (int n = 0; n < 2; ++n) { const f32x4 h = acc[ai][bj][m][n] * rs * wv[bj][n] + sh[bj][n];
                        typedef unsigned u32x2 __attribute__((ext_vector_type(2))); u32x2 w; w.x = cvt_pk_bf16(h[0], h[1]); w.y = cvt_pk_bf16(h[2], h[3]);
                        *(u32x2*)(hp + bj * HALF + n * 16) = w; } }
    }
};
struct OneRound { StaticOrder so; int round;
    __device__ __forceinline__ bool next(int i, Unit& u) const { return i == 0 && so.next(round, u); }
    __device__ __forceinline__ void a_ready(const Unit&) const {}
    __device__ __forceinline__ void done(const Unit&) const {}
};
struct EpiGU { static constexpr bool PERM = true, AFTER_DRAIN = false;
    bf16_t* A;
    __device__ __forceinline__ void operator()(const f32x4 (&acc)[2][2][4][2], const Unit& u, int wr, int wc, int fr, int fq) const {
        const int row0 = u.pm * BM + wr * 64 + fr, col0 = (u.pn & 3) * 128 + wc * 16 + 4 * fq;
#pragma unroll
        for (int ai = 0; ai < 2; ++ai)
#pragma unroll
            for (int m = 0; m < 4; ++m) { bf16_t* rowp = A + (size_t)(row0 + ai * HALF + m * 16) * 512 + col0;
#pragma unroll
                for (int bj = 0; bj < 2; ++bj) { const f32x4 g = acc[ai][bj][m][0], up = acc[ai][bj][m][1]; f32x4 a;
#pragma unroll
                    for (int e = 0; e < 4; ++e) a[e] = g[e] * __builtin_amdgcn_rcpf(1.f + __expf(-g[e])) * up[e];
                    typedef unsigned u32x2 __attribute__((ext_vector_type(2)));
                    u32x2 w; w.x = cvt_pk_bf16(a[0], a[1]); w.y = cvt_pk_bf16(a[2], a[3]);
                    *(u32x2*)(rowp + bj * 64) = w; } }
    }
};
struct EpiDown { static constexpr bool PERM = true, AFTER_DRAIN = false;
    bf16_t* Yb;
    __device__ __forceinline__ void operator()(const f32x4 (&acc)[2][2][4][2], const Unit& u, int wr, int wc, int fr, int fq) const {
        const int row0 = u.pm * BM + wr * 64 + fr, col0 = (u.pn & 3) * BM + wc * 32 + 8 * fq;
#pragma unroll
        for (int ai = 0; ai < 2; ++ai)
#pragma unroll
            for (int m = 0; m < 4; ++m) { bf16_t* rowp = Yb + (size_t)(row0 + ai * HALF + m * 16) * 1024 + col0;
#pragma unroll
                for (int bj = 0; bj < 2; ++bj) { const f32x4 v0 = acc[ai][bj][m][0], v1 = acc[ai][bj][m][1];
                    u32x4 w; w.x = cvt_pk_bf16(v0[0], v0[1]); w.y = cvt_pk_bf16(v0[2], v0[3]); w.z = cvt_pk_bf16(v1[0], v1[1]); w.w = cvt_pk_bf16(v1[2], v1[3]);
                    *(u32x4*)(rowp + bj * HALF) = w; } }
    }
};
struct MoeOrder {
    int G, c; const PG8_LAS int* xt;
    __device__ __forceinline__ bool next(int i, Unit& u) const {
        int ul = i * (G >> 3) + (c >> 3);
        if (ul >= xt[4]) return false;
        const int s = (ul >= xt[1] ? 1 : 0) + (ul >= xt[2] ? 1 : 0) + (ul >= xt[3] ? 1 : 0);
        ul -= xt[s];
        u.pm = xt[8 + s] + (ul >> 2); u.pn = 4 * ((c & 7) + 8 * s) + (ul & 3); return true;
    }
    __device__ __forceinline__ void a_ready(const Unit&) const {}
    __device__ __forceinline__ void done(const Unit&) const {}
};
}

DI float bf2f(unsigned b) { return __uint_as_float(b << 16); }
typedef float f32x2h_t __attribute__((ext_vector_type(2))); typedef __bf16 bf16x2h_t __attribute__((ext_vector_type(2)));
DI unsigned pk2h(float lo, float hi) { const f32x2h_t v = {lo, hi}; return __builtin_bit_cast(unsigned, __builtin_convertvector(v, bf16x2h_t)); }
DI float silu_f(float x) { return x * __builtin_amdgcn_rcpf(1.f + __expf(-x)); }
DI float sigmoid_f(float x) { return __builtin_amdgcn_rcpf(1.f + __expf(-x)); }
DI float gelu_tanh_f(float x) { const float z = 0.7978845608028654f * (x + 0.044715f * x * x * x); return x * __builtin_amdgcn_rcpf(1.f + __expf(-2.f * z)); }
DI float log_sigmoid_f(float x) { return fminf(x, 0.f) - log1pf(__expf(-fabsf(x))); }
DI float softplus_f(float x) { return fmaxf(x, 0.f) + log1pf(__expf(-fabsf(x))); }
DI float shx(float v, int o, int lane) { return __int_as_float(__builtin_amdgcn_ds_bpermute((lane ^ o) << 2, __float_as_int(v))); }
DI float shup(float v, int o, int lane) { return __int_as_float(__builtin_amdgcn_ds_bpermute(((lane - o) & 63) << 2, __float_as_int(v))); }
DI float shidx(float v, int src) { return __int_as_float(__builtin_amdgcn_ds_bpermute(src << 2, __float_as_int(v))); }
DI float wave_sum(float v, int lane) {
#pragma unroll
    for (int o = 1; o < 64; o <<= 1) v += shx(v, o, lane);
    return v;
}
DI f32x4 mfma16(bf16x8 a, bf16x8 b, f32x4 c) { asm volatile("s_nop 3" : "+v"(a), "+v"(b)); return __builtin_amdgcn_mfma_f32_16x16x32_bf16(a, b, c, 0, 0, 0); }
#define GL_PIN(x) asm volatile("s_nop 4" : "+v"(x))
#define GL_PIN4(a, b, c, d) asm volatile("s_nop 4" : "+v"(a), "+v"(b), "+v"(c), "+v"(d))
DI void unpack8(const v4u w, float (&x)[8]) {
#pragma unroll
    for (int e = 0; e < 4; ++e) { x[2 * e] = __uint_as_float(w[e] << 16); x[2 * e + 1] = __uint_as_float(w[e] & 0xffff0000u); }
}

struct Frame {
    LAS unsigned char* lds;
    volatile LAS unsigned* MISC;
    gu32* ctl;
    int tid, lane, wave, vcu, G, bx, l; size_t z;
    float* out; unsigned char* ws;
};
constexpr int PTRTAB_OFF = 131072 + 2048;
DI const float* inp(const Frame& F, int i) {
    const LAS unsigned* t = (const LAS unsigned*)(F.lds + PTRTAB_OFF) + 2 * i;
    const unsigned lo = __builtin_amdgcn_readfirstlane(t[0]), hi = __builtin_amdgcn_readfirstlane(t[1]);
    return (const float*)(const GAS float*)(((unsigned long long)hi << 32) | lo);
}
enum { I_X = 0, I_C, I_WIN, I_WOUT, I_MIXG, I_AFB, I_SGW, I_SGB, I_CONVW, I_CONVB, I_DTB, I_ALOG, I_DSKIP, I_IB, I_FB, I_WADA, I_BADA, I_WN1, I_WN2, I_WRG, I_BRG, I_WRE, I_BRE, I_WEG, I_WEU, I_WED, I_WNF };

DI void refresh(Frame& F) { int t_ = F.tid; asm volatile("" : "+v"(t_)); F.tid = t_; F.lane = t_ & 63; F.wave = __builtin_amdgcn_readfirstlane(t_ >> 6); size_t z_ = 0; unsigned zl_ = 0; asm volatile("" : "+s"(z_), "+s"(zl_)); F.ws = F.ws + z_; F.lds = F.lds + zl_; }
DI void tile_g2l(LAS bf16* dst, int lp, const bf16* src, size_t gp, int rows, int cols, int tid) {
    const int cpr = cols >> 3, n = rows * cpr;
    if (n % (4 * NWAVES * 64) == 0) {
        for (int i0 = tid; i0 < n; i0 += 4 * NWAVES * 64) { v4u t[4];
#pragma unroll
            for (int j = 0; j < 4; ++j) { const int i = i0 + j * NWAVES * 64, r = i / cpr, c = (i % cpr) * 8; t[j] = *(const v4u*)(src + (size_t)r * gp + c); }
#pragma unroll
            for (int j = 0; j < 4; ++j) { const int i = i0 + j * NWAVES * 64, r = i / cpr, c = (i % cpr) * 8; *(LAS v4u*)(dst + r * lp + c) = t[j]; } }
        return; }
    for (int i = tid; i < n; i += NWAVES * 64) { const int r = i / cpr, c = (i % cpr) * 8; *(LAS v4u*)(dst + r * lp + c) = *(const v4u*)(src + (size_t)r * gp + c); }
}
DI void tile_l2g(bf16* dst, size_t gp, const LAS bf16* src, int lp, int rows, int cols, int tid) {
    const int cpr = cols >> 3, n = rows * cpr;
    for (int i = tid; i < n; i += NWAVES * 64) { const int r = i / cpr, c = (i % cpr) * 8; *(v4u*)(dst + (size_t)r * gp + c) = *(const LAS v4u*)(src + r * lp + c); }
}
template <bool IS_MAX> DI float scan128(float x, int tid, LAS float* red) {
    const int lane = tid & 63;
#pragma unroll
    for (int o = 1; o < 64; o <<= 1) { const float y = shup(x, o, lane); if (lane >= o) x = IS_MAX ? fmaxf(x, y) : x + y; }
    if (tid == 63) red[0] = x;
    __syncthreads();
    if (tid >= 64 && tid < 128) { const float p = red[0]; x = IS_MAX ? fmaxf(x, p) : x + p; }
    __syncthreads();
    return x;
}

DI void p_mod(Frame& F) {
    LAS float* SC = (LAS float*)F.lds;
    LAS float* RED = SC + 4096;
    const float* c = inp(F, I_C);
    for (int i = F.tid; i < 4096; i += 512) SC[i] = silu_f(c[i]);
    __syncthreads();
    float* mod = (float*)(F.ws + WS_MOD);
    const int jj = F.tid & 63, kg = F.tid >> 6;
    for (int u = F.bx; u < NLAYER * 96; u += F.G) {
        const int l = u / 96, j0 = (u % 96) * 64;
        const float* w = inp(F, I_WADA) + ((size_t)l * 1024 + kg * 128) * 6144 + j0 + jj;
        float a0 = 0.f, a1 = 0.f, a2 = 0.f, a3 = 0.f;
#pragma unroll 16
        for (int k = 0; k < 128; ++k) { const float wv = __builtin_nontemporal_load(w + (size_t)k * 6144); const int kk = kg * 128 + k; a0 += SC[kk] * wv; a1 += SC[1024 + kk] * wv; a2 += SC[2048 + kk] * wv; a3 += SC[3072 + kk] * wv; }
        RED[(kg * 4 + 0) * 64 + jj] = a0; RED[(kg * 4 + 1) * 64 + jj] = a1; RED[(kg * 4 + 2) * 64 + jj] = a2; RED[(kg * 4 + 3) * 64 + jj] = a3;
        __syncthreads();
        if (F.tid < 256) { const int b = F.tid >> 6; float s = inp(F, I_BADA)[(size_t)l * 6144 + j0 + jj];
#pragma unroll
            for (int g = 0; g < 8; ++g) s += RED[(g * 4 + b) * 64 + jj];
            mod[((size_t)l * 4 + b) * 6144 + j0 + jj] = s; }
        __syncthreads();
    }
}

struct CvItem { const float* gp; size_t N; bf16* WT; int d0, K, k0; float sc; };
DI void cv_load(const CvItem& d, int lane, f32x4 (&v)[16]) {
    const int kp = lane >> 4;
#pragma unroll
    for (int i = 0; i < 8; ++i) { const int p = 4 * i + kp; v[2 * i] = (f32x4){0.f, 0.f, 0.f, 0.f}; v[2 * i + 1] = v[2 * i];
        if (d.gp) { v[2 * i] = __builtin_nontemporal_load((const f32x4*)(d.gp + (size_t)(d.k0 + 2 * p) * d.N)); v[2 * i + 1] = __builtin_nontemporal_load((const f32x4*)(d.gp + (size_t)(d.k0 + 2 * p + 1) * d.N)); } }
}
DI void cv_finish(const CvItem& d, const f32x4 (&v)[16], LAS unsigned* scr, int lane) {
    const int kp = lane >> 4, gi = lane & 15;
#pragma unroll
    for (int i = 0; i < 8; ++i) { const int p = 4 * i + kp;
#pragma unroll
        for (int e = 0; e < 4; ++e) scr[(4 * gi + e) * 33 + p] = pk2h(v[2 * i][e] * d.sc, v[2 * i + 1][e] * d.sc); }
    LDS_WAIT(); asm volatile("" ::: "memory");
    const int c = lane & 7;
#pragma unroll
    for (int j = 0; j < 8; ++j) { const int n = (lane >> 3) + 8 * j; const LAS unsigned* s = scr + n * 33 + 4 * c;
        v4u o; o.x = s[0]; o.y = s[1]; o.z = s[2]; o.w = s[3];
        __builtin_nontemporal_store(o, (GAS v4u*)(d.WT + (size_t)(d.d0 + n) * d.K + d.k0 + 8 * c)); }
    LDS_WAIT(); asm volatile("" ::: "memory");
}
constexpr int CV_IN = 13 * 4 * 16, CV_INS = 16, CV_OUT = 256, CV_R = 16, CV_DENSE = CV_IN + CV_INS + CV_OUT + CV_R, CV_GU = 32 * 256, CV_DN = 32 * 128, CV_EXP = CV_GU + CV_DN, CV_WIN = CV_IN + CV_INS, CV_ALL = CV_DENSE + CV_EXP;
DI CvItem cv_decode(Frame& F, int l, int it, int gi) {
    int r = it;
    if (r < CV_IN) { const int tile = r >> 6, blk = (r >> 4) & 3, kb = r & 15;
        const int so = tile == 0 ? 0 : tile == 1 ? 256 : tile == 2 ? 512 : tile == 3 ? 772 : tile == 4 ? 1028 : tile == 5 ? 1284 : tile == 6 ? 1540 : tile == 7 ? 1796 : tile == 8 ? 2052 : tile == 9 ? 2312 : tile == 10 ? 2568 : tile == 11 ? 2824 : 3080;
        return CvItem{inp(F, I_WIN) + (size_t)l * 1024 * DINP + so + blk * 64 + 4 * gi, DINP, (bf16*)(F.ws + WS_WIN), tile * 256 + blk * 64, 1024, kb * 64, tile == 0 ? ATT_C2 : 1.f}; }
    r -= CV_IN;
    if (r < CV_INS) { const int col = gi == 0 ? 768 : gi == 1 ? 2308 : gi == 2 ? 3336 : gi == 3 ? 3340 : -1;
        return CvItem{col >= 0 ? inp(F, I_WIN) + (size_t)l * 1024 * DINP + col : nullptr, DINP, (bf16*)(F.ws + WS_WIN), 3328, 1024, r * 64, 1.f}; }
    r -= CV_INS;
    if (r < CV_OUT) { const int blk = r >> 4, kb = r & 15;
        return CvItem{inp(F, I_WOUT) + (size_t)l * 1024 * 1024 + blk * 64 + 4 * gi, 1024, (bf16*)(F.ws + WS_WOUT), blk * 64, 1024, kb * 64, 1.f}; }
    r -= CV_OUT;
    if (r < CV_R) { const float* cp = gi == 0 ? inp(F, I_WRG) + (size_t)l * 1024 * 4 : gi <= 8 ? inp(F, I_WRE) + (size_t)l * 1024 * 32 + 4 * (gi - 1) : nullptr;
        return CvItem{cp, (size_t)(gi == 0 ? 4 : 32), (bf16*)(F.ws + WS_WR), 0, 1024, r * 64, 1.f}; }
    r -= CV_R;
    if (r < CV_GU) { const int e = r >> 8, blk = (r >> 4) & 15, kb = r & 15, rr = blk * 64 + 4 * gi, j = rr >> 8, cc = rr & 255;
        const int which = (cc >> 2) & 1, uu = 128 * j + 64 * (cc >> 7) + ((cc & 127) >> 3) * 4;
        return CvItem{(which ? inp(F, I_WEU) : inp(F, I_WEG)) + ((size_t)(l * 32 + e) * 1024) * 512 + uu, 512, (bf16*)(F.ws + WS_WGU + (size_t)(l & 1) * EXP_ALT) + (size_t)e * 1024 * 1024, blk * 64, 1024, kb * 64, 1.f}; }
    r -= CV_GU;
    { const int e = r >> 7, blk = (r >> 3) & 15, kb = r & 7;
        return CvItem{inp(F, I_WED) + ((size_t)(l * 32 + e) * 512) * 1024 + blk * 64 + 4 * gi, 1024, (bf16*)(F.ws + WS_WDN + (size_t)(l & 1) * EXP_ALT) + (size_t)e * 1024 * 512, blk * 64, 512, kb * 64, 1.f}; }
}
DI void p_convert(Frame& F, int l, int n0, int n1, int gw = -1, int NGW = 0) {
    LAS unsigned* scr = (LAS unsigned*)(F.lds + F.wave * 16384);
    if (gw < 0) { gw = F.vcu * NWAVES + F.wave; NGW = F.G * NWAVES; }
    const int gi = F.lane & 15;
    int it = n0 + gw; if (it >= n1) return;
    CvItem da = cv_decode(F, l, it, gi), db = da; f32x4 va[16], vb[16]; cv_load(da, F.lane, va);
    _Pragma("unroll 1") for (;;) {
        { const int nx = it + NGW; const bool more = nx < n1;
          if (more) { db = cv_decode(F, l, nx, gi); cv_load(db, F.lane, vb); }
          cv_finish(da, va, scr, F.lane);
          if (!more) break;
          it = nx; }
        { const int nx = it + NGW; const bool more = nx < n1;
          if (more) { da = cv_decode(F, l, nx, gi); cv_load(da, F.lane, va); }
          cv_finish(db, vb, scr, F.lane);
          if (!more) break;
          it = nx; }
    }
}

DI void p_convert_np(Frame& F, int l, int n0, int n1, int gw, int NGW) {
    LAS unsigned* scr = (LAS unsigned*)(F.lds + F.wave * 16384);
    const int gi = F.lane & 15;
    _Pragma("unroll 1") for (int it = n0 + gw; it < n1; it += NGW) { CvItem da = cv_decode(F, l, it, gi); f32x4 va[16]; cv_load(da, F.lane, va); cv_finish(da, va, scr, F.lane); }
}

DI int cvq_grab(gu32* ctr, int lane) { unsigned v = 0u; if (lane == 0) v = __hip_atomic_fetch_add(ctr, 1u, __ATOMIC_RELAXED, __HIP_MEMORY_SCOPE_AGENT); return (int)__builtin_amdgcn_readfirstlane(v); }
DI void p_convert_q(Frame& F, int lconv, gu32* ctr, int cap) {
    LAS unsigned* scr = (LAS unsigned*)(F.lds + F.wave * 16384);
    const int gi = F.lane & 15;
    int it = cvq_grab(ctr, F.lane); if (it >= CV_EXP) return;
    CvItem da = cv_decode(F, lconv, CV_DENSE + it, gi); f32x4 va[16]; cv_load(da, F.lane, va);
    int ndone = 1;
    for (;;) {
        const int nx = (cap < 0 || ndone < cap) ? cvq_grab(ctr, F.lane) : CV_EXP; const bool more = nx < CV_EXP;
        CvItem db = da; f32x4 vb[16];
#pragma unroll
        for (int i = 0; i < 16; ++i) vb[i] = va[i];
        if (more) { db = cv_decode(F, lconv, CV_DENSE + nx, gi); cv_load(db, F.lane, vb); }
        cv_finish(da, va, scr, F.lane);
        if (!more) break;
        da = db; ++ndone;
#pragma unroll
        for (int i = 0; i < 16; ++i) va[i] = vb[i];
    }
}

template <int MODE> DI void p_norm(Frame& F, const void* xin, const bool xbf, int comb_l, bf16* xout, const float* wn, const float* shift, const float* scale, bf16* hout, float* fout, const int blk = -1) {
    const int gw0 = F.vcu * NWAVES + F.wave; const int gw = blk < 0 ? gw0 : blk * 128 + F.wave * 16, NGW = blk < 0 ? F.G * NWAVES : 1, TE = blk < 0 ? T : blk * 128 + F.wave * 16 + 16;
    const float* mod = (const float*)(F.ws + WS_MOD);
    const int* tokd = (const int*)(F.ws + WS_TOK + 768 * 1024); const float* tokw = (const float*)(F.ws + WS_TOK + 512 * 1024);
#ifdef DIAG_COMB_XB
    const bf16* yb = (const bf16*)(F.ws + WS_XB);
#else
    const bf16* yb = (const bf16*)(F.ws + WS_YB);
#endif
    const bool comb = comb_l >= 0;
    f32x4 wv[4];
#pragma unroll
    for (int j = 0; j < 4; ++j) wv[j] = *((const f32x4*)wn + F.lane + 64 * j);
    struct Tok { v2u d, w; };
    struct Row { v2u xb[4]; f32x4 xf[4]; v2u ya[4], yc[4]; };
    auto ld_tok = [&](const int m, Tok& t) { t.d = *(const v2u*)(tokd + 2 * m); t.w = *(const v2u*)((const unsigned*)tokw + 2 * m); };
    auto ld_row = [&](const int m, const Tok& t, Row& R) {
        if (xbf) { const GAS v2u* xr = (const GAS v2u*)((const bf16*)xin + (size_t)m * D) + F.lane;
#pragma unroll
            for (int j = 0; j < 4; ++j) R.xb[j] = __builtin_nontemporal_load(xr + 64 * j);
        } else { const GAS f32x4* xr = (const GAS f32x4*)((const float*)xin + (size_t)m * D) + F.lane;
#pragma unroll
            for (int j = 0; j < 4; ++j) R.xf[j] = __builtin_nontemporal_load(xr + 64 * j); }
        if (comb) {
#pragma unroll
            for (int j = 0; j < 4; ++j) { R.ya[j] = __builtin_nontemporal_load((const v2u*)(yb + (size_t)t.d[0] * 1024) + F.lane + 64 * j); R.yc[j] = __builtin_nontemporal_load((const v2u*)(yb + (size_t)t.d[1] * 1024) + F.lane + 64 * j); } } };
    Tok tA, tB; Row RA;
    tA.d = (v2u){0u, 0u}; tA.w = tA.d; tB = tA;
    if (gw < TE) { if (comb) { ld_tok(gw, tA); if (gw + NGW < TE) ld_tok(gw + NGW, tB); } ld_row(gw, tA, RA); }
    for (int m = gw; m < TE; m += NGW) {
        Row RN; Tok tN; tN.d = (v2u){0u, 0u}; tN.w = tN.d;
        if (m + NGW < TE) { ld_row(m + NGW, tB, RN); if (comb && m + 2 * NGW < TE) ld_tok(m + 2 * NGW, tN); }
        const int b = m >> 13;
        f32x4 v[4];
        if (xbf) {
#pragma unroll
            for (int j = 0; j < 4; ++j) { const v2u a = RA.xb[j];
                v[j][0] = __uint_as_float(a[0] << 16); v[j][1] = __uint_as_float(a[0] & 0xffff0000u); v[j][2] = __uint_as_float(a[1] << 16); v[j][3] = __uint_as_float(a[1] & 0xffff0000u); }
        } else {
#pragma unroll
            for (int j = 0; j < 4; ++j) v[j] = RA.xf[j];
        }
        if (comb) {
            const float w0 = __uint_as_float(tA.w[0]), w1 = __uint_as_float(tA.w[1]);
            const float* g2 = mod + ((size_t)comb_l * 4 + b) * 6144 + 5 * 1024;
#pragma unroll
            for (int j = 0; j < 4; ++j) { const v2u a = RA.ya[j], c = RA.yc[j];
                const f32x4 g = *((const f32x4*)g2 + F.lane + 64 * j);
                f32x4 y; y[0] = w0 * bf2f(a[0] & 0xffffu) + w1 * bf2f(c[0] & 0xffffu); y[1] = w0 * bf2f(a[0] >> 16) + w1 * bf2f(c[0] >> 16); y[2] = w0 * bf2f(a[1] & 0xffffu) + w1 * bf2f(c[1] & 0xffffu); y[3] = w0 * bf2f(a[1] >> 16) + w1 * bf2f(c[1] >> 16);
                v[j] = v[j] + g * y; }
        }
        if (xout) { GAS v2u* xo = (GAS v2u*)(xout + (size_t)m * D) + F.lane;
#pragma unroll
            for (int j = 0; j < 4; ++j) { v2u o; o[0] = pk2h(v[j][0], v[j][1]); o[1] = pk2h(v[j][2], v[j][3]); __builtin_nontemporal_store(o, xo + 64 * j); } }
        float s = 0.f;
#pragma unroll
        for (int j = 0; j < 4; ++j) s += (v[j][0] * v[j][0] + v[j][1] * v[j][1]) + (v[j][2] * v[j][2] + v[j][3] * v[j][3]);
        const float rstd = rsqrtf(wave_sum(s, F.lane) * (1.f / D) + NORM_EPS);
        if (MODE == 0) {
            const float* sh = shift + (size_t)b * 6144; const float* sc = scale + (size_t)b * 6144;
            GAS v2u* o8 = (GAS v2u*)(hout + (size_t)m * D) + F.lane;
#pragma unroll
            for (int j = 0; j < 4; ++j) { const f32x4 a = *((const f32x4*)sc + F.lane + 64 * j), c = *((const f32x4*)sh + F.lane + 64 * j);
                const f32x4 h = v[j] * rstd * wv[j] * (a + 1.f) + c; v2u o; o[0] = pk2h(h[0], h[1]); o[1] = pk2h(h[2], h[3]); o8[64 * j] = o; }
        } else {
            GAS f32x4* o = (GAS f32x4*)(fout + (size_t)m * D) + F.lane;
#pragma unroll
            for (int j = 0; j < 4; ++j) o[64 * j] = v[j] * rstd * wv[j];
        }
        RA = RN; tA = tB; tB = tN;
    }
}

template <bool IS_MAX> DI float scan128x2(float x, int tid, LAS float* red) {
    const int lane = tid & 63, wave = tid >> 6;
#pragma unroll
    for (int o = 1; o < 64; o <<= 1) { const float y = shup(x, o, lane); if (lane >= o) x = IS_MAX ? fmaxf(x, y) : x + y; }
    if (lane == 63 && wave < 4 && (wave & 1) == 0) red[wave >> 1] = x;
    __syncthreads();
    if (wave < 4 && (wave & 1)) { const float p = red[wave >> 1]; x = IS_MAX ? fmaxf(x, p) : x + p; }
    __syncthreads();
    return x;
}
constexpr int LP = 136;
constexpr int LP64 = 72;
constexpr int TILE128 = 128 * LP * 2;

DI void fscan_unit(Frame& F, int l, int bh) {
    refresh(F);
    LAS float* WT = (LAS float*)F.lds;
    const int b = bh >> 2, h = bh & 3; const float bias = inp(F, I_AFB)[l * 4 + h];
    const float* g = (const float*)(F.ws + WS_GATES) + ((size_t)b * SEQ + 16 * F.tid) * 16 + h;
    float v[16]; float run = 0.f;
#pragma unroll
    for (int i = 0; i < 16; ++i) { run += log_sigmoid_f(g[i * 16] + bias); v[i] = run; }
    float x = run;
#pragma unroll
    for (int o = 1; o < 64; o <<= 1) { const float y = shup(x, o, F.lane); if (F.lane >= o) x += y; }
    if (F.lane == 63) WT[F.wave] = x;
    __syncthreads();
    float pre = 0.f;
    for (int w = 0; w < F.wave; ++w) pre += WT[w];
    const float excl = x - run + pre;
    float* o = (float*)(F.ws + WS_F2) + (size_t)bh * SEQ + 16 * F.tid;
#pragma unroll
    for (int i = 0; i < 16; ++i) o[i] = (v[i] + excl) * LOG2E;
    __syncthreads();
}

DI void qknorm_unit(Frame& F, int u, gu32* qkn) {
    refresh(F);
    const int bh = u >> 4, seg = u & 15, b = bh >> 2, h = bh & 3;
    const bf16* proj = (const bf16*)(F.ws + WS_PROJ);
    float qm = 0.f, km = 0.f;
#pragma unroll
    for (int i = 0; i < 1; ++i) { const size_t row = (size_t)b * SEQ + seg * 512 + F.tid + i; float qs = 0.f, ks = 0.f;
#pragma unroll
        for (int c = 0; c < 8; ++c) { float x[8];
            unpack8(*(const v4u*)(proj + row * PP + O_AQ + h * 64 + 8 * c), x);
#pragma unroll
            for (int e = 0; e < 8; ++e) qs += x[e] * x[e];
            unpack8(*(const v4u*)(proj + row * PP + O_AK + h * 64 + 8 * c), x);
#pragma unroll
            for (int e = 0; e < 8; ++e) ks += x[e] * x[e]; }
        qm = fmaxf(qm, qs); km = fmaxf(km, ks); }
#pragma unroll
    for (int o = 1; o < 64; o <<= 1) { qm = fmaxf(qm, shx(qm, o, F.lane)); km = fmaxf(km, shx(km, o, F.lane)); }
    if (F.lane == 0) { __hip_atomic_fetch_max(qkn + 2 * bh, __float_as_uint(qm), __ATOMIC_RELAXED, __HIP_MEMORY_SCOPE_AGENT); __hip_atomic_fetch_max(qkn + 2 * bh + 1, __float_as_uint(km), __ATOMIC_RELAXED, __HIP_MEMORY_SCOPE_AGENT); }
}

template <bool IS_MAX> DI void wscan2(float& x0, float& x1, int lane) {
    x1 = IS_MAX ? fmaxf(x0, x1) : x0 + x1;
    float s = x1;
#pragma unroll
    for (int o = 1; o < 64; o <<= 1) { const float y = shup(s, o, lane); if (lane >= o) s = IS_MAX ? fmaxf(s, y) : s + y; }
    const float ex = shup(s, 1, lane);
    if (lane > 0) { x0 = IS_MAX ? fmaxf(x0, ex) : x0 + ex; x1 = IS_MAX ? fmaxf(x1, ex) : x1 + ex; }
}
template <bool BAR = true> DI void ssd_vectors(Frame& F, int l, int t0, int g, LAS float* DT, LAS float* AC, LAS float* RED) {
    (void)RED;
    if (F.wave < 2) {
        const int r2 = F.wave, head = 2 * g + r2, s0 = 2 * F.lane; const float* gp = (const float*)(F.ws + WS_GATES) + (size_t)(t0 + s0) * 16 + 4 + head;
        const float db = inp(F, I_DTB)[l * 4 + head], na = -__expf(inp(F, I_ALOG)[l * 4 + head]);
        const float d0 = softplus_f(gp[0] + db), d1 = softplus_f(gp[16] + db); float a0 = na * d0, a1 = na * d1;
        wscan2<false>(a0, a1, F.lane);
        DT[r2 * 128 + s0] = d0; DT[r2 * 128 + s0 + 1] = d1; AC[r2 * 128 + s0] = a0; AC[r2 * 128 + s0 + 1] = a1; }
    if (BAR) __syncthreads();
}
DI void ssd_local_unit(Frame& F, int l, int ch, int g) {
    refresh(F);
    LAS bf16* XWT = (LAS bf16*)F.lds; LAS bf16* BT = XWT + 128 * LP; LAS bf16* XD = BT + 128 * LP;
    LAS float* DT = (LAS float*)(F.lds + 3 * TILE128); LAS float* AC = DT + 256; LAS float* RED = AC + 256;
    const int t0 = ch * CHUNK, cpos = ch & (CPB - 1);
    const bf16* proj = (const bf16*)(F.ws + WS_PROJ); bf16* xbcc = (bf16*)(F.ws + WS_XBCC);
    const float* cw = inp(F, I_CONVW) + (size_t)l * 4 * XC; const float* cb = inp(F, I_CONVB) + (size_t)l * XC;
    const int s = F.tid >> 2, cg = F.tid & 3;
    float okm[4]; int spc[4];
#pragma unroll
    for (int j = 0; j < 4; ++j) { const int sp = s - 3 + j; const bool ok = cpos * CHUNK + sp >= 0; okm[j] = ok ? 1.f : 0.f; spc[j] = ok ? sp : s; }
    auto load_part = [&](const int part, v4u (&raw)[4][4]) {
#pragma unroll
        for (int cc = 0; cc < 4; ++cc)
#pragma unroll
            for (int j = 0; j < 4; ++j) raw[cc][j] = *(const v4u*)(proj + (size_t)(t0 + spc[j]) * PP + O_XBC + part * 256 + g * 128 + cg * 32 + cc * 8); };
    auto do_part = [&](const int part, const v4u (&raw)[4][4]) {
#pragma unroll
        for (int cc = 0; cc < 4; ++cc) {
            const int lc = cg * 32 + cc * 8, c0 = part * 256 + g * 128 + lc;
            float acc[8];
            { const f32x4 b0 = *(const f32x4*)(cb + c0), b1 = *(const f32x4*)(cb + c0 + 4);
#pragma unroll
              for (int e = 0; e < 4; ++e) { acc[e] = b0[e]; acc[4 + e] = b1[e]; } }
#pragma unroll
            for (int j = 0; j < 4; ++j) { float x[8]; unpack8(raw[cc][j], x);
                const f32x4 w0 = *(const f32x4*)(cw + j * XC + c0), w1 = *(const f32x4*)(cw + j * XC + c0 + 4);
#pragma unroll
                for (int e = 0; e < 4; ++e) { acc[e] += w0[e] * okm[j] * x[e]; acc[4 + e] += w1[e] * okm[j] * x[4 + e]; } }
#pragma unroll
            for (int e = 0; e < 8; ++e) acc[e] = silu_f(acc[e]);
            v4u o; o.x = pk2h(acc[0], acc[1]); o.y = pk2h(acc[2], acc[3]); o.z = pk2h(acc[4], acc[5]); o.w = pk2h(acc[6], acc[7]);
            *(v4u*)(xbcc + (size_t)(t0 + s) * XC + c0) = o;
            if (part == 0) { const int r2 = lc >> 6; const float dtv = DT[r2 * 128 + s], sc = dtv * __expf(AC[r2 * 128 + 127] - AC[r2 * 128 + s]);
#pragma unroll
                for (int e = 0; e < 8; ++e) { XWT[(lc + e) * LP + s] = (bf16)f2bf(acc[e] * sc); XD[(lc + e) * LP + s] = (bf16)f2bf(acc[e] * dtv); } }
            else if (part == 1) {
#pragma unroll
                for (int e = 0; e < 8; ++e) BT[(lc + e) * LP + s] = (bf16)f2bf(acc[e]); }
        } };
    v4u ra[4][4], rb[4][4];
    load_part(1, ra);
    ssd_vectors<false>(F, l, t0, g, DT, AC, RED);
    load_part(2, rb);
    do_part(1, ra);
    load_part(0, ra);
    do_part(2, rb);
    __syncthreads();
    do_part(0, ra);
    __syncthreads();
    const int w = F.wave, r = F.lane & 15, q = F.lane >> 4;
    f32x4 acc[8];
#pragma unroll
    for (int nt = 0; nt < 8; ++nt) acc[nt] = (f32x4){0.f, 0.f, 0.f, 0.f};
#pragma unroll
    for (int ks = 0; ks < 4; ++ks) { const bf16x8 a = *(const LAS bf16x8*)(XWT + (16 * w + r) * LP + 32 * ks + 8 * q);
#pragma unroll
        for (int nt = 0; nt < 8; ++nt) { const bf16x8 b = *(const LAS bf16x8*)(BT + (16 * nt + r) * LP + 32 * ks + 8 * q); acc[nt] = mfma16(a, b, acc[nt]); } }
    float* sst = (float*)(F.ws + WS_SST);
#pragma unroll
    for (int jj = 0; jj < 4; ++jj) { const int row = 16 * w + 4 * q + jj, head = 2 * g + (row >> 6), p = row & 63;
        float* o = sst + ((size_t)(ch * 4 + head) * 64 + p) * 128 + r;
#pragma unroll
        for (int nt = 0; nt < 8; ++nt) o[16 * nt] = acc[nt][jj]; }
    if (F.tid < 2) ((float*)(F.ws + WS_SMALL))[ch * 4 + 2 * g + F.tid] = __expf(AC[F.tid * 128 + 127]);
    tile_l2g((bf16*)(F.ws + WS_XDT) + (size_t)(ch * 2 + g) * 128 * 128, 128, XD, LP, 128, 128, F.tid);
    __syncthreads();
}
DI void ssd_out_unit(Frame& F, int l, int ch, int g) {
    refresh(F);
    LAS bf16* CL = (LAS bf16*)F.lds; LAS bf16* BL = CL + 128 * LP; LAS bf16* GL = BL + 128 * LP;
    LAS float* DT = (LAS float*)(F.lds + 3 * TILE128); LAS float* AC = DT + 256; LAS float* RED = AC + 256;
    const int t0 = ch * CHUNK;
    const bf16* xbcc = (const bf16*)(F.ws + WS_XBCC); const bf16* proj = (const bf16*)(F.ws + WS_PROJ);
    tile_g2l(CL, LP, xbcc + (size_t)t0 * XC + 512 + g * 128, XC, 128, 128, F.tid);
    tile_g2l(BL, LP, xbcc + (size_t)t0 * XC + 256 + g * 128, XC, 128, 128, F.tid);
    ssd_vectors(F, l, t0, g, DT, AC, RED);
    __syncthreads();
    const int w = F.wave, r = F.lane & 15, q = F.lane >> 4, wlim = w | 1, t_own = 16 * w + r;
    const float* gain = inp(F, I_MIXG) + (size_t)l * 1024 + 512;
    const bf16* hin = (const bf16*)(F.ws + WS_SHIN); const bf16* xdt = (const bf16*)(F.ws + WS_XDT) + (size_t)(ch * 2 + g) * 128 * 128;
    v2u po[2][4][2];
#pragma unroll
    for (int r2 = 0; r2 < 2; ++r2) {
        const int head = 2 * g + r2; const LAS float* ac = AC + r2 * 128;
        bf16x8 hb[4][4];
#pragma unroll
        for (int ks = 0; ks < 4; ++ks)
#pragma unroll
            for (int pt = 0; pt < 4; ++pt) hb[ks][pt] = *(const bf16x8*)(hin + ((size_t)(ch * 4 + head) * 64 + 16 * pt + r) * 128 + 32 * ks + 8 * q);
        bf16x8 xb[4][4];
#pragma unroll
        for (int ks = 0; ks < 4; ++ks)
#pragma unroll
            for (int pt = 0; pt < 4; ++pt) { if (ks <= (w >> 1)) xb[ks][pt] = *(const bf16x8*)(xdt + (size_t)(64 * r2 + 16 * pt + r) * 128 + 32 * ks + 8 * q); else xb[ks][pt] = (bf16x8){0, 0, 0, 0, 0, 0, 0, 0}; }
        bf16 xsr[4][4], zr[4][4];
#pragma unroll
        for (int pt = 0; pt < 4; ++pt)
#pragma unroll
            for (int jj = 0; jj < 4; ++jj) { const int t = 16 * w + 4 * q + jj, p = 16 * pt + r;
                xsr[pt][jj] = xbcc[(size_t)(t0 + t) * XC + g * 128 + r2 * 64 + p]; zr[pt][jj] = proj[(size_t)(t0 + t) * PP + O_MZ + head * 64 + p]; }
        { const float at = ac[t_own];
          for (int st = 0; st <= wlim; ++st) { f32x4 c = (f32x4){0.f, 0.f, 0.f, 0.f};
#pragma unroll
              for (int ks = 0; ks < 4; ++ks) { const bf16x8 a = *(const LAS bf16x8*)(BL + (16 * st + r) * LP + 32 * ks + 8 * q), b = *(const LAS bf16x8*)(CL + (16 * w + r) * LP + 32 * ks + 8 * q); c = mfma16(a, b, c); }
              float gv[4];
#pragma unroll
              for (int jj = 0; jj < 4; ++jj) { const int s = 16 * st + 4 * q + jj; gv[jj] = (s <= t_own) ? c[jj] * __expf(at - ac[s]) : 0.f; }
              v2u o; o[0] = pk2h(gv[0], gv[1]); o[1] = pk2h(gv[2], gv[3]);
              *(LAS v2u*)(GL + t_own * LP + 16 * st + 4 * q) = o; } }
        f32x4 acc[4], accb[4];
#pragma unroll
        for (int pt = 0; pt < 4; ++pt) { acc[pt] = (f32x4){0.f, 0.f, 0.f, 0.f}; accb[pt] = (f32x4){0.f, 0.f, 0.f, 0.f}; }
#pragma unroll
        for (int ks = 0; ks < 4; ++ks) if (ks <= (w >> 1)) { const bf16x8 a = *(const LAS bf16x8*)(GL + (16 * w + r) * LP + 32 * ks + 8 * q);
            GL_PIN4(xb[ks][0], xb[ks][1], xb[ks][2], xb[ks][3]);
#pragma unroll
            for (int pt = 0; pt < 4; ++pt) acc[pt] = mfma16(a, xb[ks][pt], acc[pt]); }
#pragma unroll
        for (int ks = 0; ks < 4; ++ks) GL_PIN4(hb[ks][0], hb[ks][1], hb[ks][2], hb[ks][3]);
#pragma unroll
        for (int ks = 0; ks < 4; ++ks) { const bf16x8 a = *(const LAS bf16x8*)(CL + (16 * w + r) * LP + 32 * ks + 8 * q);
#pragma unroll
            for (int pt = 0; pt < 4; ++pt) accb[pt] = mfma16(a, hb[ks][pt], accb[pt]); }
        const float dsk = inp(F, I_DSKIP)[l * 4 + head];
        float ss[4] = {0.f, 0.f, 0.f, 0.f};
#pragma unroll
        for (int pt = 0; pt < 4; ++pt)
#pragma unroll
            for (int jj = 0; jj < 4; ++jj) { const int t = 16 * w + 4 * q + jj, p = 16 * pt + r;
                const float xs = bf2f(xsr[pt][jj]), z = bf2f(zr[pt][jj]); (void)p;
                float y = acc[pt][jj] + __expf(ac[t]) * accb[pt][jj] + dsk * xs; y *= silu_f(z); acc[pt][jj] = y; ss[jj] += y * y; }
#pragma unroll
        for (int jj = 0; jj < 4; ++jj) { float v = ss[jj]; v += shx(v, 1, F.lane); v += shx(v, 2, F.lane); v += shx(v, 4, F.lane); v += shx(v, 8, F.lane); ss[jj] = rsqrtf(v * (1.f / 64.f) + NORM_EPS); }
#pragma unroll
        for (int pt = 0; pt < 4; ++pt) { const float gn = gain[head * 64 + 16 * pt + r];
            po[r2][pt][0][0] = pk2h(acc[pt][0] * ss[0] * gn, acc[pt][1] * ss[1] * gn); po[r2][pt][0][1] = 0u;
            po[r2][pt][1][0] = pk2h(acc[pt][2] * ss[2] * gn, acc[pt][3] * ss[3] * gn); po[r2][pt][1][1] = 0u; }
    }
    LAS bf16* OUT = CL;
#pragma unroll
    for (int r2 = 0; r2 < 2; ++r2)
#pragma unroll
        for (int pt = 0; pt < 4; ++pt)
#pragma unroll
            for (int jp = 0; jp < 2; ++jp) { const unsigned pr = po[r2][pt][jp][0]; const int t = 16 * w + 4 * q + 2 * jp, c = r2 * 64 + 16 * pt + r;
                OUT[t * LP + c] = (bf16)(pr & 0xffffu); OUT[(t + 1) * LP + c] = (bf16)(pr >> 16); }
    __syncthreads();
    tile_l2g((bf16*)(F.ws + WS_Y) + (size_t)t0 * 1024 + 512 + g * 128, 1024, OUT, LP, 128, 128, F.tid);
    __syncthreads();
}
#ifdef DIAG_ML_ALT
#define ML_ALT(l) ((size_t)((l) & 1))
#else
#define ML_ALT(l) ((size_t)0)
#endif

DI void p_scans(Frame& F) {
    const int gid = F.bx * (NWAVES * 64) + F.tid, NT_ = F.G * NWAVES * 64;
    const float* sst = (const float*)(F.ws + WS_SST); bf16* hin = (bf16*)(F.ws + WS_SHIN); const float* dec = (const float*)(F.ws + WS_SMALL);
    for (int e = gid; e < 16 * 8192; e += NT_) {
        const int bh = e >> 13, idx = e & 8191, b = bh >> 2, head = bh & 3;
        float hst = 0.f;
        for (int cb = 0; cb < CPB; cb += 32) { float xs[32], ds[32];
#pragma unroll
            for (int i = 0; i < 32; ++i) { const size_t u = (size_t)((b * CPB + cb + i) * 4 + head); xs[i] = __builtin_nontemporal_load(sst + u * 8192 + idx); ds[i] = dec[u]; }
#pragma unroll
            for (int i = 0; i < 32; ++i) { const size_t u = (size_t)((b * CPB + cb + i) * 4 + head); hin[u * 8192 + idx] = (bf16)f2bf(hst); hst = ds[i] * hst + xs[i]; } }
    }
    const float* mls = (const float*)(F.ws + WS_MLS + ML_ALT(F.l) * (406 * MiB)); bf16* mlc = (bf16*)(F.ws + WS_MLC + ML_ALT(F.l) * (406 * MiB));
    const float* mlm = (const float*)(F.ws + WS_SMALL + 64 * 1024 + ML_ALT(F.l) * 16384); float* mlmin = (float*)(F.ws + WS_SMALL + 128 * 1024 + ML_ALT(F.l) * 16384);
    const int slot = (F.wave == 0) ? 0 : (F.wave == 4) ? 1 : (F.wave == 1) ? 2 : (F.wave == 5) ? 3 : -1;
    if (slot >= 0)
    for (int wt = slot * F.G + F.bx; wt < 520; wt += 4 * F.G) {
        const int e = wt * 64 + F.lane;
        const int bh = e / 2080, idx = 2 * (e % 2080), b = bh >> 2, head = bh & 3;
        float c0 = 0.f, c1 = 0.f, m = -1e30f;
        typedef float f32x2n __attribute__((ext_vector_type(2)));
        for (int cb = 0; cb < CPB; cb += 16) { f32x2n sv[16]; float ml[16], ae[16];
#pragma unroll
            for (int i = 0; i < 16; ++i) { const size_t u = (size_t)((b * CPB + cb + i) * 4 + head); ml[i] = mlm[2 * u]; ae[i] = mlm[2 * u + 1]; sv[i] = __builtin_nontemporal_load((const f32x2n*)(mls + u * 5120 + idx)); }
#pragma unroll
            for (int i = 0; i < 16; ++i) { const size_t u = (size_t)((b * CPB + cb + i) * 4 + head);
                __hip_atomic_store((unsigned*)(mlc + u * 5120 + idx), pk2h(c0, c1), __ATOMIC_RELAXED, __HIP_MEMORY_SCOPE_AGENT); if (idx == 0) mlmin[u] = m;
                const float mnew = fmaxf(ae[i] + m, ml[i]); const float fa = __expf(ae[i] + m - mnew), fb = __expf(ml[i] - mnew);
                c0 = fa * c0 + fb * sv[i].x; c1 = fa * c1 + fb * sv[i].y; m = mnew; } }
    }
}

struct SgPre { v4u u[2], v0, v1; };
DI void sg_load(Frame& F, int ch, int h, SgPre& P) {
    const bf16* proj = (const bf16*)(F.ws + WS_PROJ); const size_t t0 = (size_t)ch * CHUNK;
#pragma unroll
    for (int j = 0; j < 2; ++j) { const int i = F.tid + 512 * j, r = i >> 3, c = (i & 7) * 8; P.u[j] = *(const v4u*)(proj + (t0 + r) * PP + O_SU + h * 64 + c); }
    { const int s = F.tid >> 2, cg = F.tid & 3; const bf16* vp = proj + (t0 + s) * PP + O_SV + h * 64 + cg * 16; P.v0 = *(const v4u*)vp; P.v1 = *(const v4u*)(vp + 8); }
}
DI void sg_unit(Frame& F, int l, int ch, int h, const SgPre& P) {
    refresh(F);
    LAS bf16* WL = (LAS bf16*)F.lds;
    LAS bf16* VT = WL + 128 * LP;
    LAS bf16* UL = VT + 64 * LP;
    const int t0 = ch * CHUNK; const bf16* proj = (const bf16*)(F.ws + WS_PROJ);
#pragma unroll
    for (int j = 0; j < 2; ++j) { const int i = F.tid + 512 * j, r = i >> 3, c = (i & 7) * 8; *(LAS v4u*)(UL + r * LP64 + c) = P.u[j]; }
    { const int s = F.tid >> 2, cg = F.tid & 3; (void)proj;
      const v4u r0 = P.v0, r1 = P.v1; float x[16];
      { float a[8]; unpack8(r0, a);
#pragma unroll
        for (int e = 0; e < 8; ++e) x[e] = gelu_tanh_f(a[e]); unpack8(r1, a);
#pragma unroll
        for (int e = 0; e < 8; ++e) x[8 + e] = gelu_tanh_f(a[e]); }
      float ss = 0.f;
#pragma unroll
      for (int e = 0; e < 16; ++e) ss += x[e] * x[e];
      ss += shx(ss, 1, F.lane); ss += shx(ss, 2, F.lane);
      const float rs = rsqrtf(ss * (1.f / 64.f) + NORM_EPS); const float* gn = inp(F, I_MIXG) + (size_t)l * 1024 + 256 + h * 64 + cg * 16;
#pragma unroll
      for (int e = 0; e < 16; ++e) VT[(cg * 16 + e) * LP + s] = (bf16)f2bf(x[e] * rs * gn[e]); }
    { const float* wsrc = inp(F, I_SGW) + ((size_t)(l * 4 + h)) * 128 * 128;
#pragma unroll
      for (int i = 0; i < 8; ++i) { const int idx = F.tid + 512 * i, t = idx >> 5, s4 = (idx & 31) * 4; const f32x4 wv = *(const f32x4*)(wsrc + t * 128 + s4);
          v2u o; o[0] = pk2h(s4 <= t ? wv[0] : 0.f, s4 + 1 <= t ? wv[1] : 0.f); o[1] = pk2h(s4 + 2 <= t ? wv[2] : 0.f, s4 + 3 <= t ? wv[3] : 0.f);
          *(LAS v2u*)(WL + t * LP + s4) = o; } }
    __syncthreads();
    const int w = F.wave, r = F.lane & 15, q = F.lane >> 4;
    f32x4 acc[4];
#pragma unroll
    for (int dt = 0; dt < 4; ++dt) acc[dt] = (f32x4){0.f, 0.f, 0.f, 0.f};
    for (int ks = 0; ks <= (w >> 1); ++ks) { const bf16x8 a = *(const LAS bf16x8*)(WL + (16 * w + r) * LP + 32 * ks + 8 * q);
#pragma unroll
        for (int dt = 0; dt < 4; ++dt) { const bf16x8 b = *(const LAS bf16x8*)(VT + (16 * dt + r) * LP + 32 * ks + 8 * q); acc[dt] = mfma16(a, b, acc[dt]); } }
    const float* bs = inp(F, I_SGB) + (size_t)(l * 4 + h) * 128;
#pragma unroll
    for (int jj = 0; jj < 4; ++jj) { const int t = 16 * w + 4 * q + jj; const float bt = bs[t];
#pragma unroll
        for (int dt = 0; dt < 4; ++dt) { LAS bf16* p = UL + t * LP64 + 16 * dt + r; const float u = gelu_tanh_f(bf2f(*p)); *p = (bf16)f2bf(u * (acc[dt][jj] + bt)); } }
    __syncthreads();
    tile_l2g((bf16*)(F.ws + WS_Y) + (size_t)t0 * 1024 + 256 + h * 64, 1024, UL, LP64, 128, 64, F.tid);
    __syncthreads();
}

DI void ml_vectors(Frame& F, int l, int t0, int h, LAS float* A, LAS float* IG, LAS float* RED) {
    (void)RED;
    if (F.wave == 0) {
        const int s0 = 2 * F.lane; const float* gp = (const float*)(F.ws + WS_GATES) + (size_t)(t0 + s0) * 16; const float fb = inp(F, I_FB)[l * 4 + h], ib = inp(F, I_IB)[l * 4 + h];
        float a0 = log_sigmoid_f(gp[12 + h] + fb), a1 = log_sigmoid_f(gp[16 + 12 + h] + fb);
        IG[s0] = gp[8 + h] + ib; IG[s0 + 1] = gp[16 + 8 + h] + ib;
        wscan2<false>(a0, a1, F.lane);
        A[s0] = a0; A[s0 + 1] = a1; }
    __syncthreads();
}
struct MlLPre { v4u v0, v1, k0, k1; };
DI void ml_local_load(Frame& F, int ch, int h, MlLPre& P) {
    const bf16* proj = (const bf16*)(F.ws + WS_PROJ); const int s2 = (F.tid >> 3) * 2, c0 = (F.tid & 7) * 8;
    const bf16* vp = proj + ((size_t)ch * CHUNK + s2) * PP + O_LV + h * 64 + c0; const bf16* kp = proj + ((size_t)ch * CHUNK + s2) * PP + O_LK + h * 64 + c0;
    P.v0 = *(const v4u*)vp; P.v1 = *(const v4u*)(vp + PP); P.k0 = *(const v4u*)kp; P.k1 = *(const v4u*)(kp + PP);
}
DI void ml_local_unit(Frame& F, int l, int ch, int h, const MlLPre& P) {
    refresh(F);
    LAS bf16* VWT = (LAS bf16*)F.lds;
    LAS bf16* KT = VWT + 80 * LP;
    LAS float* A = (LAS float*)(F.lds + (80 + 64) * LP * 2); LAS float* IG = A + 128; LAS float* WG = IG + 128; LAS float* RED = WG + 128;
    const int t0 = ch * CHUNK; const bf16* proj = (const bf16*)(F.ws + WS_PROJ);
    const int s2 = (F.tid >> 3) * 2, c0 = (F.tid & 7) * 8; (void)proj;
    const v4u rv0 = P.v0, rv1 = P.v1, rk0 = P.k0, rk1 = P.k1;
    ml_vectors(F, l, t0, h, A, IG, RED);
    const float aend = A[127];
    float gval = -INFINITY;
    if (F.tid < 128) gval = aend - A[F.tid] + IG[F.tid];
    float mx = gval;
#pragma unroll
    for (int o = 1; o < 64; o <<= 1) mx = fmaxf(mx, shx(mx, o, F.lane));
    if (F.lane == 0 && F.wave < 2) RED[2 + F.wave] = mx;
    __syncthreads();
    const float mloc = fmaxf(RED[2], RED[3]);
    if (F.tid < 128) WG[F.tid] = __expf(gval - mloc);
    for (int i = F.tid; i < 15 * 64; i += 512) *(LAS unsigned*)(VWT + (65 + (i >> 6)) * LP + 2 * (i & 63)) = 0u;
    __syncthreads();
    if (F.tid < 64) *(LAS unsigned*)(VWT + 64 * LP + 2 * F.tid) = pk2h(WG[2 * F.tid], WG[2 * F.tid + 1]);
    {
      const float wg0 = WG[s2], wg1 = WG[s2 + 1];
      float x0[8], x1[8];
      unpack8(rv0, x0); unpack8(rv1, x1);
#pragma unroll
      for (int e = 0; e < 8; ++e) *(LAS unsigned*)(VWT + (c0 + e) * LP + s2) = pk2h(x0[e] * wg0, x1[e] * wg1);
      unpack8(rk0, x0); unpack8(rk1, x1);
#pragma unroll
      for (int e = 0; e < 8; ++e) *(LAS unsigned*)(KT + (c0 + e) * LP + s2) = pk2h(x0[e] * 0.125f, x1[e] * 0.125f); }
    __syncthreads();
    const int w = F.wave, r = F.lane & 15, q = F.lane >> 4;
    float* mls = (float*)(F.ws + WS_MLS + ML_ALT(F.l) * (406 * MiB)) + (size_t)(ch * 4 + h) * 5120;
#pragma unroll
    for (int it = 0; it < 3; ++it) { const int mt = (it < 2) ? (w >> 1) : 4, nt = (it < 2) ? 2 * (w & 1) + it : w;
        if (it == 2 && w >= 4) break;
        f32x4 acc = (f32x4){0.f, 0.f, 0.f, 0.f};
#pragma unroll
        for (int ks = 0; ks < 4; ++ks) { const bf16x8 a = *(const LAS bf16x8*)(VWT + (16 * mt + r) * LP + 32 * ks + 8 * q), b = *(const LAS bf16x8*)(KT + (16 * nt + r) * LP + 32 * ks + 8 * q); acc = mfma16(a, b, acc); }
#pragma unroll
#ifdef DIAG_MLS_CONST
        for (int jj = 0; jj < 4; ++jj) mls[(16 * mt + 4 * q + jj) * 64 + 16 * nt + r] = 0.01f * (float)(((16 * mt + 4 * q + jj) * 5 + (16 * nt + r) * 3 + ch) % 17 - 8);
#elif defined(DIAG_MLS_NOWG)
        for (int jj = 0; jj < 4; ++jj) mls[(16 * mt + 4 * q + jj) * 64 + 16 * nt + r] = acc[jj];
#else
        for (int jj = 0; jj < 4; ++jj) mls[(16 * mt + 4 * q + jj) * 64 + 16 * nt + r] = acc[jj];
#endif
    }
    if (F.tid == 0) { float* mlm = (float*)(F.ws + WS_SMALL + 64 * 1024 + ML_ALT(F.l) * 16384) + (size_t)(ch * 4 + h) * 2; mlm[0] = mloc; mlm[1] = aend; }
    __syncthreads();
}
struct MlPre { v4u q[2], k[2], o[2], v[2]; };
DI void ml_out_load(Frame& F, int ch, int h, MlPre& P) {
    const bf16* proj = (const bf16*)(F.ws + WS_PROJ); const size_t t0 = (size_t)ch * CHUNK;
#pragma unroll
    for (int j = 0; j < 2; ++j) { const int i = F.tid + 512 * j, r = i >> 3, c = (i & 7) * 8; const bf16* p = proj + (t0 + r) * PP + h * 64 + c;
        P.q[j] = *(const v4u*)(p + O_LQ); P.k[j] = *(const v4u*)(p + O_LK); P.o[j] = *(const v4u*)(p + O_LO); }
    { const int s = F.tid >> 2, cg = F.tid & 3; const bf16* vp = proj + (t0 + s) * PP + O_LV + h * 64 + cg * 16; P.v[0] = *(const v4u*)vp; P.v[1] = *(const v4u*)(vp + 8); }
}
struct NoHook { DI void operator()() const {} };
template <class Hook = NoHook> DI void ml_out_unit(Frame& F, int l, int ch, int h, const MlPre& P, Hook mid = Hook()) {
    refresh(F);
    LAS bf16* QL = (LAS bf16*)F.lds;
    LAS bf16* KL = QL + 128 * LP64;
    LAS bf16* OL = KL + 128 * LP64;
    LAS bf16* VT = OL + 128 * LP64;
    LAS bf16* WL = VT + 80 * LP;
    LAS float* A = (LAS float*)(F.lds + 3 * 128 * LP64 * 2 + (80 + 128) * LP * 2); LAS float* IG = A + 128; LAS float* E1 = IG + 128; LAS float* INTER = E1 + 128; LAS float* EMT = INTER + 128; LAS float* RED = EMT + 128;
    const int t0 = ch * CHUNK; const bf16* proj = (const bf16*)(F.ws + WS_PROJ);
#pragma unroll
    for (int j = 0; j < 2; ++j) { const int i = F.tid + 512 * j, r = i >> 3, c = (i & 7) * 8;
        *(LAS v4u*)(QL + r * LP64 + c) = P.q[j]; *(LAS v4u*)(KL + r * LP64 + c) = P.k[j]; *(LAS v4u*)(OL + r * LP64 + c) = P.o[j]; }
    { const int s = F.tid >> 2, cg = F.tid & 3;
      const v4u r0 = P.v[0], r1 = P.v[1];
#pragma unroll
      for (int e = 0; e < 4; ++e) { VT[(cg * 16 + 2 * e) * LP + s] = (bf16)(r0[e] & 0xffffu); VT[(cg * 16 + 2 * e + 1) * LP + s] = (bf16)(r0[e] >> 16);
          VT[(cg * 16 + 8 + 2 * e) * LP + s] = (bf16)(r1[e] & 0xffffu); VT[(cg * 16 + 8 + 2 * e + 1) * LP + s] = (bf16)(r1[e] >> 16); } }
    for (int i = F.tid; i < 16 * 128; i += 512) VT[(64 + (i >> 7)) * LP + (i & 127)] = (i < 128) ? (bf16)0x3f80u : (bf16)0;
    mid();
    const bf16* cin = (const bf16*)(F.ws + WS_MLC + ML_ALT(F.l) * (406 * MiB)) + (size_t)(ch * 4 + h) * 5120;
    bf16x8 cb[2][5];
#pragma unroll
    for (int ks = 0; ks < 2; ++ks)
#pragma unroll
        for (int nt = 0; nt < 5; ++nt) { cb[ks][nt] = *(const bf16x8*)(cin + (16 * nt + (F.lane & 15)) * 64 + 32 * ks + 8 * (F.lane >> 4)); if (nt == 4 && (F.lane & 15) != 0) cb[ks][nt] = (bf16x8){0, 0, 0, 0, 0, 0, 0, 0}; }
    ml_vectors(F, l, t0, h, A, IG, RED);
#ifdef DIAG_ML_NOINTER
    const float m_in = -1e30f;
#else
    const float m_in = ((const float*)(F.ws + WS_SMALL + 128 * 1024 + ML_ALT(F.l) * 16384))[ch * 4 + h];
#endif
    if (F.wave == 0) {
        const int s0 = 2 * F.lane; const float av0 = A[s0], av1 = A[s0 + 1]; const float ig0 = IG[s0] - av0, ig1 = IG[s0 + 1] - av1; float c0 = ig0, c1 = ig1;
        wscan2<true>(c0, c1, F.lane);
        const float m0 = fmaxf(c0, m_in), m1 = fmaxf(c1, m_in);
        IG[s0] = ig0; IG[s0 + 1] = ig1;
        E1[s0] = -m0; E1[s0 + 1] = -m1;
        INTER[s0] = __expf(m_in - m0); INTER[s0 + 1] = __expf(m_in - m1); EMT[s0] = __expf(-(av0 + m0)); EMT[s0 + 1] = __expf(-(av1 + m1)); }
    __syncthreads();
    const int w = F.wave, r = F.lane & 15, q = F.lane >> 4, wlim = w | 1, t_own = 16 * w + r;
    { const float e1 = E1[t_own];
#pragma unroll
      for (int st = 0; st < 8; ++st) if (st <= wlim) { f32x4 c = (f32x4){0.f, 0.f, 0.f, 0.f};
#pragma unroll
          for (int ks = 0; ks < 2; ++ks) { const bf16x8 a = *(const LAS bf16x8*)(KL + (16 * st + r) * LP64 + 32 * ks + 8 * q), b = *(const LAS bf16x8*)(QL + (16 * w + r) * LP64 + 32 * ks + 8 * q); c = mfma16(a, b, c); }
          float gv[4];
#pragma unroll
          for (int jj = 0; jj < 4; ++jj) { const int s = 16 * st + 4 * q + jj; gv[jj] = (s <= t_own) ? 0.125f * c[jj] * __expf(e1 + IG[s]) : 0.f; }
          v2u o; o[0] = pk2h(gv[0], gv[1]); o[1] = pk2h(gv[2], gv[3]);
          *(LAS v2u*)(WL + t_own * LP + 16 * st + 4 * q) = o; } }
    __syncthreads();
    f32x4 acc[5], accb[5];
#pragma unroll
    for (int nt = 0; nt < 5; ++nt) { acc[nt] = (f32x4){0.f, 0.f, 0.f, 0.f}; accb[nt] = (f32x4){0.f, 0.f, 0.f, 0.f}; }
    for (int ks = 0; ks <= (w >> 1); ++ks) { const bf16x8 a = *(const LAS bf16x8*)(WL + (16 * w + r) * LP + 32 * ks + 8 * q);
#pragma unroll
        for (int nt = 0; nt < 5; ++nt) { const bf16x8 b = *(const LAS bf16x8*)(VT + (16 * nt + r) * LP + 32 * ks + 8 * q); acc[nt] = mfma16(a, b, acc[nt]); } }
#pragma unroll
    for (int ks = 0; ks < 2; ++ks) { GL_PIN4(cb[ks][0], cb[ks][1], cb[ks][2], cb[ks][3]); GL_PIN(cb[ks][4]); }
#pragma unroll
    for (int ks = 0; ks < 2; ++ks) { const bf16x8 a = *(const LAS bf16x8*)(QL + (16 * w + r) * LP64 + 32 * ks + 8 * q);
#pragma unroll
        for (int nt = 0; nt < 5; ++nt) accb[nt] = mfma16(a, cb[ks][nt], accb[nt]); }
    const float* gain = inp(F, I_MIXG) + (size_t)l * 1024 + 768 + h * 64;
    float hv[4][4]; float ss[4];
#ifdef DIAG_ML_NOACCB
#pragma unroll
    for (int nt = 0; nt < 5; ++nt) accb[nt] = (f32x4){0.f, 0.f, 0.f, 0.f};
#endif
#pragma unroll
    for (int jj = 0; jj < 4; ++jj) { const int t = 16 * w + 4 * q + jj; const float it = INTER[t];
        const float den_l = acc[4][jj] + it * accb[4][jj]; const float den = shidx(den_l, F.lane & 48);
        const float dd = 1.f / fmaxf(fabsf(den), EMT[t]); float s2 = 0.f;
#pragma unroll
        for (int nt = 0; nt < 4; ++nt) { const float v = (acc[nt][jj] + it * accb[nt][jj]) * dd; hv[nt][jj] = v; s2 += v * v; }
        s2 += shx(s2, 1, F.lane); s2 += shx(s2, 2, F.lane); s2 += shx(s2, 4, F.lane); s2 += shx(s2, 8, F.lane);
        ss[jj] = rsqrtf(s2 * (1.f / 64.f) + NORM_EPS); }
#pragma unroll
    for (int nt = 0; nt < 4; ++nt) { const float gn = gain[16 * nt + r];
#pragma unroll
        for (int jj = 0; jj < 4; ++jj) { const int t = 16 * w + 4 * q + jj; const float og = sigmoid_f(bf2f(OL[t * LP64 + 16 * nt + r]));
            KL[t * LP64 + 16 * nt + r] = (bf16)f2bf(og * hv[nt][jj] * ss[jj] * gn); } }
    __syncthreads();
    tile_l2g((bf16*)(F.ws + WS_Y) + (size_t)t0 * 1024 + 768 + h * 64, 1024, KL, LP64, 128, 64, F.tid);
    __syncthreads();
}

DI void p_gates(Frame& F, int blk) {
    const bf16* H = (const bf16*)(F.ws + WS_H); const bf16* WG = (const bf16*)(F.ws + WS_WIN) + (size_t)PP * 1024; float* G = (float*)(F.ws + WS_GATES);
    const int r = F.lane & 15, q = F.lane >> 4;
    const bf16* bp = WG + (size_t)r * 1024 + 8 * q;
    _Pragma("unroll 1") for (int rt = 0; rt < 2; ++rt) { const int row0 = blk * 256 + F.wave * 32 + rt * 16;
        const bf16* ap = H + (size_t)(row0 + r) * 1024 + 8 * q;
        f32x4 acc = (f32x4){0.f, 0.f, 0.f, 0.f};
#pragma unroll
        for (int kb = 0; kb < 2; ++kb) { bf16x8 av[16], bv[16];
#pragma unroll
            for (int i = 0; i < 16; ++i) { av[i] = *(const bf16x8*)(ap + 32 * (16 * kb + i)); bv[i] = *(const bf16x8*)(bp + 32 * (16 * kb + i)); }
#pragma unroll
            for (int i = 0; i < 16; i += 4) { GL_PIN4(av[i], av[i + 1], av[i + 2], av[i + 3]); GL_PIN4(bv[i], bv[i + 1], bv[i + 2], bv[i + 3]); }
#pragma unroll
            for (int i = 0; i < 16; ++i) acc = mfma16(av[i], bv[i], acc); }
#pragma unroll
        for (int jj = 0; jj < 4; ++jj) G[(size_t)(row0 + 4 * q + jj) * 16 + r] = acc[jj]; }
}
DI void p_router(Frame& F, int l) {
    constexpr int WRP = 1032;
    LAS bf16* WRL = (LAS bf16*)F.lds;
    LAS float* LG = (LAS float*)(F.lds + 48 * WRP * 2);
    LAS int* CNT = (LAS int*)(F.lds + 48 * WRP * 2 + 8 * 16 * 48 * 4);
    const bf16* H = (const bf16*)(F.ws + WS_H); const bf16* WR = (const bf16*)(F.ws + WS_WR);
    int* tok_e = (int*)(F.ws + WS_TOK); int* tok_lp = (int*)(F.ws + WS_TOK + 256 * 1024); float* tok_w = (float*)(F.ws + WS_TOK + 512 * 1024);
    int* hist = (int*)(F.ws + WS_SMALL + 192 * 1024);
    const int r = F.lane & 15, q = F.lane >> 4;
    tile_g2l(WRL, WRP, WR, 1024, 48, 1024, F.tid);
    __syncthreads();
    for (int blk = F.bx; blk < T / 128; blk += F.G) {
        if (F.tid < 256) CNT[F.tid] = 0;
        __syncthreads();
        const int row0 = blk * 128 + F.wave * 16;
        f32x4 acc[3];
#pragma unroll
        for (int nt = 0; nt < 3; ++nt) acc[nt] = (f32x4){0.f, 0.f, 0.f, 0.f};
        const bf16* ap = H + (size_t)(row0 + r) * 1024 + 8 * q;
#pragma unroll
        for (int kb = 0; kb < 2; ++kb) { bf16x8 av[16];
#pragma unroll
            for (int i = 0; i < 16; ++i) av[i] = *(const bf16x8*)(ap + 32 * (16 * kb + i));
#pragma unroll
            for (int i = 0; i < 16; i += 4) GL_PIN4(av[i], av[i + 1], av[i + 2], av[i + 3]);
#pragma unroll
            for (int i = 0; i < 16; ++i) { const int ks = 16 * kb + i;
#pragma unroll
                for (int nt = 0; nt < 3; ++nt) { const bf16x8 b = *(const LAS bf16x8*)(WRL + (16 * nt + r) * WRP + 32 * ks + 8 * q); acc[nt] = mfma16(av[i], b, acc[nt]); } } }
        LAS float* lg = LG + F.wave * 16 * 48;
#pragma unroll
        for (int nt = 0; nt < 3; ++nt)
#pragma unroll
            for (int jj = 0; jj < 4; ++jj) lg[(4 * q + jj) * 48 + 16 * nt + r] = acc[nt][jj];
        LDS_WAIT(); asm volatile("" ::: "memory");
        int ex1 = -1, ex2 = -2; float gw1 = 0.f, gw2 = 0.f;
        if (F.lane < 16) {
            const LAS float* x = lg + F.lane * 48; const float* brg = inp(F, I_BRG) + l * 4; const float* bre = inp(F, I_BRE) + l * 32;
            float g0 = x[0] + brg[0], g1 = x[1] + brg[1], g2 = x[2] + brg[2], g3 = x[3] + brg[3];
            int gs = 0; float gm = g0; if (g1 > gm) { gm = g1; gs = 1; } if (g2 > gm) { gm = g2; gs = 2; } if (g3 > gm) { gm = g3; gs = 3; }
            const float gp = 1.f / (__expf(g0 - gm) + __expf(g1 - gm) + __expf(g2 - gm) + __expf(g3 - gm));
            float t1 = -INFINITY, t2 = -INFINITY; int i1 = 0, i2 = 0;
#pragma unroll
            for (int i = 0; i < 8; ++i) { const float v = x[4 + 8 * gs + i] + bre[8 * gs + i];
                if (v > t1) { t2 = t1; i2 = i1; t1 = v; i1 = i; } else if (v > t2) { t2 = v; i2 = i; } }
            const float e2 = __expf(t2 - t1), p1 = 1.f / (1.f + e2), p2 = e2 * p1;
            ex1 = 8 * gs + i1; ex2 = 8 * gs + i2; gw1 = gp * p1; gw2 = gp * p2;
        }
        int pos1 = 0, pos2 = 0;
#pragma unroll
        for (int j = 0; j < 16; ++j) { const int o1 = __builtin_amdgcn_ds_bpermute(j << 2, ex1), o2 = __builtin_amdgcn_ds_bpermute(j << 2, ex2);
            if (j < F.lane) { pos1 += (o1 == ex1) + (o2 == ex1); pos2 += (o1 == ex2) + (o2 == ex2); } }
        LAS int* wcnt = CNT + F.wave * 32;
        if (F.lane < 16) { __hip_atomic_fetch_add(wcnt + ex1, 1, __ATOMIC_RELAXED, __HIP_MEMORY_SCOPE_WORKGROUP); __hip_atomic_fetch_add(wcnt + ex2, 1, __ATOMIC_RELAXED, __HIP_MEMORY_SCOPE_WORKGROUP); }
        __syncthreads();
        if (F.lane < 16) { int b1 = 0, b2 = 0;
            for (int w2 = 0; w2 < F.wave; ++w2) { b1 += CNT[w2 * 32 + ex1]; b2 += CNT[w2 * 32 + ex2]; }
            const int m = row0 + F.lane;
            tok_e[2 * m] = ex1; tok_e[2 * m + 1] = ex2; tok_lp[2 * m] = b1 + pos1; tok_lp[2 * m + 1] = b2 + pos2; tok_w[2 * m] = gw1; tok_w[2 * m + 1] = gw2; }
        if (F.tid < 32) { int c = 0; for (int w2 = 0; w2 < 8; ++w2) c += CNT[w2 * 32 + F.tid]; hist[blk * 32 + F.tid] = c; }
        __syncthreads();
    }
}
DI void p_dispatch(Frame& F) {
    LAS int* PT = (LAS int*)F.lds;
    LAS int* PB = PT + 512;
    LAS int* TS = PB + 512;
    LAS int* BASE = TS + 64;
    LAS int* TOT = BASE + 32;
    const int* hist = (const int*)(F.ws + WS_SMALL + 192 * 1024); int* tstart = (int*)(F.ws + WS_SMALL + 256 * 1024);
    const int* tok_e = (const int*)(F.ws + WS_TOK); const int* tok_lp = (const int*)(F.ws + WS_TOK + 256 * 1024); int* tok_d = (int*)(F.ws + WS_TOK + 768 * 1024);
    int* rowtok = (int*)(F.ws + WS_SMALL + 512 * 1024);
    for (int blk = F.bx; blk < T / 128; blk += F.G) {
        { const int e = F.tid & 31, part = F.tid >> 5; int tot = 0, bs = 0;
          for (int b2 = part * 16; b2 < part * 16 + 16; ++b2) { const int c = hist[b2 * 32 + e]; tot += c; bs += (b2 < blk) ? c : 0; }
          PT[part * 32 + e] = tot; PB[part * 32 + e] = bs; }
        __syncthreads();
        if (F.tid < 32) { int tot = 0, bs = 0;
            for (int p = 0; p < 16; ++p) { tot += PT[p * 32 + F.tid]; bs += PB[p * 32 + F.tid]; }
            PT[F.tid] = (tot + 255) >> 8; BASE[F.tid] = bs; TOT[F.tid] = tot; }
        __syncthreads();
        if (F.tid == 0) { int run = 0; for (int e = 0; e < 32; ++e) { TS[e] = run; run += PT[e]; } TS[32] = run; }
        __syncthreads();
        if (blk == 0 && F.tid < 33) tstart[F.tid] = TS[F.tid];
        const int row0 = blk * 128 + F.wave * 16;
        if (F.lane < 32) { const int m = row0 + (F.lane >> 1), k = F.lane & 1; const int e = tok_e[2 * m + k]; const int d = 256 * TS[e] + BASE[e] + tok_lp[2 * m + k];
            tok_d[2 * m + k] = d; rowtok[d] = m; }
        __syncthreads();
    }
}

struct Args { const float* in[27]; float* out; unsigned char* ws; int ph_lo, ph_hi; };
#ifndef CV_TAILN
#define CV_TAILN 1536
#endif
constexpr int PH_PER_LAYER = 11, PH_TOTAL = 1 + NLAYER * PH_PER_LAYER + 1;

__global__ void __launch_bounds__(NWAVES * 64, 2) mega_fwd(Args args) {
    extern __shared__ __attribute__((aligned(16))) unsigned char lds[];
    Frame F;
    F.lds = (LAS unsigned char*)lds;
    F.MISC = (volatile LAS unsigned*)(F.lds + MISC_OFF);
    F.tid = threadIdx.x; F.lane = F.tid & 63; F.wave = __builtin_amdgcn_readfirstlane(F.tid >> 6);
    F.G = gridDim.x; F.bx = blockIdx.x; { const int bx = F.bx; F.vcu = (F.G % 8 == 0) ? (bx % 8) * (F.G / 8) + bx / 8 : bx; }
    F.out = args.out; F.ws = args.ws; F.ctl = (gu32*)(args.ws + WS_CTL);
    for (int u = F.tid; u < (LDS_BYTES - RING_BYTES) / 4; u += NWAVES * 64) ((LAS unsigned*)(F.lds + RING_BYTES))[u] = 0u;
    __syncthreads();
    if (F.tid < 27) { const unsigned long long p = (unsigned long long)args.in[F.tid]; LAS unsigned* t = (LAS unsigned*)(F.lds + PTRTAB_OFF) + 2 * F.tid; t[0] = (unsigned)p; t[1] = (unsigned)(p >> 32); }
    __syncthreads();
    XcdBarrier bar = xcd_barrier_post((unsigned*)(F.ctl + CW_BAR), F.MISC + 8);
    const int lo = args.ph_lo, hi = args.ph_hi;
    int ph = 0;
#define IN_RANGE() (lo <= ph && ph < hi)
#define FRESH() do { int t_ = threadIdx.x; asm volatile("" : "+v"(t_)); F.tid = t_; F.lane = t_ & 63; F.wave = __builtin_amdgcn_readfirstlane(t_ >> 6); size_t z_ = 0; unsigned zl_ = 0; int bx_ = blockIdx.x, g_ = gridDim.x; asm volatile("" : "+s"(z_), "+s"(zl_), "+s"(bx_), "+s"(g_)); F.z = z_; F.lds = (LAS unsigned char*)lds + zl_; F.ws = args.ws + z_; F.out = args.out + z_; F.ctl = (gu32*)(F.ws + WS_CTL); int ly_ = l; asm volatile("" : "+s"(ly_)); F.l = ly_; F.bx = bx_; F.G = g_; F.vcu = (g_ % 8 == 0) ? (bx_ % 8) * (g_ / 8) + bx_ / 8 : bx_; } while (0)
#ifndef PHMASK
#define PHMASK 0xffffffffu
#endif
#ifndef LRUN
#define LRUN NLAYER
#endif
#ifndef PCUT
#define PCUT 11
#endif
#ifndef DIAG_COMB_MIN
#define DIAG_COMB_MIN 11
#endif
#ifndef DUPMASK
#define DUPMASK 0u
#endif
#define REPS(k) ((((DUPMASK) >> (k)) & 1u) ? 2 : 1)
#ifndef SKIP_MOE0
#define SKIP_MOE0 0
#endif
#define EN(k) ((((PHMASK) >> (k)) & 1u) && ((k) == 0 || (k) >= 12 || l < LRUN - 1 || (k) <= PCUT) && !(SKIP_MOE0 && l == 0 && (k) >= 8 && (k) <= 11))
#define SEAM() do { if (lo <= ph && ph + 1 < hi) { size_t zb_ = 0; asm volatile("" : "+s"(zb_), "+s"(bar.x)); bar.bar = (unsigned*)(args.ws + WS_CTL + zb_) + CW_BAR; xcd_barrier(bar); } ++ph; } while (0)

#define xrun ((bf16*)(F.ws + WS_XRES))
#define mod ((const float*)(F.ws + WS_MOD))
#define H ((bf16*)(F.ws + WS_H))
#define PROJ ((bf16*)(F.ws + WS_PROJ))
#define Y ((bf16*)(F.ws + WS_Y))

    { const int l = 0; (void)l;
    if (IN_RANGE() && EN(0)) for (int rep_ = 0; rep_ < REPS(0); ++rep_) { FRESH(); p_mod(F); p_convert(F, 0, 0, CV_DENSE); } }
    SEAM();

    for (int l = 0; l < LRUN; ++l) {
#define modl (mod + (size_t)F.l * 4 * 6144)
        if (IN_RANGE() && EN(1)) for (int rep_ = 0; rep_ < REPS(1); ++rep_) { FRESH();
            p_norm<0>(F, F.l == 0 ? (const void*)inp(F, I_X) : (const void*)xrun, F.l != 0, (SKIP_MOE0 && F.l == 1) ? -1 : F.l - 1, xrun, inp(F, I_WN1) + (size_t)F.l * 1024, modl, modl + 1024, H, nullptr);
        }
        SEAM();
        if (IN_RANGE() && EN(2)) for (int rep_ = 0; rep_ < REPS(2); ++rep_) { FRESH();
            const int GG = F.G;
#ifndef STAGGER
#define STAGGER 0
#endif
            if (F.bx < GG) {
                for (int d_ = 0; d_ < STAGGER * (F.bx & 7); ++d_) __builtin_amdgcn_s_sleep(28);
#ifndef GATES_TAIL
#define GATES_TAIL 0
#endif
                if (GATES_TAIL) {
                    pg8::Gemm g{H, (const bf16*)(F.ws + WS_WIN), T, PP, D}; pg8::StaticOrder S; S.init(T, PP, GG, F.bx);
                    pg8::EpiProj E{PROJ, (float*)(F.ws + WS_GATES)};
                    pg8::gemm_phase<pg8::EpiProj, pg8::StaticOrder, PG8_ALIGN, PG8_SP2>(F.lds, g, S, E);
                    const int nun_ = (T / 256) * (PP / 256), rem_ = nun_ % GG;
                    const int ntail_ = rem_ ? GG - rem_ : GG, rank_ = rem_ ? F.bx - rem_ : F.bx;
                    if (rank_ >= 0) { __syncthreads(); refresh(F);
                        for (int blk_ = rank_; blk_ < T / 256; blk_ += ntail_) p_gates(F, blk_);
                        if (rem_) p_convert(F, F.l, CV_DENSE, CV_DENSE + CV_TAILN, rank_ * NWAVES + F.wave, ntail_ * NWAVES); }
                } else {
                pg8::Gemm g{H, (const bf16*)(F.ws + WS_WIN), T, NPROJ_T, D}; pg8::StaticOrder S; S.init(T, NPROJ_T, GG, F.bx);
                pg8::EpiProj E{PROJ, (float*)(F.ws + WS_GATES)};
                pg8::gemm_phase<pg8::EpiProj, pg8::StaticOrder, PG8_ALIGN, PG8_SP2>(F.lds, g, S, E);
                }
            } else p_convert(F, F.l, CV_DENSE, CV_ALL, (F.bx - GG) * NWAVES + F.wave, (F.G - GG) * NWAVES);
        }
        SEAM();
        if (IN_RANGE() && EN(3)) for (int rep_ = 0; rep_ < REPS(3); ++rep_) { FRESH();
            for (int ch = F.bx; ch < NCHUNK; ch += F.G) {
                _Pragma("unroll 1") for (int g = 0; g < 2; ++g) ssd_local_unit(F, F.l, ch, g);
                { MlLPre PA_, PB_; ml_local_load(F, ch, 0, PA_);
                  ml_local_load(F, ch, 1, PB_); ml_local_unit(F, F.l, ch, 0, PA_);
                  ml_local_load(F, ch, 2, PA_); ml_local_unit(F, F.l, ch, 1, PB_);
                  ml_local_load(F, ch, 3, PB_); ml_local_unit(F, F.l, ch, 2, PA_);
                  ml_local_unit(F, F.l, ch, 3, PB_); }
            }
            for (int bh = F.bx; bh < 16; bh += F.G) fscan_unit(F, F.l, bh);
            for (int u = F.bx; u < 256; u += F.G) qknorm_unit(F, u, F.ctl + CW_QKN + F.l * 32);
        }
        SEAM();
        if (IN_RANGE() && EN(4)) for (int rep_ = 0; rep_ < REPS(4); ++rep_) { FRESH();
            const bool exp_here = true;
            gu32* cvq = F.ctl + CW_CVQ + 64 * F.l; (void)exp_here;
            (void)cvq;
#ifndef CV_IN_MIX
#define CV_IN_MIX 0
#endif
#ifndef CV_MIXHEAD
#define CV_MIXHEAD 4
#endif
            const bool mixhead_ = CV_MIXHEAD > 0 && (F.G % (8 * CV_MIXHEAD)) == 0;
            const int cv0_ = mixhead_ ? CV_ALL : CV_DENSE + ((GATES_TAIL && (((T / 256) * (PP / 256)) % F.G) != 0) ? CV_TAILN : 0);
            if (F.wave < 4) { p_scans(F); if (!CV_IN_MIX) p_convert(F, F.l, cv0_, CV_ALL); if (!mixhead_ && F.l + 1 < NLAYER) p_convert(F, F.l + 1, 0, CV_WIN); }
            else { if (!CV_IN_MIX) p_convert(F, F.l, cv0_, CV_ALL); if (!mixhead_ && F.l + 1 < NLAYER) p_convert(F, F.l + 1, 0, CV_WIN); p_scans(F); } }
        SEAM();
        if (IN_RANGE() && EN(5)) for (int rep_ = 0; rep_ < REPS(5); ++rep_) { FRESH();
            const attn_body::AttnTensors AT{(const attn_body::bf16*)(PROJ + O_AQ), (const attn_body::bf16*)(PROJ + O_AK), (const attn_body::bf16*)(PROJ + O_AV), (attn_body::bf16*)Y,
                                            (const float*)(F.ws + WS_F2), inp(F, I_MIXG) + (size_t)F.l * 1024, (const unsigned*)(F.ctl + CW_QKN + F.l * 32)};
            LAS int* QS = (LAS int*)(F.lds + RING_BYTES + 640);
#ifndef MLQ_AHEAD
#define MLQ_AHEAD 0
#endif
#ifndef QMODE
#define QMODE 5
#endif
#ifndef PROBE_ATT2
#define PROBE_ATT2 0
#endif
#ifndef PROBE_ML2
#define PROBE_ML2 0
#endif
            if (CV_MIXHEAD > 0 && (F.G % (8 * CV_MIXHEAD)) == 0 && ((F.bx >> 3) % CV_MIXHEAD) == 0) {
                const int rank_ = (F.bx / (8 * CV_MIXHEAD)) * 8 + (F.bx & 7), nconv_ = F.G / CV_MIXHEAD;
                p_convert(F, F.l, CV_DENSE, CV_ALL, rank_ * NWAVES + F.wave, nconv_ * NWAVES);
                if (F.l + 1 < NLAYER) p_convert(F, F.l + 1, 0, CV_WIN, rank_ * NWAVES + F.wave, nconv_ * NWAVES);
                __syncthreads(); refresh(F); }
            constexpr int CVJ = 6; int cvp = CV_IN_MIX ? 0 : CVJ;
#define CV_PIECE() do { if (cvp < CVJ) { __syncthreads(); refresh(F); p_convert_np(F, F.l, CV_DENSE, CV_ALL, (F.vcu * NWAVES + F.wave) * CVJ + cvp, F.G * NWAVES * CVJ); ++cvp; __syncthreads(); } } while (0)
            for (int pa_ = 0; pa_ <= PROBE_ATT2; ++pa_) for (;;) {
                if (F.tid == 0) QS[0] = (int)__hip_atomic_fetch_add(F.ctl + CW_Q + 64 * F.l + 4 * pa_, 1u, __ATOMIC_RELAXED, __HIP_MEMORY_SCOPE_AGENT);
                __syncthreads();
                const int idx = __builtin_amdgcn_readfirstlane(QS[0]);
                __syncthreads();
                if (idx >= ((QMODE >= 2) ? 512 : 512 + 2560)) break;
                if (idx < 512) { const attn_body::AttnUnit u{(idx & 3) * 4 + 3 - ((idx >> 2) & 3), 31 - (idx >> 4)};
                    attn_body::attn_unit<8>(u.bh / 4, u.bh % 4, u.qb, AT.Q, AT.K, AT.V, AT.O, AT.F2, AT.gain, 2.0f * sqrtf(__uint_as_float(AT.qkn[2 * u.bh]) * __uint_as_float(AT.qkn[2 * u.bh + 1])), (char*)lds); }
                else { const int j = idx - 512;
                    if (j < 1024) { SgPre P_; sg_load(F, j >> 2, j & 3, P_); sg_unit(F, F.l, j >> 2, j & 3, P_); }
                    else if (j < 1536) ssd_out_unit(F, F.l, (j - 1024) >> 1, (j - 1024) & 1);
                    else { MlPre P_; ml_out_load(F, (j - 1536) >> 2, (j - 1536) & 3, P_); ml_out_unit(F, F.l, (j - 1536) >> 2, (j - 1536) & 3, P_); } }
#ifndef CV_NO_ATT_SITE
                CV_PIECE();
#endif
            }
            if (QMODE == 6) {
                _Pragma("unroll 1") for (int ty = 0; ty < 3; ++ty) {
                    for (;;) {
                        if (F.tid == 0) QS[0] = (int)__hip_atomic_fetch_add(F.ctl + CW_Q + 64 * F.l + 8 + 8 * ty, 1u, __ATOMIC_RELAXED, __HIP_MEMORY_SCOPE_AGENT);
                        __syncthreads();
                        const int j = __builtin_amdgcn_readfirstlane(QS[0]);
                        __syncthreads();
                        if (j >= (ty == 1 ? 512 : 1024)) break;
                        if (ty == 0) { SgPre P_; sg_load(F, j >> 2, j & 3, P_); sg_unit(F, F.l, j >> 2, j & 3, P_); } else if (ty == 1) ssd_out_unit(F, F.l, j >> 1, j & 1); else { MlPre P_; ml_out_load(F, j >> 2, j & 3, P_); ml_out_unit(F, F.l, j >> 2, j & 3, P_); }
                    } }
            } else if (QMODE == 7 && (F.G & 7) == 0) {
                for (;;) {
                    if (F.tid == 0) QS[0] = (int)__hip_atomic_fetch_add(F.ctl + CW_Q + 64 * F.l + 32, 1u, __ATOMIC_RELAXED, __HIP_MEMORY_SCOPE_AGENT);
                    __syncthreads();
                    const int j = __builtin_amdgcn_readfirstlane(QS[0]);
                    __syncthreads();
                    if (j >= 1024) break;
                    { MlPre P_; ml_out_load(F, j >> 2, j & 3, P_); ml_out_unit(F, F.l, j >> 2, j & 3, P_); }
                }
                for (;;) {
                    if (F.tid == 0) QS[0] = (int)__hip_atomic_fetch_add(F.ctl + CW_QX + (F.l * 8 + (F.bx & 7)) * 64, 1u, __ATOMIC_RELAXED, __HIP_MEMORY_SCOPE_AGENT);
                    __syncthreads();
                    const int j = __builtin_amdgcn_readfirstlane(QS[0]);
                    __syncthreads();
                    if (j >= 6 * (NCHUNK / 8)) break;
                    const int ch = (F.bx & 7) + 8 * (j / 6), sub = j % 6;
                    if (sub < 4) { SgPre P_; sg_load(F, ch, sub, P_); sg_unit(F, F.l, ch, sub, P_); } else ssd_out_unit(F, F.l, ch, sub - 4);
                }
            } else if (QMODE == 5 && MLQ_AHEAD) {
                gu32* qc_ = F.ctl + CW_Q + 64 * F.l + 32;
                if (F.tid == 0) { QS[0] = (int)__hip_atomic_fetch_add(qc_, 1u, __ATOMIC_RELAXED, __HIP_MEMORY_SCOPE_AGENT); QS[1] = (int)__hip_atomic_fetch_add(qc_, 1u, __ATOMIC_RELAXED, __HIP_MEMORY_SCOPE_AGENT); }
                __syncthreads();
                int j = __builtin_amdgcn_readfirstlane(QS[0]), jn = __builtin_amdgcn_readfirstlane(QS[1]);
                __syncthreads();
                MlPre PA_; if (j < 1024) ml_out_load(F, j >> 2, j & 3, PA_);
                _Pragma("unroll 1") while (j < 1024) {
                    unsigned nx_ = 0u; if (F.tid == 0) nx_ = __hip_atomic_fetch_add(qc_, 1u, __ATOMIC_RELAXED, __HIP_MEMORY_SCOPE_AGENT);
                    MlPre PB_; const int jl = jn < 1024 ? jn : j;
                    ml_out_unit(F, F.l, j >> 2, j & 3, PA_, [&]() { ml_out_load(F, jl >> 2, jl & 3, PB_); });
                    if (F.tid == 0) QS[0] = (int)nx_;
                    __syncthreads();
                    const int jnn = __builtin_amdgcn_readfirstlane(QS[0]);
                    __syncthreads();
                    j = jn; jn = jnn; PA_ = PB_;
                }
                for (int ch = F.bx; ch < NCHUNK; ch += F.G) {
                    { SgPre PA2_, PB2_; sg_load(F, ch, 0, PA2_);
                        sg_load(F, ch, 1, PB2_); sg_unit(F, F.l, ch, 0, PA2_);
                        sg_load(F, ch, 2, PA2_); sg_unit(F, F.l, ch, 1, PB2_);
                        sg_load(F, ch, 3, PB2_); sg_unit(F, F.l, ch, 2, PA2_);
                        sg_unit(F, F.l, ch, 3, PB2_); }
                    _Pragma("unroll 1") for (int g = 0; g < 2; ++g) ssd_out_unit(F, F.l, ch, g); }
            } else if (QMODE >= 3) {
                for (;;) {
                    if (F.tid == 0) QS[0] = (int)__hip_atomic_fetch_add(F.ctl + CW_Q + 64 * F.l + 32, 1u, __ATOMIC_RELAXED, __HIP_MEMORY_SCOPE_AGENT);
                    __syncthreads();
                    const int j = __builtin_amdgcn_readfirstlane(QS[0]);
                    __syncthreads();
                    if (j >= (QMODE == 4 ? 512 : 1024)) break;
                    if (QMODE == 3) { SgPre P_; sg_load(F, j >> 2, j & 3, P_); sg_unit(F, F.l, j >> 2, j & 3, P_); } else if (QMODE == 4) ssd_out_unit(F, F.l, j >> 1, j & 1); else { MlPre P_; ml_out_load(F, j >> 2, j & 3, P_); ml_out_unit(F, F.l, j >> 2, j & 3, P_); }
                    CV_PIECE();
                }
                _Pragma("unroll 1") while (cvp < CVJ) CV_PIECE();
                for (int ch = F.bx; ch < NCHUNK; ch += F.G) {
                    if (QMODE != 3) { SgPre PA_, PB_; sg_load(F, ch, 0, PA_);
                        sg_load(F, ch, 1, PB_); sg_unit(F, F.l, ch, 0, PA_);
                        sg_load(F, ch, 2, PA_); sg_unit(F, F.l, ch, 1, PB_);
                        sg_load(F, ch, 3, PB_); sg_unit(F, F.l, ch, 2, PA_);
                        sg_unit(F, F.l, ch, 3, PB_); }
                    if (QMODE != 4) { _Pragma("unroll 1") for (int g = 0; g < 2; ++g) ssd_out_unit(F, F.l, ch, g); }
                    if (QMODE != 5) { _Pragma("unroll 1") for (int h = 0; h < 4; ++h) { MlPre P_; ml_out_load(F, ch, h, P_); ml_out_unit(F, F.l, ch, h, P_); } } }
            }
            if (QMODE == 2) for (int ch = F.bx; ch < NCHUNK; ch += F.G) {
                _Pragma("unroll 1") for (int h = 0; h < 4; ++h) { SgPre P_; sg_load(F, ch, h, P_); sg_unit(F, F.l, ch, h, P_); }
                _Pragma("unroll 1") for (int g = 0; g < 2; ++g) ssd_out_unit(F, F.l, ch, g);
                _Pragma("unroll 1") for (int h = 0; h < 4; ++h) { MlPre P_; ml_out_load(F, ch, h, P_); ml_out_unit(F, F.l, ch, h, P_); } }
        }
        SEAM();
        if (IN_RANGE() && EN(6)) for (int rep_ = 0; rep_ < REPS(6); ++rep_) { FRESH();
            pg8::Gemm g{Y, (const bf16*)(F.ws + WS_WOUT), T, D, D}; pg8::StaticOrder S; S.init(T, D, F.G, F.bx);
#ifndef FUSE_NORM2
#define FUSE_NORM2 0
#endif
            if (FUSE_NORM2 && F.G == 256) {
                pg8::EpiOutNorm E{(float*)xrun, modl + 2 * 1024, inp(F, I_WN2) + (size_t)F.l * 1024, modl + 3 * 1024, modl + 4 * 1024, H, (float*)(F.ws + WS_SLOT) + (size_t)F.l * T * 4,
                                  (unsigned*)(F.ctl + CW_PAN + F.l * 128 * 64), (unsigned*)(F.ctl + CW_TMO)};
                { pg8::OneRound S0{S, 0}; pg8::gemm_phase<pg8::EpiOutNorm, pg8::OneRound, false, PG8_SP2>(F.lds, g, S0, E); }
                __syncthreads();
                { pg8::OneRound S1{S, 1}; pg8::gemm_phase<pg8::EpiOutNorm, pg8::OneRound, false, PG8_SP2>(F.lds, g, S1, E); }
            } else {
            pg8::EpiOut E{xrun, modl + 2 * 1024};
            pg8::gemm_phase<pg8::EpiOut, pg8::StaticOrder, PG8_ALIGN, PG8_SP2>(F.lds, g, S, E);
            }
        }
        SEAM();
        if (IN_RANGE() && EN(7)) for (int rep_ = 0; rep_ < REPS(7); ++rep_) { FRESH();
            if (!(FUSE_NORM2 && F.G == 256)) p_norm<0>(F, xrun, true, -1, nullptr, inp(F, I_WN2) + (size_t)F.l * 1024, modl + 3 * 1024, modl + 4 * 1024, H, nullptr);
        }
        SEAM();
        if (IN_RANGE() && EN(8)) for (int rep_ = 0; rep_ < REPS(8); ++rep_) { FRESH(); p_router(F, F.l); }
        SEAM();
        if (IN_RANGE() && EN(9)) for (int rep_ = 0; rep_ < REPS(9); ++rep_) { FRESH(); p_dispatch(F); }
        SEAM();
        if (IN_RANGE() && EN(10)) for (int rep_ = 0; rep_ < REPS(10); ++rep_) { FRESH();
            LAS int* TS = (LAS int*)(F.lds + RING_BYTES + 1024);
            if (F.tid < 33) TS[F.tid] = ((const int*)(F.ws + WS_SMALL + 256 * 1024))[F.tid];
            __syncthreads();
            if (F.tid == 0) { int run = 0; for (int s_ = 0; s_ < 4; ++s_) { const int e_ = (F.bx & 7) + 8 * s_; TS[40 + s_] = run; TS[48 + s_] = TS[e_]; run += 4 * (TS[e_ + 1] - TS[e_]); } TS[44] = run;
                int gm_ = 0; for (int x_ = 0; x_ < 8; ++x_) { int u_ = 0; for (int s_ = 0; s_ < 4; ++s_) u_ += 4 * (TS[x_ + 8 * s_ + 1] - TS[x_ + 8 * s_]); const int r_ = (u_ + (F.G >> 3) - 1) / (F.G >> 3); gm_ = r_ > gm_ ? r_ : gm_; } TS[45] = gm_; }
            __syncthreads();
            pg8::Gemm g{H, (const bf16*)(F.ws + WS_WGU + (size_t)(F.l & 1) * EXP_ALT), MOE_ROWS, NEXP * 1024, D};
            pg8::MoeOrder S{F.G, F.bx, TS + 40};
            LAS int* RT = (LAS int*)(F.lds + RING_BYTES + 4096);
            { pg8::Unit u_; const int* rowtok = (const int*)(F.ws + WS_SMALL + 512 * 1024);
              const int nxu_ = __builtin_amdgcn_readfirstlane(TS[44]), lcu_ = F.bx >> 3, peru_ = F.G >> 3; int nu_ = nxu_ > lcu_ ? (nxu_ - lcu_ + peru_ - 1) / peru_ : 0; nu_ = nu_ > 12 ? 12 : nu_;
              _Pragma("unroll 1") for (int i_ = 0; i_ < nu_; ++i_) { (void)S.next(i_, u_); const int pm_ = __builtin_amdgcn_readfirstlane(u_.pm);
                  if (F.tid < 256) { const unsigned tk = (unsigned)rowtok[pm_ * 256 + F.tid]; RT[i_ * 256 + F.tid] = (int)(tk < (unsigned)T ? tk : (unsigned)(T - 1)); } } }
            __syncthreads();
            pg8::EpiGU E{(bf16*)(F.ws + WS_ACT)};
            pg8::gemm_phase<pg8::EpiGU, pg8::MoeOrder, PG8_ALIGN, PG8_SP2, true>(F.lds, g, S, E, RT);
            if (F.l + 1 < NLAYER) { p_convert(F, F.l + 1, CV_WIN, CV_DENSE);
                const int nx_ = __builtin_amdgcn_readfirstlane(TS[44]), lc_ = F.bx >> 3, per_ = F.G >> 3, myunits = nx_ > lc_ ? (nx_ - lc_ + per_ - 1) / per_ : 0;
                const int idle_ = __builtin_amdgcn_readfirstlane(TS[45]) - myunits;
                (void)idle_; }
        }
        SEAM();
        if (IN_RANGE() && EN(11)) for (int rep_ = 0; rep_ < REPS(11); ++rep_) { FRESH();
            LAS int* TS = (LAS int*)(F.lds + RING_BYTES + 1024);
            if (F.tid < 33) TS[F.tid] = ((const int*)(F.ws + WS_SMALL + 256 * 1024))[F.tid];
            __syncthreads();
            if (F.tid == 0) { int run = 0; for (int s_ = 0; s_ < 4; ++s_) { const int e_ = (F.bx & 7) + 8 * s_; TS[40 + s_] = run; TS[48 + s_] = TS[e_]; run += 4 * (TS[e_ + 1] - TS[e_]); } TS[44] = run;
                int gm_ = 0; for (int x_ = 0; x_ < 8; ++x_) { int u_ = 0; for (int s_ = 0; s_ < 4; ++s_) u_ += 4 * (TS[x_ + 8 * s_ + 1] - TS[x_ + 8 * s_]); const int r_ = (u_ + (F.G >> 3) - 1) / (F.G >> 3); gm_ = r_ > gm_ ? r_ : gm_; } TS[45] = gm_; }
            __syncthreads();
            pg8::Gemm g{(const bf16*)(F.ws + WS_ACT), (const bf16*)(F.ws + WS_WDN + (size_t)(F.l & 1) * EXP_ALT), MOE_ROWS, NEXP * 1024, DEXP};
            pg8::MoeOrder S{F.G, F.bx, TS + 40};
            pg8::EpiDown E{(bf16*)(F.ws + WS_YB)};
            pg8::gemm_phase<pg8::EpiDown, pg8::MoeOrder, PG8_ALIGN, PG8_SP2>(F.lds, g, S, E);
            if (F.l + 1 < NLAYER) { const int nx_ = __builtin_amdgcn_readfirstlane(TS[44]), lc_ = F.bx >> 3, per_ = F.G >> 3, myunits = nx_ > lc_ ? (nx_ - lc_ + per_ - 1) / per_ : 0;
                const int idle_ = __builtin_amdgcn_readfirstlane(TS[45]) - myunits;
                (void)idle_; }
        }
        SEAM();
    }
    { const int l = 0; (void)l; if (IN_RANGE() && EN(12)) for (int rep_ = 0; rep_ < REPS(12); ++rep_) { FRESH(); p_norm<1>(F, xrun, true, (PCUT >= DIAG_COMB_MIN) ? LRUN - 1 : -1, nullptr, inp(F, I_WNF), nullptr, nullptr, nullptr, F.out); } }
#undef xrun
#undef mod
#undef H
#undef PROJ
#undef Y
#undef modl
#undef IN_RANGE
#undef SEAM
}

#ifndef MK_SPLIT
#define MK_SPLIT 0
#endif
extern "C" void kernel_launch(void* const* d_in, const int* in_sizes, int n_in, void* d_out, int out_size, void* d_ws, size_t ws_size, hipStream_t stream) {
    static int grid = 0;
    if (grid == 0) {
        if (n_in != 27 || out_size != T * D || ws_size < WS_END) { fprintf(stderr, "kernel_launch: unexpected shapes (n_in %d, out %d, ws %zu)\n", n_in, out_size, ws_size); grid = -1; return; }
        int dev = 0, cus = 0, per_cu = 0;
        if (hipGetDevice(&dev) != hipSuccess || hipDeviceGetAttribute(&cus, hipDeviceAttributeMultiprocessorCount, dev) != hipSuccess) { grid = -1; return; }
        if (hipFuncSetAttribute((const void*)mega_fwd, hipFuncAttributeMaxDynamicSharedMemorySize, LDS_BYTES) != hipSuccess) { fprintf(stderr, "kernel_launch: hipFuncSetAttribute failed\n"); grid = -1; return; }
        if (hipOccupancyMaxActiveBlocksPerMultiprocessor(&per_cu, (const void*)mega_fwd, NWAVES * 64, LDS_BYTES) != hipSuccess || per_cu < 1) { fprintf(stderr, "kernel_launch: occupancy query says %d\n", per_cu); (void)hipGetLastError(); grid = -1; return; }
        grid = cus;
    }
    if (grid < 0) return;
    (void)hipMemsetAsync((char*)d_ws + WS_CTL, 0, CTL_ZERO_BYTES, stream);
    Args a{};
    for (int i = 0; i < 27; ++i) a.in[i] = (const float*)d_in[i];
    a.out = (float*)d_out; a.ws = (unsigned char*)d_ws;
#if MK_SPLIT
    for (int p = 0; p < PH_TOTAL; ++p) { a.ph_lo = p; a.ph_hi = p + 1; hipLaunchKernelGGL(mega_fwd, dim3(grid), dim3(NWAVES * 64), LDS_BYTES, stream, a); }
#else
    a.ph_lo = 0; a.ph_hi = PH_TOTAL;
    hipLaunchKernelGGL(mega_fwd, dim3(grid), dim3(NWAVES * 64), LDS_BYTES, stream, a);
#endif
}
```
